# Optimizing an MI355X kernel written in HIP

```python
import math
import jax
import jax.numpy as jnp
from jax import lax
import numpy as np

D_MODEL = 1024
BATCH = 8
SEQ = 4096
DEPTH = 2

GRID_W = 64
CTX_LEN = 256
W_HALF = D_MODEL // 2
MIX_W = 2 * W_HALF
EPS = 1e-6
LRU_HEADS = 8
LRU_HEAD_DIM = W_HALF // LRU_HEADS
LRU_CONV = 4
LRU_C = 8.0
HY_ORDER = 2
HY_SHORT = 3
HY_BANDS = 16
HY_EMB = 2 * HY_BANDS + 1
HY_FFN = 64
HY_MAX_DECAY = math.log(1e-2) / 0.3
HY_MIN_DECAY = math.log(1e-2) / 1.5
HG_HEADS = 4
HG_DK = W_HALF // HG_HEADS
HG_DV = W_HALF // HG_HEADS
HG_CHUNK = 64
S5_H = 16
S5_GROUPS = W_HALF // S5_H
S5_P = 64
S5_MAX_RE = -1e-4
N_EXPERTS = 16
EC_CAPACITY = 2
D_FF_EXPERT = 3 * D_MODEL // 2
N_EVEN = (DEPTH + 1) // 2
N_ODD = DEPTH // 2

kernel_name = "hybrid_lru_hyena_hgrn2_s5_ec_diffusion"


def _rms_norm(x, g):
    xf = x.astype(jnp.float32)
    y = xf * lax.rsqrt(jnp.mean(xf * xf, axis=-1, keepdims=True) + EPS)
    return (y * g.astype(jnp.float32)).astype(x.dtype)


def _modulate(h, shift, scale):
    return h * (1.0 + scale) + shift


def _dwconv(x, w, b):
    k = w.shape[0]
    left = (k - 1) // 2
    y = lax.conv_general_dilated(x, w[:, None, :].astype(x.dtype), window_strides=(1,),
                                 padding=[(left, k - 1 - left)],
                                 dimension_numbers=('NWC', 'WIO', 'NWC'),
                                 feature_group_count=x.shape[-1])
    return y + b.astype(x.dtype)


def _linear_scan(a, b, h0, reverse):
    if reverse:
        a = jnp.flip(a, 1)
        b = jnp.flip(b, 1)
    b = b.at[:, 0].add(a[:, 0] * h0)

    def comb(l, r):
        return l[0] * r[0], r[0] * l[1] + r[1]

    _, h = lax.associative_scan(comb, (a, b), axis=1)
    last = h[:, -1]
    if reverse:
        h = jnp.flip(h, 1)
    return h, last


def _to_col_major(t, rows):
    bsz, l, ch = t.shape
    return t.reshape(bsz, rows, GRID_W, ch).transpose(0, 2, 1, 3).reshape(bsz, l, ch)


def _to_row_major(t, rows):
    bsz, l, ch = t.shape
    return t.reshape(bsz, GRID_W, rows, ch).transpose(0, 2, 1, 3).reshape(bsz, l, ch)


def _rglru_coeffs(xh, wa, ba, wx, bx, lam):
    r = jax.nn.sigmoid(jnp.einsum('blhi,hij->blhj', xh, wa) + ba)
    i = jax.nn.sigmoid(jnp.einsum('blhi,hij->blhj', xh, wx) + bx)
    log_a = -LRU_C * r * jax.nn.softplus(-lam.astype(jnp.float32))
    a = jnp.exp(log_a)
    return a, jnp.sqrt(-jnp.expm1(2.0 * log_a)) * i * xh


def _rglru_mixer(xr_c, xr_l, xg_c, xg_l, conv_w, conv_b, wa, ba, wx, bx, lam):
    need_ctx = xg_c is not None

    def prep(xr):
        bsz, l, _ = xr.shape
        return _dwconv(xr, conv_w, conv_b).astype(jnp.float32).reshape(bsz, l, LRU_HEADS, LRU_HEAD_DIM)

    xc, xl = prep(xr_c), prep(xr_l)
    bsz, l = xl.shape[:2]
    y_c = 0.0
    y_l = 0.0
    for d in range(2):
        rev = d == 1
        a, bb = _rglru_coeffs(xc, wa[d], ba[d], wx[d], bx[d], lam[d])
        h_c, last = _linear_scan(a, bb, jnp.zeros((bsz, LRU_HEADS, LRU_HEAD_DIM), jnp.float32), rev)
        a, bb = _rglru_coeffs(xl, wa[d], ba[d], wx[d], bx[d], lam[d])
        h_l, _ = _linear_scan(a, bb, last, rev)
        y_l = y_l + h_l
        if need_ctx:
            y_c = y_c + h_c
    out_l = y_l.reshape(bsz, l, W_HALF).astype(xg_l.dtype) * jax.nn.gelu(xg_l)
    if not need_ctx:
        return None, out_l
    out_c = y_c.reshape(bsz, xc.shape[1], W_HALF).astype(xg_c.dtype) * jax.nn.gelu(xg_c)
    return out_c, out_l


def _hyena_filters(l, w1, b1, w2, b2, w3, freq):
    t = jnp.arange(l, dtype=jnp.float32)
    t_unit = t / max(l - 1, 1)
    bands = jnp.linspace(1e-4, HY_BANDS - 1, HY_BANDS, dtype=jnp.float32)
    ang = (2.0 * math.pi / l) * t[:, None] * bands[None, :]
    z = jnp.concatenate([t_unit[:, None], jnp.cos(ang), -jnp.sin(ang)], axis=-1)
    fr = freq.astype(jnp.float32)
    h = jnp.sin(fr * (z @ w1.astype(jnp.float32) + b1.astype(jnp.float32)))
    h = jnp.sin(fr * (h @ w2.astype(jnp.float32) + b2.astype(jnp.float32)))
    h = h @ w3.astype(jnp.float32)
    dist = jnp.abs(t - (l // 2)) / (l / 2.0)
    deltas = jnp.abs(jnp.linspace(HY_MIN_DECAY, HY_MAX_DECAY, HY_ORDER * W_HALF, dtype=jnp.float32))
    h = h * jnp.exp(-dist[:, None] * deltas[None, :])
    h = h * lax.rsqrt(jnp.sum(h * h, axis=0, keepdims=True) + EPS)
    return h.reshape(l, HY_ORDER, W_HALF).transpose(1, 0, 2)


def _fft_conv(u, filt, skip):
    l = u.shape[1]
    n = 2 * l
    uf = u.astype(jnp.float32)
    spec = jnp.fft.rfft(uf, n=n, axis=1) * jnp.fft.rfft(filt, n=n, axis=0)[None]
    y = jnp.fft.irfft(spec, n=n, axis=1)[:, l // 2: l // 2 + l]
    return (y + uf * skip.astype(jnp.float32)).astype(u.dtype)


def _hyena(u, conv_w, conv_b, w1, b1, w2, b2, w3, freq, skip):
    l = u.shape[1]
    u = _dwconv(u, conv_w, conv_b)
    v, x1, x2 = jnp.split(u, 3, axis=-1)
    filt = _hyena_filters(l, w1, b1, w2, b2, w3, freq)
    z = x1 * _fft_conv(v, filt[0], skip[0])
    z = x2 * _fft_conv(z, filt[1], skip[1])
    return z


def _even_mixer(h_ctx, h_lat, need_ctx, in_w, out_w, lru_conv_w, lru_conv_b, lru_wa, lru_ba, lru_wx, lru_bx,
                lru_lam, hy_conv_w, hy_conv_b, hy_w1, hy_b1, hy_w2, hy_b2, hy_w3, hy_freq, hy_skip):
    w = W_HALF
    u_l = h_lat @ in_w
    u_c = h_ctx @ (in_w if need_ctx else in_w[:, :w])
    ya_c, ya_l = _rglru_mixer(u_c[..., :w], u_l[..., :w], u_c[..., w:2 * w] if need_ctx else None,
                              u_l[..., w:2 * w], lru_conv_w, lru_conv_b, lru_wa, lru_ba, lru_wx, lru_bx, lru_lam)
    yb_l = _hyena(u_l[..., 2 * w:], hy_conv_w, hy_conv_b, hy_w1, hy_b1, hy_w2, hy_b2, hy_w3, hy_freq, hy_skip)
    y_l = jnp.concatenate([ya_l, yb_l], axis=-1) @ out_w
    if not need_ctx:
        return None, y_l
    yb_c = _hyena(u_c[..., 2 * w:], hy_conv_w, hy_conv_b, hy_w1, hy_b1, hy_w2, hy_b2, hy_w3, hy_freq, hy_skip)
    y_c = jnp.concatenate([ya_c, yb_c], axis=-1) @ out_w
    return y_c, y_l


def _hgrn_gates(fp, lb):
    lbh = lb.reshape(HG_HEADS, HG_DK)
    logf = jnp.logaddexp(jnp.log(lbh), jnp.log1p(-lbh) + jax.nn.log_sigmoid(fp))
    k = (1.0 - lbh) * jax.nn.sigmoid(-fp)
    return k, logf


def _hgrn_chunk_scan(k, v, logf, q, s0):
    bsz, l, h, _ = k.shape
    n = l // HG_CHUNK

    def chunks(t):
        return t.reshape(bsz, n, HG_CHUNK, h, t.shape[-1]).transpose(1, 0, 3, 2, 4)

    with_out = q is not None
    xs = (chunks(k), chunks(v), chunks(logf)) + ((chunks(q),) if with_out else ())
    lower = jnp.tril(jnp.ones((HG_CHUNK, HG_CHUNK), dtype=bool))

    def step(s, inp):
        kc, vc, gc = inp[0], inp[1], inp[2]
        bcum = jnp.cumsum(gc, axis=2)
        b_last = bcum[:, :, -1:, :]
        s_new = (jnp.exp(b_last[:, :, 0, :])[..., None] * s
                 + jnp.einsum('bhcd,bhce->bhde', kc * jnp.exp(b_last - bcum), vc))
        if not with_out:
            return s_new, None
        qc = inp[3]
        o = jnp.einsum('bhcd,bhde->bhce', qc * jnp.exp(bcum), s)
        diff = jnp.where(lower[:, :, None], bcum[:, :, :, None, :] - bcum[:, :, None, :, :], -jnp.inf)
        att = jnp.einsum('bhtd,bhsd,bhtsd->bhts', qc, kc, jnp.exp(diff))
        o = o + jnp.einsum('bhts,bhse->bhte', att, vc)
        return s_new, o

    s_fin, o = lax.scan(step, s0, xs)
    if with_out:
        o = o.transpose(1, 0, 3, 2, 4).reshape(bsz, l, h, -1)
    return o, s_fin


def _hgrn_bidir(kf, lf, kb, lbk, v, q, s0f, s0b):
    def fl(t):
        return None if t is None else jnp.flip(t, 1)

    o_f, s_f = _hgrn_chunk_scan(kf, v, lf, q, s0f)
    o_b, s_b = _hgrn_chunk_scan(fl(kb), fl(v), fl(lbk), fl(q), s0b)
    o = None if q is None else o_f + jnp.flip(o_b, 1)
    return o, s_f, s_b


def _hgrn_out(o, g, norm_g):
    bsz, l = o.shape[:2]
    o = o * lax.rsqrt(jnp.mean(o * o, axis=-1, keepdims=True) + EPS) * norm_g.astype(jnp.float32)
    return o.reshape(bsz, l, W_HALF).astype(g.dtype) * jax.nn.silu(g)


def _s5_discrete(lam_re, lam_im, log_dt):
    lam = lax.complex(jnp.minimum(lam_re.astype(jnp.float32), S5_MAX_RE), lam_im.astype(jnp.float32))
    dt = jnp.exp(log_dt.astype(jnp.float32))[:, None]
    lam_bar = jnp.exp(lam * dt)
    return lam_bar, (lam_bar - 1.0) / lam


def _s5_bidir(u, lam_re, lam_im, log_dt, b_c, c_c, h0f, h0b, with_out):
    bu = jnp.einsum('blgh,gph->blgp', u.astype(jnp.complex64), b_c)
    y = 0.0
    h0s = (h0f, h0b)
    lasts = []
    for d in range(2):
        lam_bar, coef = _s5_discrete(lam_re[d], lam_im[d], log_dt[d])
        h, last = _linear_scan(jnp.broadcast_to(lam_bar, bu.shape), coef * bu, h0s[d], d == 1)
        lasts.append(last)
        if with_out:
            y = y + jnp.real(jnp.einsum('blgp,ghp->blgh', h, c_c))
    return (y if with_out else None), lasts[0], lasts[1]


def _s5_out(y, u, d_skip, glu_w, glu_b, dtype):
    bsz, l = u.shape[:2]
    y = jax.nn.gelu((y + u * d_skip.astype(jnp.float32)).reshape(bsz, l, W_HALF))
    return (y * jax.nn.sigmoid(y @ glu_w.astype(jnp.float32) + glu_b.astype(jnp.float32))).astype(dtype)


def _odd_mixer(h_ctx, h_lat, rows, need_ctx, in_w, out_w, lb, hg_norm_g, lam_re, lam_im, log_dt,
               b_re, b_im, c_re, c_im, d_skip, glu_w, glu_b):
    w = W_HALF
    u_l = _to_col_major(h_lat, rows) @ in_w
    u_c = h_ctx @ (in_w if need_ctx else in_w[:, :4 * w])

    def hg_parts(u, with_q):
        bsz, l, _ = u.shape

        def hd(t):
            return t.astype(jnp.float32).reshape(bsz, l, HG_HEADS, -1)

        kf, lf = _hgrn_gates(hd(u[..., :w]), lb)
        kb, lbk = _hgrn_gates(hd(u[..., w:2 * w]), lb)
        v = hd(u[..., 2 * w:3 * w])
        q = jax.nn.silu(hd(u[..., 4 * w:5 * w])) if with_q else None
        return kf, lf, kb, lbk, v, q

    bc = h_ctx.shape[0]
    s0 = jnp.zeros((bc, HG_HEADS, HG_DK, HG_DV), jnp.float32)
    o_c, s_f, s_b = _hgrn_bidir(*hg_parts(u_c, need_ctx), s0, s0)
    o_l, _, _ = _hgrn_bidir(*hg_parts(u_l, True), s_f, s_b)
    hg_l = _hgrn_out(o_l, u_l[..., 5 * w:], hg_norm_g)

    b_c = lax.complex(b_re.astype(jnp.float32), b_im.astype(jnp.float32))
    c_c = lax.complex(c_re.astype(jnp.float32), c_im.astype(jnp.float32))

    def s5_in(u):
        bsz, l, _ = u.shape
        return u[..., 3 * w:4 * w].astype(jnp.float32).reshape(bsz, l, S5_GROUPS, S5_H)

    sc, sl = s5_in(u_c), s5_in(u_l)
    z0 = jnp.zeros((bc, S5_GROUPS, S5_P), jnp.complex64)
    yc, h_f, h_b = _s5_bidir(sc, lam_re, lam_im, log_dt, b_c, c_c, z0, z0, need_ctx)
    yl, _, _ = _s5_bidir(sl, lam_re, lam_im, log_dt, b_c, c_c, h_f, h_b, True)
    s5_l = _s5_out(yl, sl, d_skip, glu_w, glu_b, h_lat.dtype)
    y_l = _to_row_major(jnp.concatenate([hg_l, s5_l], axis=-1) @ out_w, rows)
    if not need_ctx:
        return None, y_l
    hg_c = _hgrn_out(o_c, u_c[..., 5 * w:], hg_norm_g)
    s5_c = _s5_out(yc, sc, d_skip, glu_w, glu_b, h_ctx.dtype)
    y_c = jnp.concatenate([hg_c, s5_c], axis=-1) @ out_w
    return y_c, y_l


def _expert_choice_ffn(h, w_router, w_gate, w_up, w_down):
    bsz, n, d = h.shape
    cap = max(1, (EC_CAPACITY * n) // N_EXPERTS)
    aff = jax.nn.softmax(jnp.einsum('bnd,de->bne', h, w_router).astype(jnp.float32), axis=-1)
    gate, idx = lax.top_k(jnp.swapaxes(aff, 1, 2), cap)
    xin = jax.vmap(lambda hb, ib: hb[ib])(h, idx)
    a = jnp.einsum('becd,edf->becf', xin, w_gate)
    u = jnp.einsum('becd,edf->becf', xin, w_up)
    y = jnp.einsum('becf,efd->becd', jax.nn.silu(a) * u, w_down) * gate[..., None].astype(h.dtype)
    return jax.vmap(lambda yb, ib: jnp.zeros((n, d), yb.dtype).at[ib.reshape(-1)].add(yb.reshape(-1, d)))(y, idx)


def setup_inputs(seed: int = 0) -> dict:
    key = jax.random.key(seed)
    ks = iter(jax.random.split(key, 64))
    f32 = jnp.float32
    d, w = D_MODEL, W_HALF

    def nrm(shape, scale):
        return jax.random.normal(next(ks), shape, f32) * scale

    a8 = jax.random.uniform(next(ks), (N_EVEN, 2, LRU_HEADS, LRU_HEAD_DIM), f32, 0.9, 0.999)
    a_base = a8 ** (1.0 / LRU_C)
    lru_lam = jnp.log(a_base) - jnp.log1p(-a_base)
    s5_im = jnp.pi * jnp.arange(S5_P, dtype=f32)
    return {
        "x": nrm((BATCH, SEQ, d), 1.0),
        "c": nrm((BATCH, d), 1.0),
        "ctx": nrm((BATCH, CTX_LEN, d), 1.0),
        "c_ctx": nrm((d,), 1.0),
        "mod_w": nrm((DEPTH, d, 6 * d), 0.3 * d ** -0.5),
        "mod_b": nrm((DEPTH, 6 * d), 0.02),
        "norm1_g": 1.0 + nrm((DEPTH, d), 0.02),
        "norm2_g": 1.0 + nrm((DEPTH, d), 0.02),
        "out_w": nrm((DEPTH, MIX_W, d), MIX_W ** -0.5),
        "even_in_w": nrm((N_EVEN, d, 5 * w), d ** -0.5),
        "lru_conv_w": nrm((N_EVEN, LRU_CONV, w), LRU_CONV ** -0.5),
        "lru_conv_b": nrm((N_EVEN, w), 0.01),
        "lru_wa": nrm((N_EVEN, 2, LRU_HEADS, LRU_HEAD_DIM, LRU_HEAD_DIM), LRU_HEAD_DIM ** -0.5),
        "lru_ba": nrm((N_EVEN, 2, LRU_HEADS, LRU_HEAD_DIM), 0.01),
        "lru_wx": nrm((N_EVEN, 2, LRU_HEADS, LRU_HEAD_DIM, LRU_HEAD_DIM), LRU_HEAD_DIM ** -0.5),
        "lru_bx": nrm((N_EVEN, 2, LRU_HEADS, LRU_HEAD_DIM), 0.01),
        "lru_lam": lru_lam,
        "hy_conv_w": nrm((N_EVEN, HY_SHORT, 3 * w), HY_SHORT ** -0.5),
        "hy_conv_b": nrm((N_EVEN, 3 * w), 0.01),
        "hy_w1": nrm((N_EVEN, HY_EMB, HY_FFN), HY_EMB ** -0.5),
        "hy_b1": nrm((N_EVEN, HY_FFN), 0.01),
        "hy_w2": nrm((N_EVEN, HY_FFN, HY_FFN), HY_FFN ** -0.5),
        "hy_b2": nrm((N_EVEN, HY_FFN), 0.01),
        "hy_w3": nrm((N_EVEN, HY_FFN, HY_ORDER * w), HY_FFN ** -0.5),
        "hy_freq": 1.0 + nrm((N_EVEN, HY_FFN), 0.02),
        "hy_skip": nrm((N_EVEN, HY_ORDER, w), 0.5),
        "odd_in_w": nrm((N_ODD, d, 6 * w), d ** -0.5),
        "hg_lb": nrm((DEPTH, w), 0.1),
        "hg_norm_g": 1.0 + nrm((N_ODD, HG_DV), 0.02),
        "s5_lam_re": -0.5 + nrm((N_ODD, 2, S5_GROUPS, S5_P), 0.01),
        "s5_lam_im": s5_im + nrm((N_ODD, 2, S5_GROUPS, S5_P), 0.01),
        "s5_log_dt": jax.random.uniform(next(ks), (N_ODD, 2, S5_GROUPS), f32, math.log(1e-3), math.log(1e-1)),
        "s5_b_re": nrm((N_ODD, S5_GROUPS, S5_P, S5_H), (2 * S5_H) ** -0.5),
        "s5_b_im": nrm((N_ODD, S5_GROUPS, S5_P, S5_H), (2 * S5_H) ** -0.5),
        "s5_c_re": nrm((N_ODD, S5_GROUPS, S5_H, S5_P), S5_P ** -0.5),
        "s5_c_im": nrm((N_ODD, S5_GROUPS, S5_H, S5_P), S5_P ** -0.5),
        "s5_d": nrm((N_ODD, S5_GROUPS, S5_H), 1.0),
        "s5_glu_w": nrm((N_ODD, w, w), w ** -0.5),
        "s5_glu_b": nrm((N_ODD, w), 0.01),
        "router_w": nrm((DEPTH, d, N_EXPERTS), d ** -0.5),
        "ex_w_gate": nrm((DEPTH, N_EXPERTS, d, D_FF_EXPERT), d ** -0.5),
        "ex_w_up": nrm((DEPTH, N_EXPERTS, d, D_FF_EXPERT), d ** -0.5),
        "ex_w_down": nrm((DEPTH, N_EXPERTS, D_FF_EXPERT, d), D_FF_EXPERT ** -0.5),
        "final_g": 1.0 + nrm((d,), 0.02),
    }


def reference(x, c, ctx, c_ctx, mod_w, mod_b, norm1_g, norm2_g, out_w, even_in_w, lru_conv_w, lru_conv_b,
              lru_wa, lru_ba, lru_wx, lru_bx, lru_lam, hy_conv_w, hy_conv_b, hy_w1, hy_b1, hy_w2, hy_b2, hy_w3,
              hy_freq, hy_skip, odd_in_w, hg_lb, hg_norm_g, s5_lam_re, s5_lam_im, s5_log_dt, s5_b_re, s5_b_im,
              s5_c_re, s5_c_im, s5_d, s5_glu_w, s5_glu_b, router_w, ex_w_gate, ex_w_up, ex_w_down, final_g):
    rows = x.shape[1] // GRID_W
    p = jax.nn.softmax(hg_lb.astype(jnp.float32), axis=0)
    lb_all = jnp.clip(jnp.cumsum(p, axis=0) - p[0], 0.0, 1.0 - 1e-4)
    sc_lat = jax.nn.silu(c)
    sc_ctx = jax.nn.silu(c_ctx)[None]
    for i in range(DEPTH):
        need_ctx = i < DEPTH - 1
        j = i // 2
        ml = [t[:, None, :] for t in jnp.split(sc_lat @ mod_w[i] + mod_b[i], 6, axis=-1)]
        mc = [t[:, None, :] for t in jnp.split(sc_ctx @ mod_w[i] + mod_b[i], 6, axis=-1)]
        h_lat = _modulate(_rms_norm(x, norm1_g[i]), ml[0], ml[1])
        h_ctx = _modulate(_rms_norm(ctx, norm1_g[i]), mc[0], mc[1])
        if i % 2 == 0:
            y_c, y_l = _even_mixer(h_ctx, h_lat, need_ctx, even_in_w[j], out_w[i], lru_conv_w[j], lru_conv_b[j],
                                   lru_wa[j], lru_ba[j], lru_wx[j], lru_bx[j], lru_lam[j], hy_conv_w[j],
                                   hy_conv_b[j], hy_w1[j], hy_b1[j], hy_w2[j], hy_b2[j], hy_w3[j], hy_freq[j],
                                   hy_skip[j])
        else:
            y_c, y_l = _odd_mixer(h_ctx, h_lat, rows, need_ctx, odd_in_w[j], out_w[i], lb_all[i], hg_norm_g[j],
                                  s5_lam_re[j], s5_lam_im[j], s5_log_dt[j], s5_b_re[j], s5_b_im[j], s5_c_re[j],
                                  s5_c_im[j], s5_d[j], s5_glu_w[j], s5_glu_b[j])
        x = x + ml[2] * y_l
        x = x + ml[5] * _expert_choice_ffn(_modulate(_rms_norm(x, norm2_g[i]), ml[3], ml[4]),
                                           router_w[i], ex_w_gate[i], ex_w_up[i], ex_w_down[i])
        if need_ctx:
            ctx = ctx + mc[2] * y_c
            ctx = ctx + mc[5] * _expert_choice_ffn(_modulate(_rms_norm(ctx, norm2_g[i]), mc[3], mc[4]),
                                                   router_w[i], ex_w_gate[i], ex_w_up[i], ex_w_down[i])
    return _rms_norm(x, final_g)
```

```cpp
#include <hip/hip_runtime.h>
#include <hip/hip_bf16.h>
#include <hip/hip_cooperative_groups.h>
#include <cstdio>
#include <cstdint>
namespace cg = cooperative_groups;

typedef unsigned short u16;
using bf16x8 = __attribute__((ext_vector_type(8))) short;
using f32x4 = __attribute__((ext_vector_type(4))) float;
using u32x4 = __attribute__((ext_vector_type(4))) uint32_t;
#define DEVI __device__ __forceinline__

constexpr int NL = 32768, NC = 2048, NT = 34816;
constexpr size_t AL(size_t x) { return (x + 255) & ~(size_t)255; }
constexpr size_t EXPSZ = 16ull * 1536 * 1024;
constexpr size_t O_WIN0 = 0;
constexpr size_t O_WIN1 = O_WIN0 + AL(2560ull * 1024 * 2);
constexpr size_t O_WOUT = O_WIN1 + AL(3072ull * 1024 * 2);
constexpr size_t O_WGLU = O_WOUT + AL(2ull * 1024 * 1024 * 2);
constexpr size_t O_WEXP = O_WGLU + AL(512ull * 512 * 2);
constexpr size_t O_MOD = O_WEXP + AL(3 * EXPSZ * 2);
constexpr size_t O_HB = O_MOD + AL(2ull * 9 * 6144 * 4);
constexpr size_t O_U = O_HB + AL((size_t)NT * 1024 * 2);
constexpr size_t O_XC = O_U + AL((size_t)NT * 3072 * 2);
constexpr size_t O_VXL = O_XC + AL((size_t)NC * 1024 * 4);
constexpr size_t O_VXC = O_VXL + AL(3ull * 8 * 512 * 4096 * 2);
constexpr size_t O_Z1L = O_VXC + AL(3ull * 8 * 512 * 256 * 2);
constexpr size_t O_Z1C = O_Z1L + AL(8ull * 512 * 4096 * 2);
constexpr size_t O_HYEND = O_Z1C + AL(8ull * 512 * 256 * 2);
constexpr size_t O_OF = O_VXL;
constexpr size_t O_OB = O_OF + (size_t)NL * 512 * 4;
static_assert(O_OB + (size_t)NL * 512 * 4 <= O_HYEND, "alias");
constexpr size_t O_FRAWL = O_HYEND;
constexpr size_t O_FRAWC = O_FRAWL + AL(4096ull * 1024 * 4);
constexpr size_t O_CSUM = O_FRAWC + AL(256ull * 1024 * 4);
constexpr int GLS = 4096 + 128, GCS = 256 + 128;
constexpr size_t O_GL = O_CSUM + AL(272ull * 1024 * 4);
constexpr size_t O_GC = O_GL + AL(2ull * 1024 * GLS * 2);
constexpr size_t O_Y5F = O_GC + AL(2ull * 1024 * GCS * 2);
constexpr size_t O_Y5B = O_Y5F + AL((size_t)NL * 512 * 2);
constexpr size_t O_Y5 = O_Y5B + AL((size_t)NL * 512 * 2);
constexpr size_t O_AFF = O_Y5 + AL((size_t)NL * 512 * 2);
constexpr size_t O_STOK = O_AFF + AL((size_t)NT * 16 * 4);
constexpr size_t O_SGATE = O_STOK + AL(16ull * 4352 * 4);
constexpr size_t O_AGP = O_SGATE + AL(16ull * 4352 * 4);
constexpr size_t O_AGS = O_AGP + AL(2ull * 544 * 512 * 4);
constexpr size_t O_HS = O_AGS + AL(2ull * 544 * 512 * 4);
constexpr size_t O_END = O_HS + AL(2ull * 544 * 512 * 4);
constexpr int SMEM_BYTES = 67584;

struct Params {
  const float* in[44];
  float* out;
  unsigned char* ws;
};

DEVI u16 f2bf(float f) { uint32_t u = __float_as_uint(f); u += 0x7fffu + ((u >> 16) & 1u); return (u16)(u >> 16); }
DEVI float bf2f(u16 h) { return __uint_as_float(((uint32_t)h) << 16); }
DEVI uint32_t pack2(float a, float b) { return (uint32_t)f2bf(a) | ((uint32_t)f2bf(b) << 16); }
DEVI float sigm(float x) { return 1.f / (1.f + __expf(-x)); }
DEVI float siluf(float x) { return x * sigm(x); }
DEVI float geluf(float x) { float u = 0.7978845608028654f * (x + 0.044715f * x * x * x); return 0.5f * x * (1.f + tanhf(u)); }
DEVI float wsum(float v) { for (int o = 32; o > 0; o >>= 1) v += __shfl_xor(v, o); return v; }

DEVI void prep_tile(const float* src, int K, int N, u16* dst, int tile_id, float* tile) {
  int tpm = (K / 64) * (N / 64);
  int mat = tile_id / tpm, t = tile_id % tpm;
  int kt = t / (N / 64), nt = t % (N / 64);
  src += (size_t)mat * K * N; dst += (size_t)mat * K * N;
  int k0 = kt * 64, n0 = nt * 64, tid = threadIdx.x;
  int r = tid >> 4, c4 = (tid & 15) * 4;
#pragma unroll
  for (int i = 0; i < 4; ++i) {
    int k = r + 16 * i;
    float4 v = *(const float4*)(src + (size_t)(k0 + k) * N + n0 + c4);
    tile[k * 65 + c4 + 0] = v.x; tile[k * 65 + c4 + 1] = v.y; tile[k * 65 + c4 + 2] = v.z; tile[k * 65 + c4 + 3] = v.w;
  }
  __syncthreads();
  int n = tid >> 3, kc = (tid & 7) * 8;
#pragma unroll
  for (int i = 0; i < 2; ++i) {
    int nn = n + 32 * i;
    uint4 o;
    o.x = pack2(tile[(kc + 0) * 65 + nn], tile[(kc + 1) * 65 + nn]);
    o.y = pack2(tile[(kc + 2) * 65 + nn], tile[(kc + 3) * 65 + nn]);
    o.z = pack2(tile[(kc + 4) * 65 + nn], tile[(kc + 5) * 65 + nn]);
    o.w = pack2(tile[(kc + 6) * 65 + nn], tile[(kc + 7) * 65 + nn]);
    *(uint4*)(dst + (size_t)(n0 + nn) * K + k0 + kc) = o;
  }
  __syncthreads();
}

DEVI void prep_experts(const Params& p, int layer, int it, float* tile) {
  u16* wexp = (u16*)(p.ws + O_WEXP);
  int kind = it / 6144, t = it % 6144;
  if (kind == 0) prep_tile(p.in[40] + (size_t)layer * EXPSZ, 1024, 1536, wexp, t, tile);
  else if (kind == 1) prep_tile(p.in[41] + (size_t)layer * EXPSZ, 1024, 1536, wexp + EXPSZ, t, tile);
  else prep_tile(p.in[42] + (size_t)layer * EXPSZ, 1536, 1024, wexp + 2 * EXPSZ, t, tile);
}

DEVI void mod_item(const Params& p, int it, float* sm) {
  int l = it / 96, j0 = (it % 96) * 64, tid = threadIdx.x;
  float* sc = sm;
  float* red = sm + 9 * 1024;
  for (int i = tid; i < 9 * 1024; i += 256) {
    int r = i >> 10, k = i & 1023;
    float v = (r < 8) ? p.in[1][r * 1024 + k] : p.in[3][k];
    sc[i] = siluf(v);
  }
  __syncthreads();
  int col = tid & 63, kq = tid >> 6;
  float acc[9];
#pragma unroll
  for (int r = 0; r < 9; ++r) acc[r] = 0.f;
  const float* w = p.in[4] + (size_t)l * 1024 * 6144 + j0 + col;
#pragma unroll 4
  for (int k = kq * 256; k < kq * 256 + 256; ++k) {
    float wv = w[(size_t)k * 6144];
#pragma unroll
    for (int r = 0; r < 9; ++r) acc[r] += sc[r * 1024 + k] * wv;
  }
#pragma unroll
  for (int r = 0; r < 9; ++r) red[(kq * 9 + r) * 64 + col] = acc[r];
  __syncthreads();
  float* mod = (float*)(p.ws + O_MOD);
  for (int i = tid; i < 9 * 64; i += 256) {
    int r = i >> 6, c = i & 63;
    float s = red[(0 * 9 + r) * 64 + c] + red[(1 * 9 + r) * 64 + c] + red[(2 * 9 + r) * 64 + c] + red[(3 * 9 + r) * 64 + c];
    mod[((size_t)l * 9 + r) * 6144 + j0 + c] = s + p.in[5][l * 6144 + j0 + c];
  }
  __syncthreads();
}

DEVI void filt_item(const Params& p, int it, float* sm) {
  int L, t0, blk; float* fraw;
  if (it < 256) { L = 4096; t0 = it * 16; blk = it; fraw = (float*)(p.ws + O_FRAWL); }
  else { L = 256; t0 = (it - 256) * 16; blk = it; fraw = (float*)(p.ws + O_FRAWC); }
  float* z = sm;
  float* h1 = sm + 16 * 33;
  float* h2 = h1 + 16 * 64;
  int tid = threadIdx.x;
  const float* w1 = p.in[19]; const float* b1 = p.in[20]; const float* w2 = p.in[21]; const float* b2 = p.in[22];
  const float* w3 = p.in[23]; const float* fr = p.in[24];
  for (int i = tid; i < 16 * 33; i += 256) {
    int pos = i / 33, c = i % 33;
    float t = (float)(t0 + pos);
    float v;
    if (c == 0) v = t / (float)(L - 1);
    else {
      int bi = (c - 1) & 15;
      float band = 1e-4f + (float)bi * ((15.f - 1e-4f) / 15.f);
      float ang = ((6.283185307179586f / (float)L) * t) * band;
      v = (c <= 16) ? cosf(ang) : -sinf(ang);
    }
    z[i] = v;
  }
  __syncthreads();
  for (int i = tid; i < 16 * 64; i += 256) {
    int pos = i >> 6, j = i & 63;
    float s = b1[j];
#pragma unroll 3
    for (int k = 0; k < 33; ++k) s += z[pos * 33 + k] * w1[k * 64 + j];
    h1[i] = sinf(fr[j] * s);
  }
  __syncthreads();
  for (int i = tid; i < 16 * 64; i += 256) {
    int pos = i >> 6, j = i & 63;
    float s = b2[j];
#pragma unroll 4
    for (int k = 0; k < 64; ++k) s += h1[pos * 64 + k] * w2[k * 64 + j];
    h2[i] = sinf(fr[j] * s);
  }
  __syncthreads();
  float* csum = (float*)(p.ws + O_CSUM);
  const float dmin = -3.0701134573253946f, dmax = -15.350567286626973f;
#pragma unroll 1
  for (int cc = 0; cc < 4; ++cc) {
    int col = tid + 256 * cc;
    float acc[16];
#pragma unroll
    for (int q = 0; q < 16; ++q) acc[q] = 0.f;
#pragma unroll 2
    for (int k = 0; k < 64; ++k) {
      float wv = w3[k * 1024 + col];
#pragma unroll
      for (int q = 0; q < 16; ++q) acc[q] += h2[q * 64 + k] * wv;
    }
    float delta = fabsf(dmin + (float)col * ((dmax - dmin) / 1023.f));
    float ss = 0.f;
#pragma unroll
    for (int q = 0; q < 16; ++q) {
      float t = (float)(t0 + q);
      float dist = fabsf(t - (float)(L / 2)) / ((float)L * 0.5f);
      float v = acc[q] * expf(-dist * delta);
      fraw[(size_t)(t0 + q) * 1024 + col] = v;
      ss += v * v;
    }
    csum[(size_t)blk * 1024 + col] = ss;
  }
  __syncthreads();
}

DEVI void filtfin_item(const Params& p, int it, float* sm) {
  int L, gs, ct, mt, nb, b0; const float* fraw; u16* G;
  if (it < 16 * 66) { L = 4096; gs = GLS; ct = it / 66; mt = it % 66; nb = 256; b0 = 0; fraw = (const float*)(p.ws + O_FRAWL); G = (u16*)(p.ws + O_GL); }
  else { int j = it - 16 * 66; L = 256; gs = GCS; ct = j / 6; mt = j % 6; nb = 16; b0 = 256; fraw = (const float*)(p.ws + O_FRAWC); G = (u16*)(p.ws + O_GC); }
  float* scale = sm;
  float* red = sm + 64;
  float* tile = sm + 64 + 256;
  int tid = threadIdx.x, c0 = ct * 64, m0 = mt * 64;
  const float* csum = (const float*)(p.ws + O_CSUM);
  {
    int c = tid & 63, q = tid >> 6;
    float s = 0.f;
    for (int b = q; b < nb; b += 4) s += csum[(size_t)(b0 + b) * 1024 + c0 + c];
    red[q * 64 + c] = s;
  }
  __syncthreads();
  if (tid < 64) scale[tid] = rsqrtf(red[tid] + red[64 + tid] + red[128 + tid] + red[192 + tid] + 1e-6f);
  int thi = L + 63 - m0;
  for (int i = tid; i < 65 * 64; i += 256) {
    int rr = i >> 6, c = i & 63;
    int t = thi - rr;
    tile[rr * 65 + c] = (t >= 0 && t < L) ? fraw[(size_t)t * 1024 + c0 + c] : 0.f;
  }
  __syncthreads();
  for (int i = tid; i < 2 * 64 * 64; i += 256) {
    int mm = i & 63, c = (i >> 6) & 63, par = i >> 12;
    G[((size_t)par * 1024 + c0 + c) * gs + m0 + mm] = f2bf(tile[(mm + par) * 65 + c] * scale[c]);
  }
  __syncthreads();
}

DEVI void ph_norm(const Params& p, int layer, int which, bool with_ctx, bool perm, bool router) {
  const float* xl = (layer == 0 && which == 1) ? p.in[0] : p.out;
  const float* xc = (layer == 0 && which == 1) ? p.in[2] : (const float*)(p.ws + O_XC);
  const float* g = p.in[which == 1 ? 6 : 7] + layer * 1024;
  const float* mod = (const float*)(p.ws + O_MOD) + (size_t)layer * 9 * 6144;
  int sh = (which == 1) ? 0 : 3;
  u16* hb = (u16*)(p.ws + O_HB);
  float* aff = (float*)(p.ws + O_AFF);
  const float* rw = p.in[39] + (size_t)layer * 1024 * 16;
  int lane = threadIdx.x & 63, wave = threadIdx.x >> 6;
  int nrows = with_ctx ? NT : NL;
  for (int r = blockIdx.x * 4 + wave; r < nrows; r += gridDim.x * 4) {
    const float* src; int mr; size_t drow;
    if (r < NL) {
      src = xl + (size_t)r * 1024; mr = r >> 12;
      if (perm) { int t = r & 4095; drow = (size_t)(r & ~4095) + (t & 63) * 64 + (t >> 6); } else drow = r;
    } else { src = xc + (size_t)(r - NL) * 1024; mr = 8; drow = r; }
    float4 v[4]; float ss = 0.f;
#pragma unroll
    for (int i = 0; i < 4; ++i) { v[i] = *(const float4*)(src + lane * 4 + 256 * i); ss += v[i].x * v[i].x + v[i].y * v[i].y + v[i].z * v[i].z + v[i].w * v[i].w; }
    ss = wsum(ss);
    float rs = rsqrtf(ss * (1.f / 1024.f) + 1e-6f);
    const float* shp = mod + (size_t)mr * 6144 + sh * 1024;
    const float* scp = shp + 1024;
    float lg[16];
    if (router) {
#pragma unroll
      for (int e = 0; e < 16; ++e) lg[e] = 0.f;
    }
#pragma unroll
    for (int i = 0; i < 4; ++i) {
      int k = lane * 4 + 256 * i;
      float4 gg = *(const float4*)(g + k), s4 = *(const float4*)(shp + k), c4 = *(const float4*)(scp + k);
      float h0 = (v[i].x * rs * gg.x) * (1.f + c4.x) + s4.x;
      float h1 = (v[i].y * rs * gg.y) * (1.f + c4.y) + s4.y;
      float h2 = (v[i].z * rs * gg.z) * (1.f + c4.z) + s4.z;
      float h3 = (v[i].w * rs * gg.w) * (1.f + c4.w) + s4.w;
      uint2 o; o.x = pack2(h0, h1); o.y = pack2(h2, h3);
      *(uint2*)(hb + drow * 1024 + k) = o;
      if (router) {
        float hh[4] = {h0, h1, h2, h3};
#pragma unroll
        for (int q = 0; q < 4; ++q) {
          const float4* wr4 = (const float4*)(rw + (size_t)(k + q) * 16);
#pragma unroll
          for (int e4 = 0; e4 < 4; ++e4) {
            float4 w = wr4[e4];
            lg[e4 * 4 + 0] += hh[q] * w.x; lg[e4 * 4 + 1] += hh[q] * w.y; lg[e4 * 4 + 2] += hh[q] * w.z; lg[e4 * 4 + 3] += hh[q] * w.w;
          }
        }
      }
    }
    if (router) {
      float mx = -1e30f;
#pragma unroll
      for (int e = 0; e < 16; ++e) { lg[e] = wsum(lg[e]); mx = fmaxf(mx, lg[e]); }
      float den = 0.f;
#pragma unroll
      for (int e = 0; e < 16; ++e) { lg[e] = expf(lg[e] - mx); den += lg[e]; }
      float inv = 1.f / den;
      float mine = 0.f;
#pragma unroll
      for (int e = 0; e < 16; ++e) if (lane == e) mine = lg[e] * inv;
      if (lane < 16) aff[(size_t)r * 16 + lane] = mine;
    }
  }
}

DEVI void gemm_core(u16* sm, const u16* (&pa)[4], const u16* (&pb)[4], int K, f32x4 (&acc)[4][4]) {
  u16* As = sm; u16* Bs = sm + 128 * 72;
  int tid = threadIdx.x, lane = tid & 63, wid = tid >> 6, wr = wid >> 1, wc = wid & 1;
  int fr = lane & 15, fq = lane >> 4;
  int lrow = tid >> 3, lkc = (tid & 7) * 8;
  u32x4 ra[4], rb[4];
#pragma unroll
  for (int i = 0; i < 4; ++i) { ra[i] = *(const u32x4*)(pa[i]); rb[i] = *(const u32x4*)(pb[i]); }
#pragma unroll
  for (int a = 0; a < 4; ++a)
#pragma unroll
    for (int b = 0; b < 4; ++b) acc[a][b] = (f32x4){0.f, 0.f, 0.f, 0.f};
  int nk = K >> 6;
  for (int kt = 0; kt < nk; ++kt) {
    __syncthreads();
#pragma unroll
    for (int i = 0; i < 4; ++i) {
      *(u32x4*)(As + (lrow + 32 * i) * 72 + lkc) = ra[i];
      *(u32x4*)(Bs + (lrow + 32 * i) * 72 + lkc) = rb[i];
    }
    __syncthreads();
    if (kt + 1 < nk) {
#pragma unroll
      for (int i = 0; i < 4; ++i) { ra[i] = *(const u32x4*)(pa[i] + (kt + 1) * 64); rb[i] = *(const u32x4*)(pb[i] + (kt + 1) * 64); }
    }
#pragma unroll
    for (int ks = 0; ks < 2; ++ks) {
      bf16x8 af[4], bfm[4];
#pragma unroll
      for (int m = 0; m < 4; ++m) af[m] = *(const bf16x8*)(As + (wr * 64 + m * 16 + fr) * 72 + ks * 32 + fq * 8);
#pragma unroll
      for (int n = 0; n < 4; ++n) bfm[n] = *(const bf16x8*)(Bs + (wc * 64 + n * 16 + fr) * 72 + ks * 32 + fq * 8);
#pragma unroll
      for (int n = 0; n < 4; ++n)
#pragma unroll
        for (int m = 0; m < 4; ++m) acc[n][m] = __builtin_amdgcn_mfma_f32_16x16x32_bf16(bfm[n], af[m], acc[n][m], 0, 0, 0);
    }
  }
  __syncthreads();
}

DEVI void ph_gemm_in(const Params& p, u16* sm, const u16* Wt, int N) {
  const u16* H = (const u16*)(p.ws + O_HB);
  u16* U = (u16*)(p.ws + O_U);
  int ntl = N / 128, nitems = 272 * ntl;
  int tid = threadIdx.x, lane = tid & 63, wid = tid >> 6, wr = wid >> 1, wc = wid & 1, fr = lane & 15, fq = lane >> 4;
  int lr = tid >> 3, kc = (tid & 7) * 8;
  for (int it = blockIdx.x; it < nitems; it += gridDim.x) {
    int m0 = (it / ntl) * 128, n0 = (it % ntl) * 128;
    const u16* pa[4]; const u16* pb[4];
#pragma unroll
    for (int i = 0; i < 4; ++i) { pa[i] = H + (size_t)(m0 + lr + 32 * i) * 1024 + kc; pb[i] = Wt + (size_t)(n0 + lr + 32 * i) * 1024 + kc; }
    f32x4 acc[4][4];
    gemm_core(sm, pa, pb, 1024, acc);
#pragma unroll
    for (int n = 0; n < 4; ++n)
#pragma unroll
      for (int m = 0; m < 4; ++m) {
        int row = m0 + wr * 64 + m * 16 + fr, col = n0 + wc * 64 + n * 16 + fq * 4;
        uint2 o; o.x = pack2(acc[n][m][0], acc[n][m][1]); o.y = pack2(acc[n][m][2], acc[n][m][3]);
        *(uint2*)(U + (size_t)row * N + col) = o;
      }
  }
}

DEVI void ph_gemm_out(const Params& p, u16* sm, int layer) {
  const u16* Y = (const u16*)(p.ws + O_HB);
  const u16* Wt = (const u16*)(p.ws + O_WOUT) + (size_t)layer * 1024 * 1024;
  const float* mod = (const float*)(p.ws + O_MOD) + (size_t)layer * 9 * 6144 + 2 * 1024;
  float* xcw = (float*)(p.ws + O_XC);
  int mtiles = (layer == 0) ? 272 : 256, nitems = mtiles * 8;
  int tid = threadIdx.x, lane = tid & 63, wid = tid >> 6, wr = wid >> 1, wc = wid & 1, fr = lane & 15, fq = lane >> 4;
  int lr = tid >> 3, kc = (tid & 7) * 8;
  for (int it = blockIdx.x; it < nitems; it += gridDim.x) {
    int m0 = (it / 8) * 128, n0 = (it % 8) * 128;
    const u16* pa[4]; const u16* pb[4];
#pragma unroll
    for (int i = 0; i < 4; ++i) { pa[i] = Y + (size_t)(m0 + lr + 32 * i) * 1024 + kc; pb[i] = Wt + (size_t)(n0 + lr + 32 * i) * 1024 + kc; }
    f32x4 acc[4][4];
    gemm_core(sm, pa, pb, 1024, acc);
#pragma unroll
    for (int m = 0; m < 4; ++m) {
      int r = m0 + wr * 64 + m * 16 + fr;
      const float* xin; float* dst; int mr;
      if (r < NL) {
        mr = r >> 12; size_t tok = r;
        if (layer == 1) { int pp = r & 4095; tok = (size_t)(r & ~4095) + (pp & 63) * 64 + (pp >> 6); }
        xin = ((layer == 0) ? p.in[0] : (const float*)p.out) + tok * 1024; dst = p.out + tok * 1024;
      } else { mr = 8; size_t cr = r - NL; xin = p.in[2] + cr * 1024; dst = xcw + cr * 1024; }
      const float* gl = mod + (size_t)mr * 6144;
#pragma unroll
      for (int n = 0; n < 4; ++n) {
        int col = n0 + wc * 64 + n * 16 + fq * 4;
        float4 xv = *(const float4*)(xin + col), gv = *(const float4*)(gl + col);
        float4 o = make_float4(xv.x + gv.x * acc[n][m][0], xv.y + gv.y * acc[n][m][1], xv.z + gv.z * acc[n][m][2], xv.w + gv.w * acc[n][m][3]);
        *(float4*)(dst + col) = o;
      }
    }
  }
}
DEVI void lru_gates(const Params& p, const float* xh, int dir, int h, int j, int tg, float (&a)[16], float (&bb)[16]) {
  float za[16], zx[16];
#pragma unroll
  for (int q = 0; q < 16; ++q) { za[q] = 0.f; zx[q] = 0.f; }
  const float* wa = p.in[12] + (size_t)((dir * 8 + h) * 64) * 64 + j;
  const float* wx = p.in[14] + (size_t)((dir * 8 + h) * 64) * 64 + j;
  for (int i = 0; i < 64; ++i) {
    float wav = wa[i * 64], wxv = wx[i * 64];
#pragma unroll
    for (int q = 0; q < 16; ++q) { float xv = xh[(tg * 16 + q) * 64 + i]; za[q] += xv * wav; zx[q] += xv * wxv; }
  }
  int gi = (dir * 8 + h) * 64 + j;
  float bav = p.in[13][gi], bxv = p.in[15][gi], lam = p.in[16][gi];
  float sp = log1pf(expf(-lam));
#pragma unroll
  for (int q = 0; q < 16; ++q) {
    float r = sigm(za[q] + bav), ig = sigm(zx[q] + bxv);
    float la = -8.f * r * sp;
    a[q] = expf(la);
    bb[q] = sqrtf(-expm1f(2.f * la)) * ig * xh[(tg * 16 + q) * 64 + j];
  }
}

DEVI void lru_item(const Params& p, int it, float* sm, int mode) {
  int ci = it >> 3, h = it & 7;
  int rowbase, t0, slen;
  if (ci < 512) { rowbase = (ci >> 6) * 4096; t0 = (ci & 63) * 64; slen = 4096; }
  else { int cc = ci - 512; rowbase = NL + (cc >> 2) * 256; t0 = (cc & 3) * 64; slen = 256; }
  const u16* U = (const u16*)(p.ws + O_U);
  float* xraw = sm;
  float* xh = sm + 67 * 64;
  float* agg = xh + 64 * 64;
  int tid = threadIdx.x, j = tid & 63, tg = tid >> 6;
  for (int i = tid; i < 67 * 64; i += 256) {
    int rr = i >> 6, c = i & 63, t = t0 - 1 + rr;
    xraw[i] = (t >= 0 && t < slen) ? bf2f(U[(size_t)(rowbase + t) * 2560 + h * 64 + c]) : 0.f;
  }
  __syncthreads();
  {
    const float* cw = p.in[10]; int ch = h * 64 + j;
    float w0 = cw[ch], w1 = cw[512 + ch], w2 = cw[1024 + ch], w3 = cw[1536 + ch], cb = p.in[11][ch];
#pragma unroll
    for (int q = 0; q < 16; ++q) {
      int t = tg * 16 + q;
      xh[t * 64 + j] = cb + w0 * xraw[t * 64 + j] + w1 * xraw[(t + 1) * 64 + j] + w2 * xraw[(t + 2) * 64 + j] + w3 * xraw[(t + 3) * 64 + j];
    }
  }
  __syncthreads();
  float af[16], bf_[16], ab[16], bk[16];
  lru_gates(p, xh, 0, h, j, tg, af, bf_);
  lru_gates(p, xh, 1, h, j, tg, ab, bk);
  {
    float P = 1.f, S = 0.f;
#pragma unroll
    for (int q = 0; q < 16; ++q) { S = af[q] * S + bf_[q]; P *= af[q]; }
    agg[((0 * 4 + tg) * 2 + 0) * 64 + j] = P; agg[((0 * 4 + tg) * 2 + 1) * 64 + j] = S;
    P = 1.f; S = 0.f;
#pragma unroll
    for (int q = 15; q >= 0; --q) { S = ab[q] * S + bk[q]; P *= ab[q]; }
    agg[((1 * 4 + tg) * 2 + 0) * 64 + j] = P; agg[((1 * 4 + tg) * 2 + 1) * 64 + j] = S;
  }
  __syncthreads();
  int ch = h * 64 + j;
  if (mode == 1) {
    if (tg == 0) {
      float* agp = (float*)(p.ws + O_AGP); float* ags = (float*)(p.ws + O_AGS);
      float P = 1.f, S = 0.f;
      for (int g = 0; g < 4; ++g) { float pg = agg[((0 * 4 + g) * 2 + 0) * 64 + j], sg = agg[((0 * 4 + g) * 2 + 1) * 64 + j]; S = pg * S + sg; P *= pg; }
      agp[((size_t)0 * 544 + ci) * 512 + ch] = P; ags[((size_t)0 * 544 + ci) * 512 + ch] = S;
      P = 1.f; S = 0.f;
      for (int g = 3; g >= 0; --g) { float pg = agg[((1 * 4 + g) * 2 + 0) * 64 + j], sg = agg[((1 * 4 + g) * 2 + 1) * 64 + j]; S = pg * S + sg; P *= pg; }
      agp[((size_t)1 * 544 + ci) * 512 + ch] = P; ags[((size_t)1 * 544 + ci) * 512 + ch] = S;
    }
  } else {
    const float* hs = (const float*)(p.ws + O_HS);
    u16* Y = (u16*)(p.ws + O_HB);
    float s = hs[((size_t)0 * 544 + ci) * 512 + ch];
    for (int g = 0; g < tg; ++g) s = agg[((0 * 4 + g) * 2 + 0) * 64 + j] * s + agg[((0 * 4 + g) * 2 + 1) * 64 + j];
    float hf[16];
#pragma unroll
    for (int q = 0; q < 16; ++q) { s = af[q] * s + bf_[q]; hf[q] = s; }
    s = hs[((size_t)1 * 544 + ci) * 512 + ch];
    for (int g = 3; g > tg; --g) s = agg[((1 * 4 + g) * 2 + 0) * 64 + j] * s + agg[((1 * 4 + g) * 2 + 1) * 64 + j];
#pragma unroll
    for (int q = 15; q >= 0; --q) {
      s = ab[q] * s + bk[q];
      size_t row = (size_t)(rowbase + t0 + tg * 16 + q);
      float xg = bf2f(U[row * 2560 + 512 + ch]);
      Y[row * 1024 + ch] = f2bf((hf[q] + s) * geluf(xg));
    }
  }
  __syncthreads();
}

DEVI void lru_combine_item(const Params& p, int it) {
  int gt = it * 256 + threadIdx.x;
  int dir = gt >> 12, b = (gt >> 9) & 7, ch = gt & 511;
  const float* agp = (const float*)(p.ws + O_AGP) + (size_t)dir * 544 * 512;
  const float* ags = (const float*)(p.ws + O_AGS) + (size_t)dir * 544 * 512;
  float* hs = (float*)(p.ws + O_HS) + (size_t)dir * 544 * 512;
  float s = 0.f;
  if (dir == 0) {
    for (int k = 0; k < 4; ++k) { size_t ci = 512 + b * 4 + k; hs[ci * 512 + ch] = s; s = agp[ci * 512 + ch] * s + ags[ci * 512 + ch]; }
    for (int k = 0; k < 64; ++k) { size_t ci = b * 64 + k; hs[ci * 512 + ch] = s; s = agp[ci * 512 + ch] * s + ags[ci * 512 + ch]; }
  } else {
    for (int k = 3; k >= 0; --k) { size_t ci = 512 + b * 4 + k; hs[ci * 512 + ch] = s; s = agp[ci * 512 + ch] * s + ags[ci * 512 + ch]; }
    for (int k = 63; k >= 0; --k) { size_t ci = b * 64 + k; hs[ci * 512 + ch] = s; s = agp[ci * 512 + ch] * s + ags[ci * 512 + ch]; }
  }
}

DEVI void hyconv_item(const Params& p, int it, float* sm) {
  int ci = it / 24, ct = it % 24;
  int rowbase, t0, slen, b; u16* dst; int L;
  if (ci < 512) { b = ci >> 6; rowbase = b * 4096; t0 = (ci & 63) * 64; slen = 4096; dst = (u16*)(p.ws + O_VXL); L = 4096; }
  else { int cc = ci - 512; b = cc >> 2; rowbase = NL + b * 256; t0 = (cc & 3) * 64; slen = 256; dst = (u16*)(p.ws + O_VXC); L = 256; }
  const u16* U = (const u16*)(p.ws + O_U);
  float* xs = sm;
  int tid = threadIdx.x, c0 = ct * 64;
  for (int i = tid; i < 66 * 64; i += 256) {
    int rr = i >> 6, c = i & 63, t = t0 - 1 + rr;
    xs[rr * 65 + c] = (t >= 0 && t < slen) ? bf2f(U[(size_t)(rowbase + t) * 2560 + 1024 + c0 + c]) : 0.f;
  }
  __syncthreads();
  int c = tid >> 2, tq = tid & 3, ch = c0 + c;
  const float* hw = p.in[17];
  float w0 = hw[ch], w1 = hw[1536 + ch], w2 = hw[3072 + ch], cb = p.in[18][ch];
  int which = ch >> 9, cc = ch & 511;
  uint32_t o[8];
#pragma unroll
  for (int q = 0; q < 8; ++q) {
    int tl = tq * 16 + 2 * q;
    float y0 = cb + w0 * xs[tl * 65 + c] + w1 * xs[(tl + 1) * 65 + c] + w2 * xs[(tl + 2) * 65 + c];
    float y1 = cb + w0 * xs[(tl + 1) * 65 + c] + w1 * xs[(tl + 2) * 65 + c] + w2 * xs[(tl + 3) * 65 + c];
    o[q] = pack2(y0, y1);
  }
  u16* d = dst + ((size_t)(which * 8 + b) * 512 + cc) * L + t0 + tq * 16;
  *(uint4*)d = make_uint4(o[0], o[1], o[2], o[3]);
  *(uint4*)(d + 8) = make_uint4(o[4], o[5], o[6], o[7]);
  __syncthreads();
}

DEVI void toep_item(const Params& p, int it, u16* Xs, int order) {
  int c, half, L, gs; const u16* G; const u16* vx; const u16* z1; u16* z1w;
  if (it < 1024) { c = it >> 1; half = it & 1; L = 4096; gs = GLS; G = (const u16*)(p.ws + O_GL); vx = (const u16*)(p.ws + O_VXL); z1 = (const u16*)(p.ws + O_Z1L); z1w = (u16*)(p.ws + O_Z1L); }
  else { c = it - 1024; half = 0; L = 256; gs = GCS; G = (const u16*)(p.ws + O_GC); vx = (const u16*)(p.ws + O_VXC); z1 = (const u16*)(p.ws + O_Z1C); z1w = (u16*)(p.ws + O_Z1C); }
  int T1 = L >> 6, ntiles = T1 >> 1, XS = L + 8;
  int tid = threadIdx.x, lane = tid & 63, w = tid >> 6, fr = lane & 15, fq = lane >> 4;
  const u16* xsrc = (order == 0) ? vx : z1;
  int l8 = L >> 3;
  for (int i = tid; i < 8 * l8; i += 256) {
    int b = i / l8, k8 = i % l8;
    *(uint4*)(Xs + b * XS + k8 * 8) = *(const uint4*)(xsrc + ((size_t)b * 512 + c) * L + k8 * 8);
  }
  __syncthreads();
  f32x4 acc[4][4];
#pragma unroll
  for (int a = 0; a < 4; ++a)
#pragma unroll
    for (int b = 0; b < 4; ++b) acc[a][b] = (f32x4){0.f, 0.f, 0.f, 0.f};
  const u16* Gp = G + (size_t)(order * 512 + c) * gs;
  size_t parstride = (size_t)1024 * gs;
  int bq = fr & 7, t1off = fr >> 3;
  int dmax = L >> 7;
  for (int d = -dmax; d <= dmax; ++d) {
    bf16x8 afr[4][2];
#pragma unroll
    for (int m = 0; m < 4; ++m)
#pragma unroll
      for (int ks = 0; ks < 2; ++ks) {
        int i0 = (L >> 1) + 63 - 64 * d - 16 * m - fr + 32 * ks + 8 * fq;
        int par = i0 & 1;
        const uint32_t* src = (const uint32_t*)(Gp + par * parstride + (i0 - par));
        uint32_t t4[4];
        __builtin_memcpy(t4, src, 16);
        __builtin_memcpy(&afr[m][ks], t4, 16);
      }
#pragma unroll
    for (int n = 0; n < 4; ++n) {
      int Tn = half * 16 + w * 4 + n;
      int s1 = 2 * Tn + t1off - d;
      bool valid = (Tn < ntiles) && (s1 >= 0) && (s1 < T1);
      int s1c = valid ? s1 : 0;
#pragma unroll
      for (int ks = 0; ks < 2; ++ks) {
        bf16x8 bfrag = *(const bf16x8*)(Xs + bq * XS + s1c * 64 + 32 * ks + 8 * fq);
        if (!valid) bfrag = (bf16x8){0, 0, 0, 0, 0, 0, 0, 0};
#pragma unroll
        for (int m = 0; m < 4; ++m) acc[n][m] = __builtin_amdgcn_mfma_f32_16x16x32_bf16(afr[m][ks], bfrag, acc[n][m], 0, 0, 0);
      }
    }
  }
  float skip = p.in[25][order * 512 + c];
  u16* Y = (u16*)(p.ws + O_HB);
#pragma unroll
  for (int n = 0; n < 4; ++n) {
    int Tn = half * 16 + w * 4 + n;
    if (Tn < ntiles) {
      int t1 = 2 * Tn + t1off;
#pragma unroll
      for (int m = 0; m < 4; ++m) {
        int t = 64 * t1 + 16 * m + 4 * fq;
        uint2 xin = *(const uint2*)(Xs + bq * XS + t);
        uint2 xm = *(const uint2*)(vx + ((size_t)((order + 1) * 8 + bq) * 512 + c) * L + t);
        float u0 = bf2f((u16)(xin.x & 0xffff)), u1 = bf2f((u16)(xin.x >> 16)), u2 = bf2f((u16)(xin.y & 0xffff)), u3 = bf2f((u16)(xin.y >> 16));
        float m0 = bf2f((u16)(xm.x & 0xffff)), m1 = bf2f((u16)(xm.x >> 16)), m2 = bf2f((u16)(xm.y & 0xffff)), m3 = bf2f((u16)(xm.y >> 16));
        float r0 = m0 * (acc[n][m][0] + skip * u0), r1 = m1 * (acc[n][m][1] + skip * u1);
        float r2 = m2 * (acc[n][m][2] + skip * u2), r3 = m3 * (acc[n][m][3] + skip * u3);
        if (order == 0) {
          uint2 o; o.x = pack2(r0, r1); o.y = pack2(r2, r3);
          *(uint2*)(z1w + ((size_t)bq * 512 + c) * L + t) = o;
        } else {
          size_t row = (L == 4096) ? ((size_t)bq * 4096 + t) : ((size_t)NL + bq * 256 + t);
          Y[(row + 0) * 1024 + 512 + c] = f2bf(r0); Y[(row + 1) * 1024 + 512 + c] = f2bf(r1);
          Y[(row + 2) * 1024 + 512 + c] = f2bf(r2); Y[(row + 3) * 1024 + 512 + c] = f2bf(r3);
        }
      }
    }
  }
  __syncthreads();
}

DEVI int blk_count(int c, int* cnts, int& flip) {
  for (int o = 32; o > 0; o >>= 1) c += __shfl_xor(c, o);
  int* s = cnts + (flip & 1) * 4;
  if ((threadIdx.x & 63) == 0) s[threadIdx.x >> 6] = c;
  __syncthreads();
  int tot = s[0] + s[1] + s[2] + s[3];
  flip ^= 1;
  return tot;
}

DEVI void topk_item(const Params& p, int it, int* smi) {
  int e = it & 15, seq = it >> 4;
  int n, cap, rowbase, slotbase, ept;
  if (seq < 8) { n = 4096; cap = 512; rowbase = seq * 4096; slotbase = seq * 512; ept = 16; }
  else { int b = seq - 8; n = 256; cap = 32; rowbase = NL + b * 256; slotbase = 4096 + b * 32; ept = 1; }
  const float* aff = (const float*)(p.ws + O_AFF);
  int* stok = (int*)(p.ws + O_STOK) + e * 4352 + slotbase;
  float* sgate = (float*)(p.ws + O_SGATE) + e * 4352 + slotbase;
  int* cnts = smi;
  int* wt = smi + 8;
  int tid = threadIdx.x, flip = 0;
  uint32_t v[16];
#pragma unroll
  for (int j = 0; j < 16; ++j) v[j] = (j < ept) ? __float_as_uint(aff[(size_t)(rowbase + tid * ept + j) * 16 + e]) : 0u;
  uint32_t T = 0;
  for (int bit = 30; bit >= 0; --bit) {
    uint32_t cand = T | (1u << bit);
    int c = 0;
#pragma unroll
    for (int j = 0; j < 16; ++j) c += (j < ept && v[j] >= cand) ? 1 : 0;
    int tot = blk_count(c, cnts, flip);
    if (tot >= cap) T = cand;
  }
  int ngt = 0, neq = 0;
#pragma unroll
  for (int j = 0; j < 16; ++j) { if (j < ept) { ngt += (v[j] > T) ? 1 : 0; neq += (v[j] == T) ? 1 : 0; } }
  int cnt_gt = blk_count(ngt, cnts, flip);
  int need_eq = cap - cnt_gt;
  int comb = ngt | (neq << 16);
  int inc = comb;
  int lane = tid & 63, wv = tid >> 6;
  for (int o = 1; o < 64; o <<= 1) { int t = __shfl_up(inc, o); if (lane >= o) inc += t; }
  __syncthreads();
  if (lane == 63) wt[wv] = inc;
  __syncthreads();
  int pre = 0;
  for (int q = 0; q < wv; ++q) pre += wt[q];
  int ex = pre + inc - comb;
  int pg = ex & 0xffff, pe = ex >> 16;
#pragma unroll
  for (int j = 0; j < 16; ++j) {
    if (j < ept) {
      int slot = -1;
      if (v[j] > T) slot = pg++;
      else if (v[j] == T) { if (pe < need_eq) slot = cnt_gt + pe; pe++; }
      if (slot >= 0) { stok[slot] = rowbase + tid * ept + j; sgate[slot] = __uint_as_float(v[j]); }
    }
  }
  __syncthreads();
}

DEVI void ph_moe_up(const Params& p, u16* sm, int mtl) {
  const u16* Hn = (const u16*)(p.ws + O_HB);
  const u16* Wg = (const u16*)(p.ws + O_WEXP);
  const u16* Wu = Wg + EXPSZ;
  u16* Act = (u16*)(p.ws + O_U);
  const int* stok = (const int*)(p.ws + O_STOK);
  int nitems = 16 * 24 * mtl;
  int tid = threadIdx.x, lane = tid & 63, wid = tid >> 6, wr = wid >> 1, wc = wid & 1, fr = lane & 15, fq = lane >> 4;
  int lr = tid >> 3, kc = (tid & 7) * 8;
  for (int it = blockIdx.x; it < nitems; it += gridDim.x) {
    int e = it / (24 * mtl), rem = it % (24 * mtl);
    int f0 = (rem / mtl) * 64, m0 = (rem % mtl) * 128;
    const u16* pa[4]; const u16* pb[4];
#pragma unroll
    for (int i = 0; i < 4; ++i) {
      int tok = stok[e * 4352 + m0 + lr + 32 * i];
      pa[i] = Hn + (size_t)tok * 1024 + kc;
      int r = lr + 32 * i, wcc = r >> 6, rr = r & 63;
      const u16* base = (rr < 32) ? Wg : Wu;
      pb[i] = base + ((size_t)e * 1536 + f0 + wcc * 32 + (rr & 31)) * 1024 + kc;
    }
    f32x4 acc[4][4];
    gemm_core(sm, pa, pb, 1024, acc);
#pragma unroll
    for (int m = 0; m < 4; ++m) {
      int slot = m0 + wr * 64 + m * 16 + fr;
#pragma unroll
      for (int n = 0; n < 2; ++n) {
        int f = f0 + wc * 32 + n * 16 + fq * 4;
        float v0 = siluf(acc[n][m][0]) * acc[n + 2][m][0], v1 = siluf(acc[n][m][1]) * acc[n + 2][m][1];
        float v2 = siluf(acc[n][m][2]) * acc[n + 2][m][2], v3 = siluf(acc[n][m][3]) * acc[n + 2][m][3];
        uint2 o; o.x = pack2(v0, v1); o.y = pack2(v2, v3);
        *(uint2*)(Act + ((size_t)e * 4352 + slot) * 1536 + f) = o;
      }
    }
  }
}

DEVI void ph_moe_down(const Params& p, u16* sm, int layer, int mtl) {
  const u16* Act = (const u16*)(p.ws + O_U);
  const u16* Wd = (const u16*)(p.ws + O_WEXP) + 2 * EXPSZ;
  const int* stok = (const int*)(p.ws + O_STOK);
  const float* sgate = (const float*)(p.ws + O_SGATE);
  const float* mod = (const float*)(p.ws + O_MOD) + (size_t)layer * 9 * 6144 + 5 * 1024;
  float* xcw = (float*)(p.ws + O_XC);
  int nitems = 16 * 8 * mtl;
  int tid = threadIdx.x, lane = tid & 63, wid = tid >> 6, wr = wid >> 1, wc = wid & 1, fr = lane & 15, fq = lane >> 4;
  int lr = tid >> 3, kc = (tid & 7) * 8;
  for (int it = blockIdx.x; it < nitems; it += gridDim.x) {
    int e = it / (8 * mtl), rem = it % (8 * mtl);
    int n0 = (rem / mtl) * 128, m0 = (rem % mtl) * 128;
    const u16* pa[4]; const u16* pb[4];
#pragma unroll
    for (int i = 0; i < 4; ++i) {
      pa[i] = Act + ((size_t)e * 4352 + m0 + lr + 32 * i) * 1536 + kc;
      pb[i] = Wd + ((size_t)e * 1024 + n0 + lr + 32 * i) * 1536 + kc;
    }
    f32x4 acc[4][4];
    gemm_core(sm, pa, pb, 1536, acc);
#pragma unroll
    for (int m = 0; m < 4; ++m) {
      int slot = m0 + wr * 64 + m * 16 + fr;
      int tok = stok[e * 4352 + slot];
      float gt = sgate[e * 4352 + slot];
      float* dst; int mr;
      if (tok < NL) { mr = tok >> 12; dst = p.out + (size_t)tok * 1024; } else { mr = 8; dst = xcw + (size_t)(tok - NL) * 1024; }
      const float* gl = mod + (size_t)mr * 6144;
#pragma unroll
      for (int n = 0; n < 4; ++n) {
        int col = n0 + wc * 64 + n * 16 + fq * 4;
        float4 gv = *(const float4*)(gl + col);
        unsafeAtomicAdd(dst + col + 0, acc[n][m][0] * gt * gv.x);
        unsafeAtomicAdd(dst + col + 1, acc[n][m][1] * gt * gv.y);
        unsafeAtomicAdd(dst + col + 2, acc[n][m][2] * gt * gv.z);
        unsafeAtomicAdd(dst + col + 3, acc[n][m][3] * gt * gv.w);
      }
    }
  }
}

DEVI void ph_final(const Params& p) {
  int lane = threadIdx.x & 63, wave = threadIdx.x >> 6;
  const float* g = p.in[43];
  for (int r = blockIdx.x * 4 + wave; r < NL; r += gridDim.x * 4) {
    float* row = p.out + (size_t)r * 1024;
    float4 v[4]; float ss = 0.f;
#pragma unroll
    for (int i = 0; i < 4; ++i) { v[i] = *(const float4*)(row + lane * 4 + 256 * i); ss += v[i].x * v[i].x + v[i].y * v[i].y + v[i].z * v[i].z + v[i].w * v[i].w; }
    ss = wsum(ss);
    float rs = rsqrtf(ss * (1.f / 1024.f) + 1e-6f);
#pragma unroll
    for (int i = 0; i < 4; ++i) {
      float4 gg = *(const float4*)(g + lane * 4 + 256 * i);
      *(float4*)(row + lane * 4 + 256 * i) = make_float4(v[i].x * rs * gg.x, v[i].y * rs * gg.y, v[i].z * rs * gg.z, v[i].w * rs * gg.w);
    }
  }
}
DEVI void wave_lds_sync() { __builtin_amdgcn_fence(__ATOMIC_RELEASE, "wavefront"); __builtin_amdgcn_wave_barrier(); __builtin_amdgcn_fence(__ATOMIC_ACQUIRE, "wavefront"); }

DEVI size_t seq_row(int s, int b, int dir) {
  if (s < 256) return (size_t)NL + b * 256 + (dir ? 255 - s : s);
  int q = s - 256;
  return (size_t)b * 4096 + (dir ? 4095 - q : q);
}

DEVI void hgrn_wave(const Params& p, int wi, float* wsm) {
  int eg = wi & 15, dir = (wi >> 4) & 1, h = (wi >> 5) & 3, b = wi >> 7;
  int lane = threadIdx.x & 63, dq = lane >> 3, el = lane & 7, e = eg * 8 + el;
  const u16* U = (const u16*)(p.ws + O_U);
  float* O = (float*)(p.ws + (dir ? O_OB : O_OF));
  float* fbuf = wsm;
  float* qbuf = wsm + 8 * 128;
  float lb2[2];
#pragma unroll
  for (int q = 0; q < 2; ++q) {
    int ch = h * 128 + lane * 2 + q;
    float l0 = p.in[27][ch], l1 = p.in[27][512 + ch];
    float mx = fmaxf(l0, l1), e0 = expf(l0 - mx), e1 = expf(l1 - mx);
    float p1 = e1 / (e0 + e1);
    lb2[q] = fminf(fmaxf(p1, 0.f), 1.f - 1e-4f);
  }
  float S[16];
#pragma unroll
  for (int q = 0; q < 16; ++q) S[q] = 0.f;
  for (int s0 = 0; s0 < 4352; s0 += 8) {
    bool lat = s0 >= 256;
    float vv[8];
#pragma unroll
    for (int s8 = 0; s8 < 8; ++s8) {
      size_t row = seq_row(s0 + s8, b, dir);
      const u16* ur = U + row * 3072;
      uint32_t fp2 = *(const uint32_t*)(ur + dir * 512 + h * 128 + lane * 2);
      float f0 = lb2[0] + (1.f - lb2[0]) * sigm(bf2f((u16)(fp2 & 0xffff)));
      float f1 = lb2[1] + (1.f - lb2[1]) * sigm(bf2f((u16)(fp2 >> 16)));
      *(float2*)(fbuf + s8 * 128 + lane * 2) = make_float2(f0, f1);
      if (lat) {
        uint32_t q2 = *(const uint32_t*)(ur + 2048 + h * 128 + lane * 2);
        *(float2*)(qbuf + s8 * 128 + lane * 2) = make_float2(siluf(bf2f((u16)(q2 & 0xffff))), siluf(bf2f((u16)(q2 >> 16))));
      }
      vv[s8] = bf2f(ur[1024 + h * 128 + e]);
    }
    wave_lds_sync();
#pragma unroll
    for (int s8 = 0; s8 < 8; ++s8) {
      float o = 0.f;
#pragma unroll
      for (int c4 = 0; c4 < 4; ++c4) {
        float4 f4 = *(const float4*)(fbuf + s8 * 128 + dq * 16 + c4 * 4);
        float ff[4] = {f4.x, f4.y, f4.z, f4.w};
        float qq[4] = {0.f, 0.f, 0.f, 0.f};
        if (lat) { float4 q4 = *(const float4*)(qbuf + s8 * 128 + dq * 16 + c4 * 4); qq[0] = q4.x; qq[1] = q4.y; qq[2] = q4.z; qq[3] = q4.w; }
#pragma unroll
        for (int k = 0; k < 4; ++k) {
          float sv = ff[k] * S[c4 * 4 + k] + (1.f - ff[k]) * vv[s8];
          S[c4 * 4 + k] = sv;
          o += sv * qq[k];
        }
      }
      if (lat) {
        o += __shfl_xor(o, 8); o += __shfl_xor(o, 16); o += __shfl_xor(o, 32);
        if (dq == 0) O[seq_row(s0 + s8, b, dir) * 512 + h * 128 + e] = o;
      }
    }
    wave_lds_sync();
  }
}

DEVI void s5_wave(const Params& p, int wi, float* wsm) {
  int dir = wi & 1, g = (wi >> 1) & 31, b = wi >> 6;
  int lane = threadIdx.x & 63;
  const u16* U = (const u16*)(p.ws + O_U);
  u16* Yo = (u16*)(p.ws + (dir ? O_Y5B : O_Y5F));
  float* Cre = wsm;
  float* Cim = wsm + 1024;
  float* Hre = wsm + 2048;
  float* Him = Hre + 8 * 68;
  for (int i = lane; i < 1024; i += 64) { Cre[i] = p.in[34][(size_t)g * 1024 + i]; Cim[i] = p.in[35][(size_t)g * 1024 + i]; }
  float lre = fminf(p.in[29][(dir * 32 + g) * 64 + lane], -1e-4f), lim = p.in[30][(dir * 32 + g) * 64 + lane];
  float dt = expf(p.in[31][dir * 32 + g]);
  float mag = expf(lre * dt), lbr = mag * cosf(lim * dt), lbi = mag * sinf(lim * dt);
  float xr = lbr - 1.f, xi = lbi, den = 1.f / (lre * lre + lim * lim);
  float cr = (xr * lre + xi * lim) * den, ci = (xi * lre - xr * lim) * den;
  float Br[16], Bi[16];
#pragma unroll
  for (int q = 0; q < 16; ++q) {
    float br = p.in[32][((size_t)g * 64 + lane) * 16 + q], bi = p.in[33][((size_t)g * 64 + lane) * 16 + q];
    Br[q] = cr * br - ci * bi; Bi[q] = cr * bi + ci * br;
  }
  float hr = 0.f, hi = 0.f;
  wave_lds_sync();
  for (int s0 = 0; s0 < 4352; s0 += 8) {
    bool lat = s0 >= 256;
#pragma unroll
    for (int s8 = 0; s8 < 8; ++s8) {
      size_t row = seq_row(s0 + s8, b, dir);
      const uint4* up = (const uint4*)(U + row * 3072 + 1536 + g * 16);
      uint4 u0 = up[0], u1 = up[1];
      uint32_t uw[8] = {u0.x, u0.y, u0.z, u0.w, u1.x, u1.y, u1.z, u1.w};
      float bur = 0.f, bui = 0.f;
#pragma unroll
      for (int q = 0; q < 8; ++q) {
        float a0 = bf2f((u16)(uw[q] & 0xffff)), a1 = bf2f((u16)(uw[q] >> 16));
        bur += Br[2 * q] * a0 + Br[2 * q + 1] * a1; bui += Bi[2 * q] * a0 + Bi[2 * q + 1] * a1;
      }
      float nr = lbr * hr - lbi * hi + bur, ni = lbr * hi + lbi * hr + bui;
      hr = nr; hi = ni;
      if (lat) { Hre[s8 * 68 + lane] = hr; Him[s8 * 68 + lane] = hi; }
    }
    if (lat) {
      wave_lds_sync();
      int s8 = lane >> 3, hp = lane & 7;
      float y0 = 0.f, y1 = 0.f;
#pragma unroll
      for (int p4 = 0; p4 < 16; ++p4) {
        float4 a = *(const float4*)(Hre + s8 * 68 + p4 * 4), bq = *(const float4*)(Him + s8 * 68 + p4 * 4);
        float4 c0 = *(const float4*)(Cre + (hp * 2) * 64 + p4 * 4), d0 = *(const float4*)(Cim + (hp * 2) * 64 + p4 * 4);
        float4 c1 = *(const float4*)(Cre + (hp * 2 + 1) * 64 + p4 * 4), d1 = *(const float4*)(Cim + (hp * 2 + 1) * 64 + p4 * 4);
        y0 += a.x * c0.x - bq.x * d0.x + a.y * c0.y - bq.y * d0.y + a.z * c0.z - bq.z * d0.z + a.w * c0.w - bq.w * d0.w;
        y1 += a.x * c1.x - bq.x * d1.x + a.y * c1.y - bq.y * d1.y + a.z * c1.z - bq.z * d1.z + a.w * c1.w - bq.w * d1.w;
      }
      size_t row = seq_row(s0 + s8, b, dir);
      *(uint32_t*)(Yo + row * 512 + g * 16 + hp * 2) = pack2(y0, y1);
      wave_lds_sync();
    }
  }
}

DEVI void ph_l1_finalize(const Params& p) {
  int lane = threadIdx.x & 63, wave = threadIdx.x >> 6;
  const u16* U = (const u16*)(p.ws + O_U);
  const float* Of = (const float*)(p.ws + O_OF); const float* Ob = (const float*)(p.ws + O_OB);
  const u16* Yf = (const u16*)(p.ws + O_Y5F); const u16* Yb = (const u16*)(p.ws + O_Y5B);
  u16* Y5 = (u16*)(p.ws + O_Y5); u16* Ym = (u16*)(p.ws + O_HB);
  int ch = lane * 8;
  for (int r = blockIdx.x * 4 + wave; r < NL; r += gridDim.x * 4) {
    size_t ro = (size_t)r;
    float o[8];
    {
      float4 a0 = *(const float4*)(Of + ro * 512 + ch), a1 = *(const float4*)(Of + ro * 512 + ch + 4);
      float4 b0 = *(const float4*)(Ob + ro * 512 + ch), b1 = *(const float4*)(Ob + ro * 512 + ch + 4);
      o[0] = a0.x + b0.x; o[1] = a0.y + b0.y; o[2] = a0.z + b0.z; o[3] = a0.w + b0.w;
      o[4] = a1.x + b1.x; o[5] = a1.y + b1.y; o[6] = a1.z + b1.z; o[7] = a1.w + b1.w;
    }
    float ss = 0.f;
#pragma unroll
    for (int q = 0; q < 8; ++q) ss += o[q] * o[q];
    ss += __shfl_xor(ss, 1); ss += __shfl_xor(ss, 2); ss += __shfl_xor(ss, 4); ss += __shfl_xor(ss, 8);
    float rs = rsqrtf(ss * (1.f / 128.f) + 1e-6f);
    uint4 gq = *(const uint4*)(U + ro * 3072 + 2560 + ch);
    uint32_t gw[4] = {gq.x, gq.y, gq.z, gq.w};
    uint32_t ow[4];
#pragma unroll
    for (int q = 0; q < 4; ++q) {
      int ee = (ch & 127) + 2 * q;
      float g0 = bf2f((u16)(gw[q] & 0xffff)), g1 = bf2f((u16)(gw[q] >> 16));
      ow[q] = pack2(o[2 * q] * rs * p.in[28][ee] * siluf(g0), o[2 * q + 1] * rs * p.in[28][ee + 1] * siluf(g1));
    }
    *(uint4*)(Ym + ro * 1024 + ch) = make_uint4(ow[0], ow[1], ow[2], ow[3]);
    uint4 yf = *(const uint4*)(Yf + ro * 512 + ch), yb = *(const uint4*)(Yb + ro * 512 + ch), uu = *(const uint4*)(U + ro * 3072 + 1536 + ch);
    uint32_t fw[4] = {yf.x, yf.y, yf.z, yf.w}, bw[4] = {yb.x, yb.y, yb.z, yb.w}, uw[4] = {uu.x, uu.y, uu.z, uu.w};
#pragma unroll
    for (int q = 0; q < 4; ++q) {
      float d0 = p.in[36][ch + 2 * q], d1 = p.in[36][ch + 2 * q + 1];
      float y0 = bf2f((u16)(fw[q] & 0xffff)) + bf2f((u16)(bw[q] & 0xffff)) + bf2f((u16)(uw[q] & 0xffff)) * d0;
      float y1 = bf2f((u16)(fw[q] >> 16)) + bf2f((u16)(bw[q] >> 16)) + bf2f((u16)(uw[q] >> 16)) * d1;
      ow[q] = pack2(geluf(y0), geluf(y1));
    }
    *(uint4*)(Y5 + ro * 512 + ch) = make_uint4(ow[0], ow[1], ow[2], ow[3]);
  }
}

DEVI void ph_gemm_glu(const Params& p, u16* sm) {
  const u16* Y5 = (const u16*)(p.ws + O_Y5);
  const u16* Wt = (const u16*)(p.ws + O_WGLU);
  u16* Ym = (u16*)(p.ws + O_HB);
  int nitems = 256 * 4;
  int tid = threadIdx.x, lane = tid & 63, wid = tid >> 6, wr = wid >> 1, wc = wid & 1, fr = lane & 15, fq = lane >> 4;
  int lr = tid >> 3, kc = (tid & 7) * 8;
  for (int it = blockIdx.x; it < nitems; it += gridDim.x) {
    int m0 = (it / 4) * 128, n0 = (it % 4) * 128;
    const u16* pa[4]; const u16* pb[4];
#pragma unroll
    for (int i = 0; i < 4; ++i) { pa[i] = Y5 + (size_t)(m0 + lr + 32 * i) * 512 + kc; pb[i] = Wt + (size_t)(n0 + lr + 32 * i) * 512 + kc; }
    f32x4 acc[4][4];
    gemm_core(sm, pa, pb, 512, acc);
#pragma unroll
    for (int m = 0; m < 4; ++m) {
      size_t r = m0 + wr * 64 + m * 16 + fr;
#pragma unroll
      for (int n = 0; n < 4; ++n) {
        int col = n0 + wc * 64 + n * 16 + fq * 4;
        uint2 yv = *(const uint2*)(Y5 + r * 512 + col);
        float4 bv = *(const float4*)(p.in[38] + col);
        float y0 = bf2f((u16)(yv.x & 0xffff)), y1 = bf2f((u16)(yv.x >> 16)), y2 = bf2f((u16)(yv.y & 0xffff)), y3 = bf2f((u16)(yv.y >> 16));
        uint2 o;
        o.x = pack2(y0 * sigm(acc[n][m][0] + bv.x), y1 * sigm(acc[n][m][1] + bv.y));
        o.y = pack2(y2 * sigm(acc[n][m][2] + bv.z), y3 * sigm(acc[n][m][3] + bv.w));
        *(uint2*)(Ym + r * 1024 + 512 + col) = o;
      }
    }
  }
}

DEVI void run_phase(const Params& p, int ph, unsigned char* smem) {
  float* smf = (float*)smem; u16* smh = (u16*)smem;
  int bid = blockIdx.x, nb = gridDim.x;
#ifdef ONLY_PHASE
  if (ph != ONLY_PHASE) return;
  ph = ONLY_PHASE;
#endif
  switch (ph) {
    case 0: {
      int total = 192 + 272 + 1984 + 18432;
      for (int it = bid; it < total; it += nb) {
        if (it < 192) mod_item(p, it, smf);
        else if (it < 464) filt_item(p, it - 192, smf);
        else if (it < 464 + 1984) {
          int t = it - 464;
          if (t < 640) prep_tile(p.in[9], 1024, 2560, (u16*)(p.ws + O_WIN0), t, smf);
          else if (t < 1408) prep_tile(p.in[26], 1024, 3072, (u16*)(p.ws + O_WIN1), t - 640, smf);
          else if (t < 1920) prep_tile(p.in[8], 1024, 1024, (u16*)(p.ws + O_WOUT), t - 1408, smf);
          else prep_tile(p.in[37], 512, 512, (u16*)(p.ws + O_WGLU), t - 1920, smf);
        } else prep_experts(p, 0, it - 2448, smf);
      }
    } break;
    case 1: {
      for (int it = bid; it < 1152; it += nb) filtfin_item(p, it, smf);
      ph_norm(p, 0, 1, true, false, false);
    } break;
    case 2: ph_gemm_in(p, smh, (const u16*)(p.ws + O_WIN0), 2560); break;
    case 3: {
      int total = 4352 + 13056;
      for (int it = bid; it < total; it += nb) { if (it < 4352) lru_item(p, it, smf, 1); else hyconv_item(p, it - 4352, smf); }
    } break;
    case 4: {
      int total = 32 + 1536;
      for (int it = bid; it < total; it += nb) { if (it < 32) lru_combine_item(p, it); else toep_item(p, it - 32, smh, 0); }
    } break;
    case 5: {
      int total = 4352 + 1536;
      for (int it = bid; it < total; it += nb) { if (it < 1536) toep_item(p, it, smh, 1); else lru_item(p, it - 1536, smf, 3); }
    } break;
    case 6: ph_gemm_out(p, smh, 0); break;
    case 7: ph_norm(p, 0, 2, true, false, true); break;
    case 8: for (int it = bid; it < 256; it += nb) topk_item(p, it, (int*)smem); break;
    case 9: ph_moe_up(p, smh, 34); break;
    case 10: ph_moe_down(p, smh, 0, 34); break;
    case 11: {
      for (int it = bid; it < 18432; it += nb) prep_experts(p, 1, it, smf);
      ph_norm(p, 1, 1, true, true, false);
    } break;
    case 12: ph_gemm_in(p, smh, (const u16*)(p.ws + O_WIN1), 3072); break;
    case 13: {
      int wave = threadIdx.x >> 6;
      float* wsm = smf + wave * 4096;
      for (int it = bid; it < 384; it += nb) {
        int wi = it * 4 + wave;
        if (wi < 1024) hgrn_wave(p, wi, wsm); else s5_wave(p, wi - 1024, wsm);
      }
    } break;
    case 14: ph_l1_finalize(p); break;
    case 15: ph_gemm_glu(p, smh); break;
    case 16: ph_gemm_out(p, smh, 1); break;
    case 17: ph_norm(p, 1, 2, false, false, true); break;
    case 18: for (int it = bid; it < 128; it += nb) topk_item(p, it, (int*)smem); break;
    case 19: ph_moe_up(p, smh, 32); break;
    case 20: ph_moe_down(p, smh, 1, 32); break;
    case 21: ph_final(p); break;
  }
}

__global__ void __launch_bounds__(256, 2) mega(Params p, int ph_lo, int ph_hi) {
  extern __shared__ __attribute__((aligned(16))) unsigned char smem[];
  cg::grid_group grid = cg::this_grid();
#define PHC(N) if (ph_lo <= N && N <= ph_hi) { if (N > ph_lo) grid.sync(); run_phase(p, N, smem); }
  PHC(0) PHC(1) PHC(2) PHC(3) PHC(4) PHC(5) PHC(6) PHC(7) PHC(8) PHC(9) PHC(10) PHC(11)
  PHC(12) PHC(13) PHC(14) PHC(15) PHC(16) PHC(17) PHC(18) PHC(19) PHC(20) PHC(21)
#undef PHC
}

extern "C" void kernel_launch(void* const* d_in, const int* in_sizes, int n_in, void* d_out, int out_size,
                              void* d_ws, size_t ws_size, hipStream_t stream) {
  static int grid_blocks = 0;
  if (!grid_blocks) {
    int dev = 0, cus = 0, per_cu = 0;
    (void)hipGetDevice(&dev);
    (void)hipDeviceGetAttribute(&cus, hipDeviceAttributeMultiprocessorCount, dev);
    (void)hipFuncSetAttribute((const void*)mega, hipFuncAttributeMaxDynamicSharedMemorySize, SMEM_BYTES);
    (void)hipOccupancyMaxActiveBlocksPerMultiprocessor(&per_cu, mega, 256, SMEM_BYTES);
    if (per_cu > 2) per_cu = 2;
    if (per_cu < 1) per_cu = 1;
    grid_blocks = cus * per_cu;
  }
  Params p{};
  for (int i = 0; i < 44; ++i) p.in[i] = (const float*)d_in[i];
  p.out = (float*)d_out; p.ws = (unsigned char*)d_ws;
  int lo = 0, hi = 21;
  void* args[] = {&p, &lo, &hi};
  hipError_t e = hipLaunchCooperativeKernel((void*)mega, dim3(grid_blocks), dim3(256), args, SMEM_BYTES, stream);
  if (e != hipSuccess) fprintf(stderr, "cooperative launch failed: %s (grid %d)\n", hipGetErrorString(e), grid_blocks);
}
```

```cpp
#include <hip/hip_runtime.h>
#include <hip/hip_bf16.h>
#include <hip/hip_cooperative_groups.h>
#include <cstdio>
#include <cstdint>
namespace cg = cooperative_groups;

typedef unsigned short u16;
using bf16x8 = __attribute__((ext_vector_type(8))) short;
using f32x4 = __attribute__((ext_vector_type(4))) float;
using u32x4 = __attribute__((ext_vector_type(4))) uint32_t;
#define DEVI __device__ __forceinline__
__device__ __forceinline__ int tid_opaque() { int t = threadIdx.x; asm volatile("" : "+v"(t)); return t; }
#define TIDX tid_opaque()

constexpr int NL = 32768, NC = 2048, NT = 34816;
constexpr size_t AL(size_t x) { return (x + 255) & ~(size_t)255; }
constexpr size_t EXPSZ = 16ull * 1536 * 1024;
constexpr size_t O_WIN0 = 0;
constexpr size_t O_WIN1 = O_WIN0 + AL(2560ull * 1024 * 2);
constexpr size_t O_WOUT = O_WIN1 + AL(3072ull * 1024 * 2);
constexpr size_t O_WGLU = O_WOUT + AL(2ull * 1024 * 1024 * 2);
constexpr size_t O_WEXP = O_WGLU + AL(512ull * 512 * 2);
constexpr size_t O_MOD = O_WEXP + AL(3 * EXPSZ * 2);
constexpr size_t O_HB = O_MOD + AL(2ull * 9 * 6144 * 4);
constexpr size_t O_U = O_HB + AL((size_t)NT * 1024 * 2);
constexpr size_t O_XC = O_U + AL((size_t)NT * 3072 * 2);
constexpr size_t O_VXL = O_XC + AL((size_t)NC * 1024 * 4);
constexpr size_t O_VXC = O_VXL + AL(3ull * 8 * 512 * 4096 * 2);
constexpr size_t O_Z1L = O_VXC + AL(3ull * 8 * 512 * 256 * 2);
constexpr size_t O_Z1C = O_Z1L + AL(8ull * 512 * 4096 * 2);
constexpr size_t O_HYEND = O_Z1C + AL(8ull * 512 * 256 * 2);
constexpr size_t O_OF = O_VXL;
constexpr size_t O_OB = O_OF + (size_t)NL * 512 * 4;
static_assert(O_OB + (size_t)NL * 512 * 4 <= O_HYEND, "alias");
constexpr size_t O_FRAWL = O_HYEND;
constexpr size_t O_FRAWC = O_FRAWL + AL(4096ull * 1024 * 4);
constexpr size_t O_CSUM = O_FRAWC + AL(256ull * 1024 * 4);
constexpr int GLS = 4096 + 128, GCS = 256 + 128;
constexpr size_t O_GL = O_CSUM + AL(272ull * 1024 * 4);
constexpr size_t O_GC = O_GL + AL(2ull * 1024 * GLS * 2);
constexpr size_t O_Y5F = O_GC + AL(2ull * 1024 * GCS * 2);
constexpr size_t O_Y5B = O_Y5F + AL((size_t)NL * 512 * 2);
constexpr size_t O_Y5 = O_Y5B + AL((size_t)NL * 512 * 2);
constexpr size_t O_AFF = O_Y5 + AL((size_t)NL * 512 * 2);
constexpr size_t O_STOK = O_AFF + AL((size_t)NT * 16 * 4);
constexpr size_t O_SGATE = O_STOK + AL(16ull * 4352 * 4);
constexpr size_t O_AGP = O_SGATE + AL(16ull * 4352 * 4);
constexpr size_t O_AGS = O_AGP + AL(2ull * 544 * 512 * 4);
constexpr size_t O_HS = O_AGS + AL(2ull * 544 * 512 * 4);
constexpr size_t O_END = O_HS + AL(2ull * 544 * 512 * 4);
constexpr size_t O_OUTB = O_VXL;
constexpr size_t O_INV = O_END;
constexpr size_t O_WLT = O_INV + AL((size_t)NT * 16 * 4);
constexpr size_t O_END1 = O_WLT + AL(2ull * 8 * 128 * 64 * 2);
constexpr int SMEM_BYTES = 71680;

struct Params {
  const float* in[44];
  float* out;
  unsigned char* ws;
};

DEVI u16 f2bf(float f) { uint32_t u = __float_as_uint(f); u += 0x7fffu + ((u >> 16) & 1u); return (u16)(u >> 16); }
DEVI float bf2f(u16 h) { return __uint_as_float(((uint32_t)h) << 16); }
DEVI uint32_t pack2(float a, float b) { return (uint32_t)f2bf(a) | ((uint32_t)f2bf(b) << 16); }
DEVI void unpack8(const uint4& x, float (&v)[8]) {
  v[0] = bf2f((u16)(x.x & 0xffff)); v[1] = bf2f((u16)(x.x >> 16)); v[2] = bf2f((u16)(x.y & 0xffff)); v[3] = bf2f((u16)(x.y >> 16));
  v[4] = bf2f((u16)(x.z & 0xffff)); v[5] = bf2f((u16)(x.z >> 16)); v[6] = bf2f((u16)(x.w & 0xffff)); v[7] = bf2f((u16)(x.w >> 16));
}

DEVI float sigm(float x) { return 1.f / (1.f + __expf(-x)); }
DEVI float siluf(float x) { return x * sigm(x); }
DEVI float geluf(float x) { float u = 0.7978845608028654f * (x + 0.044715f * x * x * x); return 0.5f * x * (1.f + tanhf(u)); }
DEVI float wsum(float v) { for (int o = 32; o > 0; o >>= 1) v += __shfl_xor(v, o); return v; }

DEVI void prep_tile(const float* src, int K, int N, u16* dst, int tile_id, float* tile) {
  int tpm = (K / 64) * (N / 64);
  int mat = tile_id / tpm, t = tile_id % tpm;
  int kt = t / (N / 64), nt = t % (N / 64);
  src += (size_t)mat * K * N; dst += (size_t)mat * K * N;
  int k0 = kt * 64, n0 = nt * 64, tid = TIDX;
  int r = tid >> 4, c4 = (tid & 15) * 4;
#pragma unroll
  for (int i = 0; i < 4; ++i) {
    int k = r + 16 * i;
    float4 v = *(const float4*)(src + (size_t)(k0 + k) * N + n0 + c4);
    tile[k * 65 + c4 + 0] = v.x; tile[k * 65 + c4 + 1] = v.y; tile[k * 65 + c4 + 2] = v.z; tile[k * 65 + c4 + 3] = v.w;
  }
  __syncthreads();
  int n = tid >> 3, kc = (tid & 7) * 8;
#pragma unroll
  for (int i = 0; i < 2; ++i) {
    int nn = n + 32 * i;
    uint4 o;
    o.x = pack2(tile[(kc + 0) * 65 + nn], tile[(kc + 1) * 65 + nn]);
    o.y = pack2(tile[(kc + 2) * 65 + nn], tile[(kc + 3) * 65 + nn]);
    o.z = pack2(tile[(kc + 4) * 65 + nn], tile[(kc + 5) * 65 + nn]);
    o.w = pack2(tile[(kc + 6) * 65 + nn], tile[(kc + 7) * 65 + nn]);
    *(uint4*)(dst + (size_t)(n0 + nn) * K + k0 + kc) = o;
  }
  __syncthreads();
}

DEVI void prep_tile128(const float* src, int K, int N, u16* dst, int tile_id, float* tile) {
  int tpm = (K / 128) * (N / 128);
  int mat = tile_id / tpm, t = tile_id % tpm;
  int kt = t / (N / 128), nt = t % (N / 128);
  src += (size_t)mat * K * N; dst += (size_t)mat * K * N;
  int k0 = kt * 128, n0 = nt * 128, tid = TIDX;
  int r = tid >> 5, c4 = (tid & 31) * 4;
#pragma unroll 4
  for (int i = 0; i < 16; ++i) {
    int k = r + 8 * i;
    float4 v = *(const float4*)(src + (size_t)(k0 + k) * N + n0 + c4);
    tile[k * 129 + c4 + 0] = v.x; tile[k * 129 + c4 + 1] = v.y; tile[k * 129 + c4 + 2] = v.z; tile[k * 129 + c4 + 3] = v.w;
  }
  __syncthreads();
  int n = tid >> 4, kc = (tid & 15) * 8;
#pragma unroll 2
  for (int i = 0; i < 8; ++i) {
    int nn = n + 16 * i;
    uint4 o;
    o.x = pack2(tile[(kc + 0) * 129 + nn], tile[(kc + 1) * 129 + nn]);
    o.y = pack2(tile[(kc + 2) * 129 + nn], tile[(kc + 3) * 129 + nn]);
    o.z = pack2(tile[(kc + 4) * 129 + nn], tile[(kc + 5) * 129 + nn]);
    o.w = pack2(tile[(kc + 6) * 129 + nn], tile[(kc + 7) * 129 + nn]);
    *(uint4*)(dst + (size_t)(n0 + nn) * K + k0 + kc) = o;
  }
  __syncthreads();
}

DEVI void prep_tile2(const float* src0, int K, int N, u16* dst0, int tile_id, float* tile) {
  int tpm = (K / 64) * (N / 64), tid = TIDX;
  int r = tid >> 4, c4 = (tid & 15) * 4;
  float4 v[2][4];
#pragma unroll
  for (int j = 0; j < 2; ++j) {
    int tj = tile_id + j, mat = tj / tpm, t = tj % tpm;
    int k0 = (t / (N / 64)) * 64, n0 = (t % (N / 64)) * 64;
    const float* src = src0 + (size_t)mat * K * N;
#pragma unroll
    for (int i = 0; i < 4; ++i) v[j][i] = *(const float4*)(src + (size_t)(k0 + r + 16 * i) * N + n0 + c4);
  }
#pragma unroll
  for (int j = 0; j < 2; ++j)
#pragma unroll
    for (int i = 0; i < 4; ++i) {
      float* tl = tile + j * 4160 + (r + 16 * i) * 65 + c4;
      tl[0] = v[j][i].x; tl[1] = v[j][i].y; tl[2] = v[j][i].z; tl[3] = v[j][i].w;
    }
  __syncthreads();
  int n = tid >> 3, kc = (tid & 7) * 8;
#pragma unroll
  for (int j = 0; j < 2; ++j) {
    int tj = tile_id + j, mat = tj / tpm, t = tj % tpm;
    int k0 = (t / (N / 64)) * 64, n0 = (t % (N / 64)) * 64;
    u16* dst = dst0 + (size_t)mat * K * N;
    const float* tl = tile + j * 4160;
#pragma unroll
    for (int i = 0; i < 2; ++i) {
      int nn = n + 32 * i;
      uint4 o;
      o.x = pack2(tl[(kc + 0) * 65 + nn], tl[(kc + 1) * 65 + nn]);
      o.y = pack2(tl[(kc + 2) * 65 + nn], tl[(kc + 3) * 65 + nn]);
      o.z = pack2(tl[(kc + 4) * 65 + nn], tl[(kc + 5) * 65 + nn]);
      o.w = pack2(tl[(kc + 6) * 65 + nn], tl[(kc + 7) * 65 + nn]);
      *(uint4*)(dst + (size_t)(n0 + nn) * K + k0 + kc) = o;
    }
  }
  __syncthreads();
}

DEVI void prep_experts(const Params& p, int layer, int it, float* tile) {
  u16* wexp = (u16*)(p.ws + O_WEXP);
  int kind = it / 3072, t = (it % 3072) * 2;
  if (kind == 0) prep_tile2(p.in[40] + (size_t)layer * EXPSZ, 1024, 1536, wexp, t, tile);
  else if (kind == 1) prep_tile2(p.in[41] + (size_t)layer * EXPSZ, 1024, 1536, wexp + EXPSZ, t, tile);
  else prep_tile2(p.in[42] + (size_t)layer * EXPSZ, 1536, 1024, wexp + 2 * EXPSZ, t, tile);
}

DEVI void mod_item(const Params& p, int it, float* sm) {
  int l = it / 96, j0 = (it % 96) * 64, tid = TIDX;
  float* sc = sm;
  float* red = sm + 9 * 1024;
  for (int i = tid; i < 9 * 1024; i += 256) {
    int r = i >> 10, k = i & 1023;
    float v = (r < 8) ? p.in[1][r * 1024 + k] : p.in[3][k];
    sc[i] = siluf(v);
  }
  __syncthreads();
  int col = tid & 63, kq = tid >> 6;
  float acc[9];
#pragma unroll
  for (int r = 0; r < 9; ++r) acc[r] = 0.f;
  const float* w = p.in[4] + (size_t)l * 1024 * 6144 + j0 + col;
#pragma unroll 8
  for (int k = kq * 256; k < kq * 256 + 256; ++k) {
    float wv = w[(size_t)k * 6144];
#pragma unroll
    for (int r = 0; r < 9; ++r) acc[r] += sc[r * 1024 + k] * wv;
  }
#pragma unroll
  for (int r = 0; r < 9; ++r) red[(kq * 9 + r) * 64 + col] = acc[r];
  __syncthreads();
  float* mod = (float*)(p.ws + O_MOD);
  for (int i = tid; i < 9 * 64; i += 256) {
    int r = i >> 6, c = i & 63;
    float s = red[(0 * 9 + r) * 64 + c] + red[(1 * 9 + r) * 64 + c] + red[(2 * 9 + r) * 64 + c] + red[(3 * 9 + r) * 64 + c];
    mod[((size_t)l * 9 + r) * 6144 + j0 + c] = s + p.in[5][l * 6144 + j0 + c];
  }
  __syncthreads();
}

DEVI void filt_item(const Params& p, int it, float* sm) {
  int L, t0, blk; float* fraw;
  if (it < 256) { L = 4096; t0 = it * 16; blk = it; fraw = (float*)(p.ws + O_FRAWL); }
  else { L = 256; t0 = (it - 256) * 16; blk = it; fraw = (float*)(p.ws + O_FRAWC); }
  float* z = sm;
  float* h1 = sm + 16 * 33;
  float* h2 = h1 + 16 * 64;
  int tid = TIDX;
  const float* w1 = p.in[19]; const float* b1 = p.in[20]; const float* w2 = p.in[21]; const float* b2 = p.in[22];
  const float* w3 = p.in[23]; const float* fr = p.in[24];
  for (int i = tid; i < 16 * 33; i += 256) {
    int pos = i / 33, c = i % 33;
    float t = (float)(t0 + pos);
    float v;
    if (c == 0) v = t / (float)(L - 1);
    else {
      int bi = (c - 1) & 15;
      float band = 1e-4f + (float)bi * ((15.f - 1e-4f) / 15.f);
      float ang = ((6.283185307179586f / (float)L) * t) * band;
      v = (c <= 16) ? cosf(ang) : -sinf(ang);
    }
    z[i] = v;
  }
  __syncthreads();
  for (int i = tid; i < 16 * 64; i += 256) {
    int pos = i >> 6, j = i & 63;
    float s = b1[j];
#pragma unroll 3
    for (int k = 0; k < 33; ++k) s += z[pos * 33 + k] * w1[k * 64 + j];
    h1[i] = sinf(fr[j] * s);
  }
  __syncthreads();
  for (int i = tid; i < 16 * 64; i += 256) {
    int pos = i >> 6, j = i & 63;
    float s = b2[j];
#pragma unroll 4
    for (int k = 0; k < 64; ++k) s += h1[pos * 64 + k] * w2[k * 64 + j];
    h2[i] = sinf(fr[j] * s);
  }
  __syncthreads();
  float* csum = (float*)(p.ws + O_CSUM);
  const float dmin = -3.0701134573253946f, dmax = -15.350567286626973f;
#pragma unroll 1
  for (int cc = 0; cc < 4; ++cc) {
    int col = tid + 256 * cc;
    float acc[16];
#pragma unroll
    for (int q = 0; q < 16; ++q) acc[q] = 0.f;
#pragma unroll 8
    for (int k = 0; k < 64; ++k) {
      float wv = w3[k * 1024 + col];
#pragma unroll
      for (int q = 0; q < 16; ++q) acc[q] += h2[q * 64 + k] * wv;
    }
    float delta = fabsf(dmin + (float)col * ((dmax - dmin) / 1023.f));
    float ss = 0.f;
#pragma unroll
    for (int q = 0; q < 16; ++q) {
      float t = (float)(t0 + q);
      float dist = fabsf(t - (float)(L / 2)) / ((float)L * 0.5f);
      float v = acc[q] * expf(-dist * delta);
      fraw[(size_t)(t0 + q) * 1024 + col] = v;
      ss += v * v;
    }
    csum[(size_t)blk * 1024 + col] = ss;
  }
  __syncthreads();
}

DEVI void filtfin_item(const Params& p, int it, float* sm) {
  int L, gs, ct, mt, nb, b0; const float* fraw; u16* G;
  if (it < 16 * 66) { L = 4096; gs = GLS; ct = it / 66; mt = it % 66; nb = 256; b0 = 0; fraw = (const float*)(p.ws + O_FRAWL); G = (u16*)(p.ws + O_GL); }
  else { int j = it - 16 * 66; L = 256; gs = GCS; ct = j / 6; mt = j % 6; nb = 16; b0 = 256; fraw = (const float*)(p.ws + O_FRAWC); G = (u16*)(p.ws + O_GC); }
  float* scale = sm;
  float* red = sm + 64;
  float* tile = sm + 64 + 256;
  int tid = TIDX, c0 = ct * 64, m0 = mt * 64;
  const float* csum = (const float*)(p.ws + O_CSUM);
  {
    int c = tid & 63, q = tid >> 6;
    float s = 0.f;
#pragma unroll 8
    for (int b = q; b < nb; b += 4) s += csum[(size_t)(b0 + b) * 1024 + c0 + c];
    red[q * 64 + c] = s;
  }
  __syncthreads();
  if (tid < 64) scale[tid] = rsqrtf(red[tid] + red[64 + tid] + red[128 + tid] + red[192 + tid] + 1e-6f);
  int thi = L + 63 - m0;
  for (int i = tid; i < 65 * 64; i += 256) {
    int rr = i >> 6, c = i & 63;
    int t = thi - rr;
    tile[rr * 65 + c] = (t >= 0 && t < L) ? fraw[(size_t)t * 1024 + c0 + c] : 0.f;
  }
  __syncthreads();
  for (int i = tid; i < 2 * 64 * 8; i += 256) {
    int m8 = (i & 7) * 8, c = (i >> 3) & 63, par = i >> 9;
    float sc = scale[c];
    uint4 o;
    o.x = pack2(tile[(m8 + 0 + par) * 65 + c] * sc, tile[(m8 + 1 + par) * 65 + c] * sc);
    o.y = pack2(tile[(m8 + 2 + par) * 65 + c] * sc, tile[(m8 + 3 + par) * 65 + c] * sc);
    o.z = pack2(tile[(m8 + 4 + par) * 65 + c] * sc, tile[(m8 + 5 + par) * 65 + c] * sc);
    o.w = pack2(tile[(m8 + 6 + par) * 65 + c] * sc, tile[(m8 + 7 + par) * 65 + c] * sc);
    *(uint4*)(G + ((size_t)par * 1024 + c0 + c) * gs + m0 + m8) = o;
  }
  __syncthreads();
}

DEVI void moe_combine(const Params& p, int r, int lane, float4 (&v)[4]) {
  const int* inv = (const int*)(p.ws + O_INV) + (size_t)r * 16;
  const u16* ob = (const u16*)(p.ws + O_OUTB);
  for (int e = 0; e < 16; ++e) {
    int slot = inv[e];
    if (slot >= 0) {
      const u16* orow = ob + ((size_t)e * 4352 + slot) * 1024 + lane * 4;
#pragma unroll
      for (int i = 0; i < 4; ++i) {
        uint2 q = *(const uint2*)(orow + 256 * i);
        v[i].x += bf2f((u16)(q.x & 0xffff)); v[i].y += bf2f((u16)(q.x >> 16)); v[i].z += bf2f((u16)(q.y & 0xffff)); v[i].w += bf2f((u16)(q.y >> 16));
      }
    }
  }
}

DEVI void ph_norm(const Params& p, int layer, int which, bool with_ctx, bool perm, bool router, bool combine, float* smf) {
  const float* xl = (layer == 0 && which == 1) ? p.in[0] : p.out;
  const float* xc = (layer == 0 && which == 1) ? p.in[2] : (const float*)(p.ws + O_XC);
  const float* g = p.in[which == 1 ? 6 : 7] + layer * 1024;
  const float* mod = (const float*)(p.ws + O_MOD) + (size_t)layer * 9 * 6144;
  int sh = (which == 1) ? 0 : 3;
  u16* hb = (u16*)(p.ws + O_HB);
  float* aff = (float*)(p.ws + O_AFF);
  const float* rw = p.in[39] + (size_t)layer * 1024 * 16;
  int lane = TIDX & 63, wave = TIDX >> 6;
  int nrows = with_ctx ? NT : NL;
  float4* rws = (float4*)smf;
  if (router) {
    for (int i = TIDX; i < 4096; i += 256) {
      int k = i >> 2, e4 = i & 3;
      rws[((e4 * 4 + (k & 3)) * 4 + (k >> 8)) * 64 + ((k >> 2) & 63)] = *(const float4*)(rw + (size_t)k * 16 + e4 * 4);
    }
    __syncthreads();
  }
  for (int r = blockIdx.x * 4 + wave; r < nrows; r += gridDim.x * 4) {
    const float* src; int mr; size_t drow;
    if (r < NL) {
      src = xl + (size_t)r * 1024; mr = r >> 12;
      if (perm) { int t = r & 4095; drow = (size_t)(r & ~4095) + (t & 63) * 64 + (t >> 6); } else drow = r;
    } else { src = xc + (size_t)(r - NL) * 1024; mr = 8; drow = r; }
    float4 v[4]; float ss = 0.f;
#pragma unroll
    for (int i = 0; i < 4; ++i) v[i] = *(const float4*)(src + lane * 4 + 256 * i);
    if (combine) {
      moe_combine(p, r, lane, v);
      float* wb = (float*)src;
#pragma unroll
      for (int i = 0; i < 4; ++i) *(float4*)(wb + lane * 4 + 256 * i) = v[i];
    }
#pragma unroll
    for (int i = 0; i < 4; ++i) ss += v[i].x * v[i].x + v[i].y * v[i].y + v[i].z * v[i].z + v[i].w * v[i].w;
    ss = wsum(ss);
    float rs = rsqrtf(ss * (1.f / 1024.f) + 1e-6f);
    const float* shp = mod + (size_t)mr * 6144 + sh * 1024;
    const float* scp = shp + 1024;
    float lg[16];
    if (router) {
#pragma unroll
      for (int e = 0; e < 16; ++e) lg[e] = 0.f;
    }
#pragma unroll
    for (int i = 0; i < 4; ++i) {
      int k = lane * 4 + 256 * i;
      float4 gg = *(const float4*)(g + k), s4 = *(const float4*)(shp + k), c4 = *(const float4*)(scp + k);
      float h0 = (v[i].x * rs * gg.x) * (1.f + c4.x) + s4.x;
      float h1 = (v[i].y * rs * gg.y) * (1.f + c4.y) + s4.y;
      float h2 = (v[i].z * rs * gg.z) * (1.f + c4.z) + s4.z;
      float h3 = (v[i].w * rs * gg.w) * (1.f + c4.w) + s4.w;
      uint2 o; o.x = pack2(h0, h1); o.y = pack2(h2, h3);
      *(uint2*)(hb + drow * 1024 + k) = o;
      if (router) {
        float hh[4] = {h0, h1, h2, h3};
#pragma unroll
        for (int q = 0; q < 4; ++q) {
#pragma unroll
          for (int e4 = 0; e4 < 4; ++e4) {
            float4 w = rws[((e4 * 4 + q) * 4 + i) * 64 + lane];
            lg[e4 * 4 + 0] += hh[q] * w.x; lg[e4 * 4 + 1] += hh[q] * w.y; lg[e4 * 4 + 2] += hh[q] * w.z; lg[e4 * 4 + 3] += hh[q] * w.w;
          }
          __builtin_amdgcn_sched_barrier(0);
        }
      }
    }
    if (router) {
      float mx = -1e30f;
#pragma unroll
      for (int e = 0; e < 16; ++e) { lg[e] = wsum(lg[e]); mx = fmaxf(mx, lg[e]); }
      float den = 0.f;
#pragma unroll
      for (int e = 0; e < 16; ++e) { lg[e] = expf(lg[e] - mx); den += lg[e]; }
      float inv = 1.f / den;
      float mine = 0.f;
#pragma unroll
      for (int e = 0; e < 16; ++e) if (lane == e) mine = lg[e] * inv;
      if (lane < 16) aff[(size_t)r * 16 + lane] = mine;
    }
  }
}

DEVI int vbid() { int nb = gridDim.x; return ((nb & 7) == 0) ? (int)((blockIdx.x & 7) * (nb >> 3) + (blockIdx.x >> 3)) : (int)blockIdx.x; }

DEVI uint32_t gemm_boff(int i, uint32_t ldb) { return ldb ? (uint32_t)i * 32u * ldb : (((i & 3) < 2) ? 0u : (uint32_t)EXPSZ) + (uint32_t)((i >> 2) * 64 + 32 * (i & 1)) * 1024u; }
template <bool GATHER>
DEVI void gemm_core(u16* sm, const u16* Ab, const uint32_t (&pa)[4], uint32_t lda, const u16* Bb, uint32_t pb0, uint32_t ldb, int K, f32x4 (&acc)[8][4]) {
  u16* As = sm; u16* Bs = sm + 128 * 72;
  int tid = TIDX, lane = tid & 63, wid = tid >> 6, wr = wid >> 1, wc = wid & 1;
  int fr = lane & 15, fq = lane >> 4;
  int lrow = tid >> 3, lkc = (tid & 7) * 8;
  u32x4 ra[4], rb[8];
#pragma unroll
  for (int i = 0; i < 4; ++i) ra[i] = *(const u32x4*)(Ab + (GATHER ? pa[i] : pa[0] + (uint32_t)i * 32u * lda));
#pragma unroll
  for (int i = 0; i < 8; ++i) rb[i] = *(const u32x4*)(Bb + pb0 + gemm_boff(i, ldb));
#pragma unroll
  for (int a = 0; a < 8; ++a)
#pragma unroll
    for (int b = 0; b < 4; ++b) acc[a][b] = (f32x4){0.f, 0.f, 0.f, 0.f};
  int nk = K >> 6;
  for (int kt = 0; kt < nk; ++kt) {
    __syncthreads();
#pragma unroll
    for (int i = 0; i < 4; ++i) *(u32x4*)(As + (lrow + 32 * i) * 72 + lkc) = ra[i];
#pragma unroll
    for (int i = 0; i < 8; ++i) *(u32x4*)(Bs + (lrow + 32 * i) * 72 + lkc) = rb[i];
    __syncthreads();
    if (kt + 1 < nk) {
#pragma unroll
      for (int i = 0; i < 4; ++i) ra[i] = *(const u32x4*)(Ab + (GATHER ? pa[i] : pa[0] + (uint32_t)i * 32u * lda) + (kt + 1) * 64);
#pragma unroll
      for (int i = 0; i < 8; ++i) rb[i] = *(const u32x4*)(Bb + pb0 + gemm_boff(i, ldb) + (kt + 1) * 64);
    }
    __builtin_amdgcn_sched_barrier(0);
#pragma unroll
    for (int ks = 0; ks < 2; ++ks) {
      bf16x8 af[4];
#pragma unroll
      for (int m = 0; m < 4; ++m) af[m] = *(const bf16x8*)(As + (wr * 64 + m * 16 + fr) * 72 + ks * 32 + fq * 8);
#pragma unroll
      for (int nh = 0; nh < 4; ++nh) {
        bf16x8 bfm[2];
#pragma unroll
        for (int n = 0; n < 2; ++n) bfm[n] = *(const bf16x8*)(Bs + (wc * 128 + (nh * 2 + n) * 16 + fr) * 72 + ks * 32 + fq * 8);
#pragma unroll
        for (int n = 0; n < 2; ++n)
#pragma unroll
          for (int m = 0; m < 4; ++m) acc[nh * 2 + n][m] = __builtin_amdgcn_mfma_f32_16x16x32_bf16(bfm[n], af[m], acc[nh * 2 + n][m], 0, 0, 0);
      }
      __builtin_amdgcn_sched_barrier(0);
    }
  }
  __syncthreads();
}

DEVI void ph_gemm_in(const Params& p, u16* sm, const u16* Wt, int N) {
  const u16* H = (const u16*)(p.ws + O_HB);
  u16* U = (u16*)(p.ws + O_U);
  int ntl = N / 256, nitems = 272 * ntl;
  int tid = TIDX, lane = tid & 63, wid = tid >> 6, wr = wid >> 1, wc = wid & 1, fr = lane & 15, fq = lane >> 4;
  int lr = tid >> 3, kc = (tid & 7) * 8;
  int gsz = (ntl == 10) ? 5 : 4;
  for (int it = vbid(); it < nitems; it += gridDim.x) {
    int ng = it / (272 * gsz), rem = it % (272 * gsz);
    int m0 = (rem / gsz) * 128, n0 = (ng * gsz + rem % gsz) * 256;
    uint32_t pa[4], pb0 = (uint32_t)(n0 + lr) * 1024u + kc;
#pragma unroll
    for (int i = 0; i < 4; ++i) pa[i] = (uint32_t)(m0 + lr + 32 * i) * 1024u + kc;
    f32x4 acc[8][4];
    gemm_core<false>(sm, H, pa, 1024u, Wt, pb0, 1024u, 1024, acc);
#pragma unroll
    for (int n = 0; n < 8; ++n)
#pragma unroll
      for (int m = 0; m < 4; ++m) {
        int row = m0 + wr * 64 + m * 16 + fr, col = n0 + wc * 128 + n * 16 + fq * 4;
        uint2 o; o.x = pack2(acc[n][m][0], acc[n][m][1]); o.y = pack2(acc[n][m][2], acc[n][m][3]);
        *(uint2*)(U + (size_t)row * N + col) = o;
      }
  }
}

DEVI void ph_gemm_out(const Params& p, u16* sm, int layer) {
  const u16* Y = (const u16*)(p.ws + O_HB);
  const u16* Wt = (const u16*)(p.ws + O_WOUT) + (size_t)layer * 1024 * 1024;
  const float* mod = (const float*)(p.ws + O_MOD) + (size_t)layer * 9 * 6144 + 2 * 1024;
  float* xcw = (float*)(p.ws + O_XC);
  int mtiles = (layer == 0) ? 272 : 256, nitems = mtiles * 4;
  int tid = TIDX, lane = tid & 63, wid = tid >> 6, wr = wid >> 1, wc = wid & 1, fr = lane & 15, fq = lane >> 4;
  int lr = tid >> 3, kc = (tid & 7) * 8;
  for (int it = vbid(); it < nitems; it += gridDim.x) {
    int m0 = (it / 4) * 128, n0 = (it % 4) * 256;
    uint32_t pa[4], pb0 = (uint32_t)(n0 + lr) * 1024u + kc;
#pragma unroll
    for (int i = 0; i < 4; ++i) pa[i] = (uint32_t)(m0 + lr + 32 * i) * 1024u + kc;
    f32x4 acc[8][4];
    gemm_core<false>(sm, Y, pa, 1024u, Wt, pb0, 1024u, 1024, acc);
#pragma unroll
    for (int m = 0; m < 4; ++m) {
      int r = m0 + wr * 64 + m * 16 + fr;
      const float* xin; float* dst; int mr;
      if (r < NL) {
        mr = r >> 12; size_t tok = r;
        if (layer == 1) { int pp = r & 4095; tok = (size_t)(r & ~4095) + (pp & 63) * 64 + (pp >> 6); }
        xin = ((layer == 0) ? p.in[0] : (const float*)p.out) + tok * 1024; dst = p.out + tok * 1024;
      } else { mr = 8; size_t cr = r - NL; xin = p.in[2] + cr * 1024; dst = xcw + cr * 1024; }
      const float* gl = mod + (size_t)mr * 6144;
#pragma unroll
      for (int n = 0; n < 8; ++n) {
        int col = n0 + wc * 128 + n * 16 + fq * 4;
        float4 xv = *(const float4*)(xin + col), gv = *(const float4*)(gl + col);
        float4 o = make_float4(xv.x + gv.x * acc[n][m][0], xv.y + gv.y * acc[n][m][1], xv.z + gv.z * acc[n][m][2], xv.w + gv.w * acc[n][m][3]);
        *(float4*)(dst + col) = o;
      }
    }
  }
}
DEVI void lru_gates(const Params& p, const float* xh, const u16* xhb, float* z, int dir, int h, int j, int tg, float (&a)[16], float (&bb)[16]) {
  int lane = TIDX & 63, w = TIDX >> 6, fr = lane & 15, fq = lane >> 4;
  const u16* WL = (const u16*)(p.ws + O_WLT) + (size_t)((dir * 8 + h) * 128) * 64;
  f32x4 acc[2][4];
#pragma unroll
  for (int n = 0; n < 2; ++n)
#pragma unroll
    for (int m = 0; m < 4; ++m) acc[n][m] = (f32x4){0.f, 0.f, 0.f, 0.f};
#pragma unroll
  for (int ks = 0; ks < 2; ++ks) {
    bf16x8 wf[2], xf[4];
#pragma unroll
    for (int n = 0; n < 2; ++n) wf[n] = *(const bf16x8*)(WL + ((2 * w + n) * 16 + fr) * 64 + ks * 32 + fq * 8);
#pragma unroll
    for (int m = 0; m < 4; ++m) xf[m] = *(const bf16x8*)(xhb + (m * 16 + fr) * 72 + ks * 32 + fq * 8);
#pragma unroll
    for (int n = 0; n < 2; ++n)
#pragma unroll
      for (int m = 0; m < 4; ++m) acc[n][m] = __builtin_amdgcn_mfma_f32_16x16x32_bf16(wf[n], xf[m], acc[n][m], 0, 0, 0);
  }
#pragma unroll
  for (int n = 0; n < 2; ++n)
#pragma unroll
    for (int m = 0; m < 4; ++m)
      *(float4*)(z + (m * 16 + fr) * 132 + (2 * w + n) * 16 + 4 * fq) = make_float4(acc[n][m][0], acc[n][m][1], acc[n][m][2], acc[n][m][3]);
  __syncthreads();
  int gi = (dir * 8 + h) * 64 + j;
  float bav = p.in[13][gi], bxv = p.in[15][gi], lam = p.in[16][gi];
  float sp = log1pf(expf(-lam));
#pragma unroll
  for (int q = 0; q < 16; ++q) {
    int tok = tg * 16 + q;
    float r = sigm(z[tok * 132 + j] + bav), ig = sigm(z[tok * 132 + 64 + j] + bxv);
    float la = -8.f * r * sp;
    a[q] = __expf(la);
    bb[q] = sqrtf(1.f - __expf(2.f * la)) * ig * xh[tok * 64 + j];
  }
  __syncthreads();
}

DEVI void lru_item(const Params& p, int it, unsigned char* smem, int mode) {
  int ci = it >> 3, h = it & 7;
  int rowbase, t0, slen;
  if (ci < 512) { rowbase = (ci >> 6) * 4096; t0 = (ci & 63) * 64; slen = 4096; }
  else { int cc = ci - 512; rowbase = NL + (cc >> 2) * 256; t0 = (cc & 3) * 64; slen = 256; }
  const u16* U = (const u16*)(p.ws + O_U);
  float* xh = (float*)smem;
  u16* xhb = (u16*)(smem + 16384);
  float* z = (float*)(smem + 25600);
  float* xraw = z;
  float* agg = (float*)(smem + 59392);
  int tid = TIDX, j = tid & 63, tg = tid >> 6;
  for (int i = tid; i < 67 * 8; i += 256) {
    int rr = i >> 3, c8 = (i & 7) * 8, t = t0 - 1 + rr;
    float v8[8];
    if (t >= 0 && t < slen) unpack8(*(const uint4*)(U + (size_t)(rowbase + t) * 2560 + h * 64 + c8), v8);
    else { for (int k = 0; k < 8; ++k) v8[k] = 0.f; }
#pragma unroll
    for (int k = 0; k < 8; ++k) xraw[rr * 64 + c8 + k] = v8[k];
  }
  __syncthreads();
  {
    const float* cw = p.in[10]; int ch = h * 64 + j;
    float w0 = cw[ch], w1 = cw[512 + ch], w2 = cw[1024 + ch], w3 = cw[1536 + ch], cb = p.in[11][ch];
#pragma unroll
    for (int q = 0; q < 16; ++q) {
      int t = tg * 16 + q;
      float v = cb + w0 * xraw[t * 64 + j] + w1 * xraw[(t + 1) * 64 + j] + w2 * xraw[(t + 2) * 64 + j] + w3 * xraw[(t + 3) * 64 + j];
      xh[t * 64 + j] = v; xhb[t * 72 + j] = f2bf(v);
    }
  }
  __syncthreads();
  float af[16], bf_[16], ab[16], bk[16];
  lru_gates(p, xh, xhb, z, 0, h, j, tg, af, bf_);
  lru_gates(p, xh, xhb, z, 1, h, j, tg, ab, bk);
  {
    float P = 1.f, S = 0.f;
#pragma unroll
    for (int q = 0; q < 16; ++q) { S = af[q] * S + bf_[q]; P *= af[q]; }
    agg[((0 * 4 + tg) * 2 + 0) * 64 + j] = P; agg[((0 * 4 + tg) * 2 + 1) * 64 + j] = S;
    P = 1.f; S = 0.f;
#pragma unroll
    for (int q = 15; q >= 0; --q) { S = ab[q] * S + bk[q]; P *= ab[q]; }
    agg[((1 * 4 + tg) * 2 + 0) * 64 + j] = P; agg[((1 * 4 + tg) * 2 + 1) * 64 + j] = S;
  }
  __syncthreads();
  int ch = h * 64 + j;
  if (mode == 1) {
    if (tg == 0) {
      float* agp = (float*)(p.ws + O_AGP); float* ags = (float*)(p.ws + O_AGS);
      float P = 1.f, S = 0.f;
      for (int g = 0; g < 4; ++g) { float pg = agg[((0 * 4 + g) * 2 + 0) * 64 + j], sg = agg[((0 * 4 + g) * 2 + 1) * 64 + j]; S = pg * S + sg; P *= pg; }
      agp[((size_t)0 * 544 + ci) * 512 + ch] = P; ags[((size_t)0 * 544 + ci) * 512 + ch] = S;
      P = 1.f; S = 0.f;
      for (int g = 3; g >= 0; --g) { float pg = agg[((1 * 4 + g) * 2 + 0) * 64 + j], sg = agg[((1 * 4 + g) * 2 + 1) * 64 + j]; S = pg * S + sg; P *= pg; }
      agp[((size_t)1 * 544 + ci) * 512 + ch] = P; ags[((size_t)1 * 544 + ci) * 512 + ch] = S;
    }
  } else {
    const float* hs = (const float*)(p.ws + O_HS);
    u16* Y = (u16*)(p.ws + O_HB);
    float s = hs[((size_t)0 * 544 + ci) * 512 + ch];
    for (int g = 0; g < tg; ++g) s = agg[((0 * 4 + g) * 2 + 0) * 64 + j] * s + agg[((0 * 4 + g) * 2 + 1) * 64 + j];
    float hf[16];
#pragma unroll
    for (int q = 0; q < 16; ++q) { s = af[q] * s + bf_[q]; hf[q] = s; }
    s = hs[((size_t)1 * 544 + ci) * 512 + ch];
    for (int g = 3; g > tg; --g) s = agg[((1 * 4 + g) * 2 + 0) * 64 + j] * s + agg[((1 * 4 + g) * 2 + 1) * 64 + j];
#pragma unroll
    for (int q = 15; q >= 0; --q) {
      s = ab[q] * s + bk[q];
      size_t row = (size_t)(rowbase + t0 + tg * 16 + q);
      float xg = bf2f(U[row * 2560 + 512 + ch]);
      Y[row * 1024 + ch] = f2bf((hf[q] + s) * geluf(xg));
    }
  }
  __syncthreads();
}

DEVI void lru_combine_item(const Params& p, int it) {
  int gt = it * 256 + TIDX;
  int dir = gt >> 12, b = (gt >> 9) & 7, ch = gt & 511;
  const float* agp = (const float*)(p.ws + O_AGP) + (size_t)dir * 544 * 512 + ch;
  const float* ags = (const float*)(p.ws + O_AGS) + (size_t)dir * 544 * 512 + ch;
  float* hs = (float*)(p.ws + O_HS) + (size_t)dir * 544 * 512 + ch;
  float s = 0.f;
#pragma unroll 1
  for (int kb = 0; kb < 68; kb += 17) {
    float P[17], S[17]; int ci[17];
#pragma unroll
    for (int q = 0; q < 17; ++q) {
      int k = kb + q;
      ci[q] = (k < 4) ? (512 + b * 4 + (dir ? 3 - k : k)) : (b * 64 + (dir ? 67 - k : k - 4));
      P[q] = agp[(size_t)ci[q] * 512]; S[q] = ags[(size_t)ci[q] * 512];
    }
#pragma unroll
    for (int q = 0; q < 17; ++q) { hs[(size_t)ci[q] * 512] = s; s = P[q] * s + S[q]; }
  }
}

DEVI void hyconv_item(const Params& p, int it, float* sm) {
  int ci = it / 24, ct = it % 24;
  int rowbase, t0, slen, b; u16* dst; int L;
  if (ci < 512) { b = ci >> 6; rowbase = b * 4096; t0 = (ci & 63) * 64; slen = 4096; dst = (u16*)(p.ws + O_VXL); L = 4096; }
  else { int cc = ci - 512; b = cc >> 2; rowbase = NL + b * 256; t0 = (cc & 3) * 64; slen = 256; dst = (u16*)(p.ws + O_VXC); L = 256; }
  const u16* U = (const u16*)(p.ws + O_U);
  float* xs = sm;
  int tid = TIDX, c0 = ct * 64;
  for (int i = tid; i < 66 * 8; i += 256) {
    int rr = i >> 3, c8 = (i & 7) * 8, t = t0 - 1 + rr;
    float v8[8];
    if (t >= 0 && t < slen) unpack8(*(const uint4*)(U + (size_t)(rowbase + t) * 2560 + 1024 + c0 + c8), v8);
    else { for (int k = 0; k < 8; ++k) v8[k] = 0.f; }
#pragma unroll
    for (int k = 0; k < 8; ++k) xs[rr * 65 + c8 + k] = v8[k];
  }
  __syncthreads();
  int c = tid >> 2, tq = tid & 3, ch = c0 + c;
  const float* hw = p.in[17];
  float w0 = hw[ch], w1 = hw[1536 + ch], w2 = hw[3072 + ch], cb = p.in[18][ch];
  int which = ch >> 9, cc = ch & 511;
  uint32_t o[8];
#pragma unroll
  for (int q = 0; q < 8; ++q) {
    int tl = tq * 16 + 2 * q;
    float y0 = cb + w0 * xs[tl * 65 + c] + w1 * xs[(tl + 1) * 65 + c] + w2 * xs[(tl + 2) * 65 + c];
    float y1 = cb + w0 * xs[(tl + 1) * 65 + c] + w1 * xs[(tl + 2) * 65 + c] + w2 * xs[(tl + 3) * 65 + c];
    o[q] = pack2(y0, y1);
  }
  u16* d = dst + ((size_t)(which * 8 + b) * 512 + cc) * L + t0 + tq * 16;
  *(uint4*)d = make_uint4(o[0], o[1], o[2], o[3]);
  *(uint4*)(d + 8) = make_uint4(o[4], o[5], o[6], o[7]);
  __syncthreads();
}

DEVI void toep_item(const Params& p, int it, u16* Xs, int order) {
  int c, half, L, gs; const u16* G; const u16* vx; const u16* z1; u16* z1w;
  if (it < 1024) { c = it >> 1; half = it & 1; L = 4096; gs = GLS; G = (const u16*)(p.ws + O_GL); vx = (const u16*)(p.ws + O_VXL); z1 = (const u16*)(p.ws + O_Z1L); z1w = (u16*)(p.ws + O_Z1L); }
  else { c = it - 1024; half = 0; L = 256; gs = GCS; G = (const u16*)(p.ws + O_GC); vx = (const u16*)(p.ws + O_VXC); z1 = (const u16*)(p.ws + O_Z1C); z1w = (u16*)(p.ws + O_Z1C); }
  int T1 = L >> 6, ntiles = T1 >> 1, XS = L + 8;
  int tid = TIDX, lane = tid & 63, w = tid >> 6, fr = lane & 15, fq = lane >> 4;
  const u16* xsrc = (order == 0) ? vx : z1;
  int l8 = L >> 3;
  for (int i = tid; i < 8 * l8; i += 256) {
    int b = i / l8, k8 = i % l8;
    *(uint4*)(Xs + b * XS + k8 * 8) = *(const uint4*)(xsrc + ((size_t)b * 512 + c) * L + k8 * 8);
  }
  __syncthreads();
  f32x4 acc[4][4];
#pragma unroll
  for (int a = 0; a < 4; ++a)
#pragma unroll
    for (int b = 0; b < 4; ++b) acc[a][b] = (f32x4){0.f, 0.f, 0.f, 0.f};
  const u16* Gp = G + (size_t)(order * 512 + c) * gs;
  size_t parstride = (size_t)1024 * gs;
  int bq = fr & 7, t1off = fr >> 3;
  int dmax = L >> 7;
  int base = (L >> 1) + 63 - fr + 8 * fq, par = base & 1;
  const u16* wp = Gp + par * parstride + (base - par);
  auto ldw = [&](int u) { bf16x8 r; uint32_t t4[4]; __builtin_memcpy(t4, (const uint32_t*)(wp + 16 * u), 16); __builtin_memcpy(&r, t4, 16); return r; };
  bf16x8 W[6], Nw[4];
  int t1lo = 2 * (half * 16 + w * 4);
  int dlo = max(-dmax, t1lo - (T1 - 1)), dhi = min(dmax, t1lo + 7);
#pragma unroll
  for (int j = 0; j < 6; ++j) W[j] = ldw(-4 * dlo - 3 + j);
#pragma unroll 1
  for (int d = dlo; d <= dhi; ++d) {
    if (d < dhi) {
#pragma unroll
      for (int j = 0; j < 4; ++j) Nw[j] = ldw(-4 * (d + 1) - 3 + j);
    }
#pragma unroll
    for (int n = 0; n < 4; ++n) {
      int Tn = half * 16 + w * 4 + n;
      int s1 = 2 * Tn + t1off - d;
      bool valid = (Tn < ntiles) && (s1 >= 0) && (s1 < T1);
      int s1c = valid ? s1 : 0;
#pragma unroll
      for (int ks = 0; ks < 2; ++ks) {
        bf16x8 bfrag = *(const bf16x8*)(Xs + bq * XS + s1c * 64 + 32 * ks + 8 * fq);
        if (!valid) bfrag = (bf16x8){0, 0, 0, 0, 0, 0, 0, 0};
#pragma unroll
        for (int m = 0; m < 4; ++m) acc[n][m] = __builtin_amdgcn_mfma_f32_16x16x32_bf16(W[3 - m + 2 * ks], bfrag, acc[n][m], 0, 0, 0);
      }
    }
    W[4] = W[0]; W[5] = W[1];
#pragma unroll
    for (int j = 0; j < 4; ++j) W[j] = Nw[j];
  }
  float skip = p.in[25][order * 512 + c];
#pragma unroll
  for (int n = 0; n < 4; ++n) {
    int Tn = half * 16 + w * 4 + n;
    if (Tn < ntiles) {
      int t1 = 2 * Tn + t1off;
#pragma unroll
      for (int m = 0; m < 4; ++m) {
        int t = 64 * t1 + 16 * m + 4 * fq;
        uint2 xin = *(const uint2*)(Xs + bq * XS + t);
        uint2 xm = *(const uint2*)(vx + ((size_t)((order + 1) * 8 + bq) * 512 + c) * L + t);
        float u0 = bf2f((u16)(xin.x & 0xffff)), u1 = bf2f((u16)(xin.x >> 16)), u2 = bf2f((u16)(xin.y & 0xffff)), u3 = bf2f((u16)(xin.y >> 16));
        float m0 = bf2f((u16)(xm.x & 0xffff)), m1 = bf2f((u16)(xm.x >> 16)), m2 = bf2f((u16)(xm.y & 0xffff)), m3 = bf2f((u16)(xm.y >> 16));
        float r0 = m0 * (acc[n][m][0] + skip * u0), r1 = m1 * (acc[n][m][1] + skip * u1);
        float r2 = m2 * (acc[n][m][2] + skip * u2), r3 = m3 * (acc[n][m][3] + skip * u3);
        {
          uint2 o; o.x = pack2(r0, r1); o.y = pack2(r2, r3);
          u16* dstz = (order == 0) ? z1w : (u16*)vx;
          *(uint2*)(dstz + ((size_t)bq * 512 + c) * L + t) = o;
        }
      }
    }
  }
  __syncthreads();
}

DEVI void hytr_item(const Params& p, int it, u16* sm) {
  int ci = it >> 3, c0 = (it & 7) * 64;
  int rowbase, t0, b, L; const u16* z2;
  if (ci < 512) { b = ci >> 6; rowbase = b * 4096; t0 = (ci & 63) * 64; L = 4096; z2 = (const u16*)(p.ws + O_VXL); }
  else { int cc = ci - 512; b = cc >> 2; rowbase = NL + b * 256; t0 = (cc & 3) * 64; L = 256; z2 = (const u16*)(p.ws + O_VXC); }
  int tid = TIDX;
  for (int i = tid; i < 64 * 8; i += 256) {
    int c = i >> 3, t8 = (i & 7) * 8;
    *(uint4*)(sm + c * 72 + t8) = *(const uint4*)(z2 + ((size_t)b * 512 + c0 + c) * L + t0 + t8);
  }
  __syncthreads();
  u16* Y = (u16*)(p.ws + O_HB);
  for (int i = tid; i < 64 * 8; i += 256) {
    int t = i >> 3, c8 = (i & 7) * 8;
    uint32_t o[4];
#pragma unroll
    for (int k = 0; k < 4; ++k) o[k] = (uint32_t)sm[(c8 + 2 * k) * 72 + t] | ((uint32_t)sm[(c8 + 2 * k + 1) * 72 + t] << 16);
    *(uint4*)(Y + (size_t)(rowbase + t0 + t) * 1024 + 512 + c0 + c8) = make_uint4(o[0], o[1], o[2], o[3]);
  }
  __syncthreads();
}

DEVI int blk_count(int c, int* cnts, int& flip) {
  for (int o = 32; o > 0; o >>= 1) c += __shfl_xor(c, o);
  int* s = cnts + (flip & 1) * 4;
  if ((TIDX & 63) == 0) s[TIDX >> 6] = c;
  __syncthreads();
  int tot = s[0] + s[1] + s[2] + s[3];
  flip ^= 1;
  return tot;
}

DEVI void topk_item(const Params& p, int it, int* smi) {
  int e = it & 15, seq = it >> 4;
  int n, cap, rowbase, slotbase, ept;
  if (seq < 8) { n = 4096; cap = 512; rowbase = seq * 4096; slotbase = seq * 512; ept = 16; }
  else { int b = seq - 8; n = 256; cap = 32; rowbase = NL + b * 256; slotbase = 4096 + b * 32; ept = 1; }
  const float* aff = (const float*)(p.ws + O_AFF);
  int* stok = (int*)(p.ws + O_STOK) + e * 4352 + slotbase;
  float* sgate = (float*)(p.ws + O_SGATE) + e * 4352 + slotbase;
  int* cnts = smi;
  int* wt = smi + 8;
  int tid = TIDX, flip = 0;
  uint32_t v[16];
#pragma unroll
  for (int j = 0; j < 16; ++j) v[j] = (j < ept) ? __float_as_uint(aff[(size_t)(rowbase + tid * ept + j) * 16 + e]) : 0u;
  int* hist = smi + 16;
  if (tid < 32) hist[tid] = 0;
  __syncthreads();
  uint32_t T = 0; int need = cap;
#pragma unroll 1
  for (int pass = 0; pass < 8; ++pass) {
    int shift = 28 - 4 * pass;
    uint32_t mhi = (pass == 0) ? 0u : ~((1u << (shift + 4)) - 1u);
    int* H = hist + (pass & 1) * 16;
#pragma unroll
    for (int j = 0; j < 16; ++j) if (j < ept && (v[j] & mhi) == T) atomicAdd(&H[(v[j] >> shift) & 15], 1);
    __syncthreads();
    int cum = 0, chosen = 0;
    for (int dg = 15; dg >= 0; --dg) { int hc = H[dg]; if (cum + hc >= need) { chosen = dg; break; } cum += hc; }
    if (tid < 16) hist[((pass + 1) & 1) * 16 + tid] = 0;
    T |= (uint32_t)chosen << shift; need -= cum;
    __syncthreads();
  }
  int need_eq = need, cnt_gt = cap - need;
  int ngt = 0, neq = 0;
#pragma unroll
  for (int j = 0; j < 16; ++j) { if (j < ept) { ngt += (v[j] > T) ? 1 : 0; neq += (v[j] == T) ? 1 : 0; } }
  int comb = ngt | (neq << 16);
  int inc = comb;
  int lane = tid & 63, wv = tid >> 6;
  for (int o = 1; o < 64; o <<= 1) { int t = __shfl_up(inc, o); if (lane >= o) inc += t; }
  __syncthreads();
  if (lane == 63) wt[wv] = inc;
  __syncthreads();
  int pre = 0;
  for (int q = 0; q < wv; ++q) pre += wt[q];
  int ex = pre + inc - comb;
  int pg = ex & 0xffff, pe = ex >> 16;
#pragma unroll
  for (int j = 0; j < 16; ++j) {
    if (j < ept) {
      int slot = -1;
      if (v[j] > T) slot = pg++;
      else if (v[j] == T) { if (pe < need_eq) slot = cnt_gt + pe; pe++; }
      if (slot >= 0) { stok[slot] = rowbase + tid * ept + j; sgate[slot] = __uint_as_float(v[j]); }
      ((int*)(p.ws + O_INV))[(size_t)(rowbase + tid * ept + j) * 16 + e] = (slot >= 0) ? (slotbase + slot) : -1;
    }
  }
  __syncthreads();
}

DEVI void ph_moe_up(const Params& p, u16* sm, int mtl) {
  const u16* Hn = (const u16*)(p.ws + O_HB);
  const u16* Wg = (const u16*)(p.ws + O_WEXP);
  u16* Act = (u16*)(p.ws + O_U);
  const int* stok = (const int*)(p.ws + O_STOK);
  int nitems = 16 * 12 * mtl;
  int tid = TIDX, lane = tid & 63, wid = tid >> 6, wr = wid >> 1, wc = wid & 1, fr = lane & 15, fq = lane >> 4;
  int lr = tid >> 3, kc = (tid & 7) * 8;
  for (int it = vbid(); it < nitems; it += gridDim.x) {
    int e = it / (12 * mtl), rem = it % (12 * mtl);
    int fg = rem / (4 * mtl), r2 = rem % (4 * mtl);
    int f0 = (fg * 4 + (r2 & 3)) * 128, m0 = (r2 >> 2) * 128;
    uint32_t pa[4], pb0 = (uint32_t)(e * 1536 + f0 + lr) * 1024u + kc;
#pragma unroll
    for (int i = 0; i < 4; ++i) {
      int tok = stok[e * 4352 + m0 + lr + 32 * i];
      pa[i] = (uint32_t)tok * 1024u + kc;
    }
    f32x4 acc[8][4];
    gemm_core<true>(sm, Hn, pa, 0u, Wg, pb0, 0u, 1024, acc);
#pragma unroll
    for (int m = 0; m < 4; ++m) {
      int slot = m0 + wr * 64 + m * 16 + fr;
#pragma unroll
      for (int n = 0; n < 4; ++n) {
        int f = f0 + wc * 64 + n * 16 + fq * 4;
        float v0 = siluf(acc[n][m][0]) * acc[n + 4][m][0], v1 = siluf(acc[n][m][1]) * acc[n + 4][m][1];
        float v2 = siluf(acc[n][m][2]) * acc[n + 4][m][2], v3 = siluf(acc[n][m][3]) * acc[n + 4][m][3];
        uint2 o; o.x = pack2(v0, v1); o.y = pack2(v2, v3);
        *(uint2*)(Act + ((size_t)e * 4352 + slot) * 1536 + f) = o;
      }
    }
  }
}

DEVI void ph_moe_down(const Params& p, u16* sm, int layer, int mtl) {
  const u16* Act = (const u16*)(p.ws + O_U);
  const u16* Wd = (const u16*)(p.ws + O_WEXP) + 2 * EXPSZ;
  const int* stok = (const int*)(p.ws + O_STOK);
  const float* sgate = (const float*)(p.ws + O_SGATE);
  const float* mod = (const float*)(p.ws + O_MOD) + (size_t)layer * 9 * 6144 + 5 * 1024;
  int nitems = 16 * 4 * mtl;
  int tid = TIDX, lane = tid & 63, wid = tid >> 6, wr = wid >> 1, wc = wid & 1, fr = lane & 15, fq = lane >> 4;
  int lr = tid >> 3, kc = (tid & 7) * 8;
  for (int it = vbid(); it < nitems; it += gridDim.x) {
    int e = it / (4 * mtl), rem = it % (4 * mtl);
    int n0 = (rem & 3) * 256, m0 = (rem >> 2) * 128;
    uint32_t pa[4], pb0 = (uint32_t)(e * 1024 + n0 + lr) * 1536u + kc;
#pragma unroll
    for (int i = 0; i < 4; ++i) pa[i] = (uint32_t)(e * 4352 + m0 + lr + 32 * i) * 1536u + kc;
    f32x4 acc[8][4];
    gemm_core<false>(sm, Act, pa, 1536u, Wd, pb0, 1536u, 1536, acc);
#pragma unroll
    for (int m = 0; m < 4; ++m) {
      int slot = m0 + wr * 64 + m * 16 + fr;
      int tok = stok[e * 4352 + slot];
      float gt = sgate[e * 4352 + slot];
      int mr = (tok < NL) ? (tok >> 12) : 8;
      const float* gl = mod + (size_t)mr * 6144;
      u16* dst = (u16*)(p.ws + O_OUTB) + ((size_t)e * 4352 + slot) * 1024;
#pragma unroll
      for (int n = 0; n < 8; ++n) {
        int col = n0 + wc * 128 + n * 16 + fq * 4;
        float4 gv = *(const float4*)(gl + col);
        uint2 o; o.x = pack2(acc[n][m][0] * gt * gv.x, acc[n][m][1] * gt * gv.y); o.y = pack2(acc[n][m][2] * gt * gv.z, acc[n][m][3] * gt * gv.w);
        *(uint2*)(dst + col) = o;
      }
    }
  }
}

DEVI void ph_final(const Params& p) {
  int lane = TIDX & 63, wave = TIDX >> 6;
  const float* g = p.in[43];
  for (int r = blockIdx.x * 4 + wave; r < NL; r += gridDim.x * 4) {
    float* row = p.out + (size_t)r * 1024;
    float4 v[4]; float ss = 0.f;
#pragma unroll
    for (int i = 0; i < 4; ++i) v[i] = *(const float4*)(row + lane * 4 + 256 * i);
    moe_combine(p, r, lane, v);
#pragma unroll
    for (int i = 0; i < 4; ++i) ss += v[i].x * v[i].x + v[i].y * v[i].y + v[i].z * v[i].z + v[i].w * v[i].w;
    ss = wsum(ss);
    float rs = rsqrtf(ss * (1.f / 1024.f) + 1e-6f);
#pragma unroll
    for (int i = 0; i < 4; ++i) {
      float4 gg = *(const float4*)(g + lane * 4 + 256 * i);
      *(float4*)(row + lane * 4 + 256 * i) = make_float4(v[i].x * rs * gg.x, v[i].y * rs * gg.y, v[i].z * rs * gg.z, v[i].w * rs * gg.w);
    }
  }
}
constexpr size_t O_SB = O_VXL;
constexpr size_t O_S5H = O_FRAWL;
constexpr size_t O_HDEC = O_S5H + AL(512ull * 68 * 64 * 8);
static_assert(O_SB + 4352ull * 16384 * 2 <= O_HYEND, "sb");
static_assert(O_HDEC + 4352ull * 128 * 4 <= O_Y5F, "hdec");

DEVI size_t seq_row(int s, int b, int dir) {
  if (s < 256) return (size_t)NL + b * 256 + (dir ? 255 - s : s);
  int q = s - 256;
  return (size_t)b * 4096 + (dir ? 4095 - q : q);
}
DEVI float hg_lb_val(const Params& p, int ch) {
  float l0 = p.in[27][ch], l1 = p.in[27][512 + ch];
  float mx = fmaxf(l0, l1), e0 = expf(l0 - mx), e1 = expf(l1 - mx);
  return fminf(fmaxf(e1 / (e0 + e1), 0.f), 1.f - 1e-4f);
}
DEVI void hgrnA_item(const Params& p, int it, unsigned char* smem) {
  int seq = it / 68, c = it % 68;
  int b = seq >> 3, h = (seq >> 1) & 3, dir = seq & 1;
  float* G = (float*)smem;
  u16* KdT = (u16*)(smem + 33280);
  u16* VT = (u16*)(smem + 51712);
  float* lbs = (float*)(smem + 70144);
  int tid = TIDX, lane = tid & 63, w = tid >> 6, fr = lane & 15, fq = lane >> 4;
  if (tid < 128) lbs[tid] = hg_lb_val(p, h * 128 + tid);
  __syncthreads();
  const u16* U = (const u16*)(p.ws + O_U);
  int i = tid >> 2, part = tid & 3;
  const u16* ur = U + seq_row(c * 64 + i, b, dir) * 3072;
  {
    const uint4* src = (const uint4*)(ur + dir * 512 + h * 128 + part * 32);
    const uint4* srv = (const uint4*)(ur + 1024 + h * 128 + part * 32);
#pragma unroll
    for (int q4 = 0; q4 < 4; ++q4) {
      uint4 x = src[q4], y = srv[q4];
      float fv[8]; unpack8(x, fv);
      uint32_t yw[4] = {y.x, y.y, y.z, y.w};
#pragma unroll
      for (int k = 0; k < 8; ++k) {
        int d = part * 32 + q4 * 8 + k;
        float lb = lbs[d];
        G[i * 129 + d] = __logf(lb + (1.f - lb) * sigm(fv[k]));
        VT[d * 72 + i] = (u16)((k & 1) ? (yw[k >> 1] >> 16) : (yw[k >> 1] & 0xffff));
      }
    }
  }
  __syncthreads();
  if (tid < 128) { float a = 0.f; for (int ii = 0; ii < 64; ++ii) { a += G[ii * 129 + tid]; G[ii * 129 + tid] = a; } }
  __syncthreads();
#pragma unroll 8
  for (int k = 0; k < 32; ++k) {
    int d = part * 32 + k;
    float bc = G[i * 129 + d], bp = (i > 0) ? G[(i - 1) * 129 + d] : 0.f, bl = G[63 * 129 + d];
    float f = __expf(bc - bp);
    KdT[d * 72 + i] = f2bf((1.f - f) * __expf(bl - bc));
  }
  if (tid < 128) ((float*)(p.ws + O_HDEC))[(size_t)it * 128 + tid] = __expf(G[63 * 129 + tid]);
  __syncthreads();
  f32x4 acc[2][8];
#pragma unroll
  for (int m = 0; m < 2; ++m)
#pragma unroll
    for (int n = 0; n < 8; ++n) acc[m][n] = (f32x4){0.f, 0.f, 0.f, 0.f};
#pragma unroll
  for (int ks = 0; ks < 2; ++ks) {
    bf16x8 af[2];
#pragma unroll
    for (int m = 0; m < 2; ++m) af[m] = *(const bf16x8*)(KdT + ((2 * w + m) * 16 + fr) * 72 + ks * 32 + fq * 8);
#pragma unroll
    for (int n = 0; n < 8; ++n) {
      bf16x8 bv = *(const bf16x8*)(VT + (n * 16 + fr) * 72 + ks * 32 + fq * 8);
#pragma unroll
      for (int m = 0; m < 2; ++m) acc[m][n] = __builtin_amdgcn_mfma_f32_16x16x32_bf16(af[m], bv, acc[m][n], 0, 0, 0);
    }
  }
  u16* SB = (u16*)(p.ws + O_SB) + (size_t)it * 16384;
#pragma unroll
  for (int m = 0; m < 2; ++m)
#pragma unroll
    for (int n = 0; n < 8; ++n) {
      uint2 o; o.x = pack2(acc[m][n][0], acc[m][n][1]); o.y = pack2(acc[m][n][2], acc[m][n][3]);
      *(uint2*)(SB + (n * 16 + fr) * 128 + (2 * w + m) * 16 + 4 * fq) = o;
    }
  __syncthreads();
}

DEVI void hgrnB_item(const Params& p, int it) {
  int gt = it * 256 + TIDX;
  int seq = gt >> 11, idx = (gt & 2047) * 8, d0 = idx & 127;
  u16* SB = (u16*)(p.ws + O_SB) + (size_t)seq * 68 * 16384 + idx;
  const float* DEC = (const float*)(p.ws + O_HDEC) + (size_t)seq * 68 * 128 + d0;
  float carry[8];
#pragma unroll
  for (int k = 0; k < 8; ++k) carry[k] = 0.f;
#pragma unroll 1
  for (int cb = 0; cb < 68; cb += 4) {
    uint4 kvq[4]; float4 da[4], db[4];
#pragma unroll
    for (int q = 0; q < 4; ++q) {
      kvq[q] = *(const uint4*)(SB + (size_t)(cb + q) * 16384);
      da[q] = *(const float4*)(DEC + (cb + q) * 128); db[q] = *(const float4*)(DEC + (cb + q) * 128 + 4);
    }
#pragma unroll
    for (int q = 0; q < 4; ++q) {
      float kv[8]; unpack8(kvq[q], kv);
      float dd[8] = {da[q].x, da[q].y, da[q].z, da[q].w, db[q].x, db[q].y, db[q].z, db[q].w};
      uint4 o;
      o.x = pack2(carry[0], carry[1]); o.y = pack2(carry[2], carry[3]); o.z = pack2(carry[4], carry[5]); o.w = pack2(carry[6], carry[7]);
      *(uint4*)(SB + (size_t)(cb + q) * 16384) = o;
#pragma unroll
      for (int k = 0; k < 8; ++k) carry[k] = dd[k] * carry[k] + kv[k];
    }
  }
}

DEVI void hgrnC_item(const Params& p, int it, unsigned char* smem) {
  int pb = it & 63, h = (it >> 6) & 3, b = it >> 8;
  u16* Qs = (u16*)smem;
  u16* Kt = (u16*)(smem + 17408);
  float* G = (float*)(smem + 34816);
  u16* VT = (u16*)(smem + 34816);
  u16* At = (u16*)(smem + 34816 + 18432);
  float* lbs = (float*)(smem + 68096);
  float* ssum = lbs + 128;
  int tid = TIDX, lane = tid & 63, w = tid >> 6, fr = lane & 15, fq = lane >> 4;
  if (tid < 128) lbs[tid] = hg_lb_val(p, h * 128 + tid);
  __syncthreads();
  const u16* U = (const u16*)(p.ws + O_U);
  size_t row0 = (size_t)b * 4096 + pb * 64;
  int i = tid >> 2, part = tid & 3;
  const u16* ur = U + (row0 + i) * 3072;
  f32x4 o[4][2];
#pragma unroll
  for (int m = 0; m < 4; ++m)
#pragma unroll
    for (int n = 0; n < 2; ++n) o[m][n] = (f32x4){0.f, 0.f, 0.f, 0.f};
#pragma unroll 1
  for (int dir = 0; dir < 2; ++dir) {
    {
      const uint4* src = (const uint4*)(ur + dir * 512 + h * 128 + part * 32);
#pragma unroll
      for (int q4 = 0; q4 < 4; ++q4) {
        float fv[8]; unpack8(src[q4], fv);
#pragma unroll
        for (int k = 0; k < 8; ++k) { int d = part * 32 + q4 * 8 + k; float lb = lbs[d]; G[i * 129 + d] = __logf(lb + (1.f - lb) * sigm(fv[k])); }
      }
    }
    __syncthreads();
    if (tid < 128) {
      float a = 0.f;
      if (dir == 0) { for (int ii = 0; ii < 64; ++ii) { a += G[ii * 129 + tid]; G[ii * 129 + tid] = a; } }
      else { for (int ii = 63; ii >= 0; --ii) { a += G[ii * 129 + tid]; G[ii * 129 + tid] = a; } }
    }
    __syncthreads();
    {
      const uint4* srq = (const uint4*)(ur + 2048 + h * 128 + part * 32);
      int ip = (dir == 0) ? i - 1 : i + 1;
      bool edge = (dir == 0) ? (i == 0) : (i == 63);
#pragma unroll
      for (int q4 = 0; q4 < 4; ++q4) {
        float qv[8]; unpack8(srq[q4], qv);
        uint32_t qo[4], ko[4];
#pragma unroll
        for (int k2 = 0; k2 < 4; ++k2) {
          float qq[2], kk[2];
#pragma unroll
          for (int z = 0; z < 2; ++z) {
            int d = part * 32 + q4 * 8 + k2 * 2 + z;
            float bc = G[i * 129 + d], bp = edge ? 0.f : G[ip * 129 + d];
            float f = __expf(bc - bp);
            qq[z] = siluf(qv[k2 * 2 + z]) * __expf(bc);
            kk[z] = (1.f - f) * __expf(-bc);
          }
          qo[k2] = pack2(qq[0], qq[1]); ko[k2] = pack2(kk[0], kk[1]);
        }
        *(uint4*)(Qs + i * 136 + part * 32 + q4 * 8) = make_uint4(qo[0], qo[1], qo[2], qo[3]);
        *(uint4*)(Kt + i * 136 + part * 32 + q4 * 8) = make_uint4(ko[0], ko[1], ko[2], ko[3]);
      }
    }
    __syncthreads();
    {
      const uint4* srv = (const uint4*)(ur + 1024 + h * 128 + part * 32);
#pragma unroll
      for (int q4 = 0; q4 < 4; ++q4) {
        uint4 y = srv[q4];
        uint32_t yw[4] = {y.x, y.y, y.z, y.w};
#pragma unroll
        for (int k = 0; k < 8; ++k) VT[(part * 32 + q4 * 8 + k) * 72 + i] = (u16)((k & 1) ? (yw[k >> 1] >> 16) : (yw[k >> 1] & 0xffff));
      }
    }
    int seq = (b * 4 + h) * 2 + dir, c = 4 + (dir ? 63 - pb : pb);
    const u16* SB = (const u16*)(p.ws + O_SB) + ((size_t)seq * 68 + c) * 16384;
#pragma unroll
    for (int ks = 0; ks < 4; ++ks) {
      bf16x8 sf[2];
#pragma unroll
      for (int n = 0; n < 2; ++n) sf[n] = *(const bf16x8*)(SB + ((2 * w + n) * 16 + fr) * 128 + ks * 32 + fq * 8);
#pragma unroll
      for (int m = 0; m < 4; ++m) {
        bf16x8 qf = *(const bf16x8*)(Qs + (m * 16 + fr) * 136 + ks * 32 + fq * 8);
#pragma unroll
        for (int n = 0; n < 2; ++n) o[m][n] = __builtin_amdgcn_mfma_f32_16x16x32_bf16(qf, sf[n], o[m][n], 0, 0, 0);
      }
    }
    {
      f32x4 at[4];
#pragma unroll
      for (int m = 0; m < 4; ++m) at[m] = (f32x4){0.f, 0.f, 0.f, 0.f};
#pragma unroll
      for (int ks = 0; ks < 4; ++ks) {
        bf16x8 kf = *(const bf16x8*)(Kt + (w * 16 + fr) * 136 + ks * 32 + fq * 8);
#pragma unroll
        for (int m = 0; m < 4; ++m) {
          bf16x8 qf = *(const bf16x8*)(Qs + (m * 16 + fr) * 136 + ks * 32 + fq * 8);
          at[m] = __builtin_amdgcn_mfma_f32_16x16x32_bf16(kf, qf, at[m], 0, 0, 0);
        }
      }
#pragma unroll
      for (int m = 0; m < 4; ++m) {
        int ii = m * 16 + fr, j0 = w * 16 + 4 * fq;
        float a4[4];
#pragma unroll
        for (int r = 0; r < 4; ++r) { int j = j0 + r; bool keep = (dir == 0) ? (j <= ii) : (j >= ii); a4[r] = keep ? at[m][r] : 0.f; }
        uint2 ov; ov.x = pack2(a4[0], a4[1]); ov.y = pack2(a4[2], a4[3]);
        *(uint2*)(At + ii * 72 + j0) = ov;
      }
    }
    __syncthreads();
#pragma unroll
    for (int ks = 0; ks < 2; ++ks) {
      bf16x8 vf[2];
#pragma unroll
      for (int n = 0; n < 2; ++n) vf[n] = *(const bf16x8*)(VT + ((2 * w + n) * 16 + fr) * 72 + ks * 32 + fq * 8);
#pragma unroll
      for (int m = 0; m < 4; ++m) {
        bf16x8 af = *(const bf16x8*)(At + (m * 16 + fr) * 72 + ks * 32 + fq * 8);
#pragma unroll
        for (int n = 0; n < 2; ++n) o[m][n] = __builtin_amdgcn_mfma_f32_16x16x32_bf16(af, vf[n], o[m][n], 0, 0, 0);
      }
    }
    __syncthreads();
  }
#pragma unroll
  for (int m = 0; m < 4; ++m)
#pragma unroll
    for (int r = 0; r < 4; ++r) {
      float s = o[m][0][r] * o[m][0][r] + o[m][1][r] * o[m][1][r];
      s += __shfl_xor(s, 1); s += __shfl_xor(s, 2); s += __shfl_xor(s, 4); s += __shfl_xor(s, 8);
      if (fr == 0) ssum[w * 64 + m * 16 + 4 * fq + r] = s;
    }
  __syncthreads();
  u16* Ym = (u16*)(p.ws + O_HB);
#pragma unroll
  for (int m = 0; m < 4; ++m)
#pragma unroll
    for (int r = 0; r < 4; ++r) {
      int ii = m * 16 + 4 * fq + r;
      float tot = ssum[ii] + ssum[64 + ii] + ssum[128 + ii] + ssum[192 + ii];
      float rs = rsqrtf(tot * (1.f / 128.f) + 1e-6f);
      size_t row = row0 + ii;
#pragma unroll
      for (int n = 0; n < 2; ++n) {
        int e = (2 * w + n) * 16 + fr;
        float g = bf2f(U[row * 3072 + 2560 + h * 128 + e]);
        Ym[row * 1024 + h * 128 + e] = f2bf(o[m][n][r] * rs * p.in[28][e] * siluf(g));
      }
    }
  __syncthreads();
}

DEVI void wave_lds_sync() { __builtin_amdgcn_fence(__ATOMIC_RELEASE, "wavefront"); __builtin_amdgcn_wave_barrier(); __builtin_amdgcn_fence(__ATOMIC_ACQUIRE, "wavefront"); }

DEVI void s5_wave(const Params& p, int sq, int c, int mode, float* wsm) {
  int dir = sq & 1, g = (sq >> 1) & 31, b = sq >> 6;
  int lane = TIDX & 63;
  const u16* U = (const u16*)(p.ws + O_U);
  u16* Yo = (u16*)(p.ws + (dir ? O_Y5B : O_Y5F));
  float2* HS = (float2*)(p.ws + O_S5H) + ((size_t)sq * 68 + c) * 64;
  float* Cre = wsm;
  float* Cim = wsm + 1024;
  float* Hre = wsm + 2048;
  float* Him = Hre + 8 * 68;
  if (mode == 1) { for (int i = lane; i < 1024; i += 64) { Cre[i] = p.in[34][(size_t)g * 1024 + i]; Cim[i] = p.in[35][(size_t)g * 1024 + i]; } }
  float lre = fminf(p.in[29][(dir * 32 + g) * 64 + lane], -1e-4f), lim = p.in[30][(dir * 32 + g) * 64 + lane];
  float dt = expf(p.in[31][dir * 32 + g]);
  float mag = expf(lre * dt), lbr = mag * cosf(lim * dt), lbi = mag * sinf(lim * dt);
  float xr = lbr - 1.f, xi = lbi, den = 1.f / (lre * lre + lim * lim);
  float cr = (xr * lre + xi * lim) * den, ci = (xi * lre - xr * lim) * den;
  float Br[16], Bi[16];
#pragma unroll
  for (int q = 0; q < 16; ++q) {
    float br = p.in[32][((size_t)g * 64 + lane) * 16 + q], bi = p.in[33][((size_t)g * 64 + lane) * 16 + q];
    Br[q] = cr * br - ci * bi; Bi[q] = cr * bi + ci * br;
  }
  float hr = 0.f, hi = 0.f;
  if (mode == 1) { float2 h0 = HS[lane]; hr = h0.x; hi = h0.y; }
  wave_lds_sync();
  for (int s0 = c * 64; s0 < c * 64 + 64; s0 += 8) {
#pragma unroll
    for (int s8 = 0; s8 < 8; ++s8) {
      size_t row = seq_row(s0 + s8, b, dir);
      const uint4* up = (const uint4*)(U + row * 3072 + 1536 + g * 16);
      float ua[8], ub[8]; unpack8(up[0], ua); unpack8(up[1], ub);
      float bur = 0.f, bui = 0.f;
#pragma unroll
      for (int q = 0; q < 8; ++q) { bur += Br[q] * ua[q] + Br[8 + q] * ub[q]; bui += Bi[q] * ua[q] + Bi[8 + q] * ub[q]; }
      float nr = lbr * hr - lbi * hi + bur, ni = lbr * hi + lbi * hr + bui;
      hr = nr; hi = ni;
      if (mode == 1) { Hre[s8 * 68 + lane] = hr; Him[s8 * 68 + lane] = hi; }
    }
    if (mode == 1) {
      wave_lds_sync();
      int s8 = lane >> 3, hp = lane & 7;
      float y0 = 0.f, y1 = 0.f;
#pragma unroll
      for (int p4 = 0; p4 < 16; ++p4) {
        float4 a = *(const float4*)(Hre + s8 * 68 + p4 * 4), bq = *(const float4*)(Him + s8 * 68 + p4 * 4);
        float4 c0 = *(const float4*)(Cre + (hp * 2) * 64 + p4 * 4), d0 = *(const float4*)(Cim + (hp * 2) * 64 + p4 * 4);
        float4 c1 = *(const float4*)(Cre + (hp * 2 + 1) * 64 + p4 * 4), d1 = *(const float4*)(Cim + (hp * 2 + 1) * 64 + p4 * 4);
        y0 += a.x * c0.x - bq.x * d0.x + a.y * c0.y - bq.y * d0.y + a.z * c0.z - bq.z * d0.z + a.w * c0.w - bq.w * d0.w;
        y1 += a.x * c1.x - bq.x * d1.x + a.y * c1.y - bq.y * d1.y + a.z * c1.z - bq.z * d1.z + a.w * c1.w - bq.w * d1.w;
      }
      size_t row = seq_row(s0 + s8, b, dir);
      *(uint32_t*)(Yo + row * 512 + g * 16 + hp * 2) = pack2(y0, y1);
      wave_lds_sync();
    }
  }
  if (mode == 0) HS[lane] = make_float2(hr, hi);
}

DEVI void s5B_item(const Params& p, int it) {
  int gt = it * 256 + TIDX;
  int sq = gt >> 6, lane = gt & 63;
  int dir = sq & 1, g = (sq >> 1) & 31;
  float lre = fminf(p.in[29][(dir * 32 + g) * 64 + lane], -1e-4f), lim = p.in[30][(dir * 32 + g) * 64 + lane];
  float dt = expf(p.in[31][dir * 32 + g]);
  float mag = expf(lre * dt), ar = mag * cosf(lim * dt), ai = mag * sinf(lim * dt);
#pragma unroll
  for (int k = 0; k < 6; ++k) { float nr = ar * ar - ai * ai, ni = 2.f * ar * ai; ar = nr; ai = ni; }
  float2* HS = (float2*)(p.ws + O_S5H) + (size_t)sq * 68 * 64 + lane;
  float cr = 0.f, ci = 0.f;
#pragma unroll 1
  for (int cb = 0; cb < 68; cb += 17) {
    float2 v[17];
#pragma unroll
    for (int q = 0; q < 17; ++q) v[q] = HS[(cb + q) * 64];
#pragma unroll
    for (int q = 0; q < 17; ++q) {
      HS[(cb + q) * 64] = make_float2(cr, ci);
      float nr = ar * cr - ai * ci + v[q].x, ni = ar * ci + ai * cr + v[q].y;
      cr = nr; ci = ni;
    }
  }
}

DEVI void ph_l1_finalize(const Params& p) {
  int lane = TIDX & 63, wave = TIDX >> 6;
  const u16* U = (const u16*)(p.ws + O_U);
  const u16* Yf = (const u16*)(p.ws + O_Y5F); const u16* Yb = (const u16*)(p.ws + O_Y5B);
  u16* Y5 = (u16*)(p.ws + O_Y5);
  int ch = lane * 8;
  for (int r = blockIdx.x * 4 + wave; r < NL; r += gridDim.x * 4) {
    size_t ro = (size_t)r;
    float a[8], bb[8], uu[8];
    unpack8(*(const uint4*)(Yf + ro * 512 + ch), a); unpack8(*(const uint4*)(Yb + ro * 512 + ch), bb); unpack8(*(const uint4*)(U + ro * 3072 + 1536 + ch), uu);
    uint32_t ow[4];
#pragma unroll
    for (int q = 0; q < 4; ++q) {
      float y0 = a[2 * q] + bb[2 * q] + uu[2 * q] * p.in[36][ch + 2 * q];
      float y1 = a[2 * q + 1] + bb[2 * q + 1] + uu[2 * q + 1] * p.in[36][ch + 2 * q + 1];
      ow[q] = pack2(geluf(y0), geluf(y1));
    }
    *(uint4*)(Y5 + ro * 512 + ch) = make_uint4(ow[0], ow[1], ow[2], ow[3]);
  }
}
constexpr size_t O_POW = O_END1;
constexpr size_t O_BP = O_POW + AL(64ull * 65 * 64 * 8);
constexpr size_t O_KT = O_BP + AL(64ull * 64 * 16 * 8);
constexpr size_t O_WST = O_KT + AL(64ull * 65 * 256 * 2);
constexpr size_t O_WB = O_WST + AL(64ull * 64 * 16 * 128 * 2);
constexpr size_t O_END2 = O_WB + AL(64ull * 128 * 1024 * 2);
constexpr size_t O_BAR = O_END2;
static_assert(O_BAR + 16384 < 800000000ull, "workspace budget");

DEVI void s5pow_item(const Params& p, int it) {
  int gt = it * 256 + TIDX;
  int gd = gt >> 6, lane = gt & 63, g = gd >> 1, dir = gd & 1;
  float lre = fminf(p.in[29][(dir * 32 + g) * 64 + lane], -1e-4f), lim = p.in[30][(dir * 32 + g) * 64 + lane];
  float dt = expf(p.in[31][dir * 32 + g]);
  float mag = expf(lre * dt), lbr = mag * cosf(lim * dt), lbi = mag * sinf(lim * dt);
  float xr = lbr - 1.f, xi = lbi, den = 1.f / (lre * lre + lim * lim);
  float cr = (xr * lre + xi * lim) * den, ci = (xi * lre - xr * lim) * den;
  float2* POW = (float2*)(p.ws + O_POW) + (size_t)gd * 65 * 64 + lane;
  float pr = 1.f, pi = 0.f;
  for (int t = 0; t < 65; ++t) { POW[t * 64] = make_float2(pr, pi); float nr = pr * lbr - pi * lbi, ni = pr * lbi + pi * lbr; pr = nr; pi = ni; }
  float2* BP = (float2*)(p.ws + O_BP) + ((size_t)gd * 64 + lane) * 16;
  for (int q = 0; q < 16; ++q) {
    float br = p.in[32][((size_t)g * 64 + lane) * 16 + q], bi = p.in[33][((size_t)g * 64 + lane) * 16 + q];
    BP[q] = make_float2(cr * br - ci * bi, cr * bi + ci * br);
  }
}

DEVI void s5tab_item(const Params& p, int it) {
  const float2* POWa = (const float2*)(p.ws + O_POW);
  const float2* BPa = (const float2*)(p.ws + O_BP);
  int tid = TIDX;
  if (it < 576) {
    int gd = it / 9, t8 = it % 9, g = gd >> 1;
    int hh = tid >> 4, hp = tid & 15;
    const float2* POW = POWa + (size_t)gd * 65 * 64;
    const float2* BP = BPa + (size_t)gd * 64 * 16;
    const float* Cr = p.in[34] + ((size_t)g * 16 + hh) * 64; const float* Ci = p.in[35] + ((size_t)g * 16 + hh) * 64;
    u16* KT = (u16*)(p.ws + O_KT) + (size_t)gd * 65 * 256;
    for (int ts = t8 * 8; ts < t8 * 8 + 8 && ts < 65; ++ts) {
      float acc = 0.f;
      if (ts >= 1) {
        for (int pp = 0; pp < 64; ++pp) {
          float2 P = POW[(ts - 1) * 64 + pp], B = BP[pp * 16 + hp];
          float c_r = Cr[pp], c_i = Ci[pp];
          float cpr = c_r * P.x - c_i * P.y, cpi = c_r * P.y + c_i * P.x;
          acc += cpr * B.x - cpi * B.y;
        }
      }
      KT[ts * 256 + hh * 16 + hp] = f2bf(acc);
    }
  } else if (it < 576 + 512) {
    int j = it - 576, gd = j >> 3, i8 = j & 7, g = gd >> 1;
    int hh = tid >> 4, kq = (tid & 15) * 8, p0 = kq >> 1;
    const float2* POW = POWa + (size_t)gd * 65 * 64;
    u16* WS = (u16*)(p.ws + O_WST) + (size_t)gd * 64 * 16 * 128;
    for (int ii = 0; ii < 8; ++ii) {
      int i = i8 * 8 + ii;
      float v[8];
#pragma unroll
      for (int pp = 0; pp < 4; ++pp) {
        int pq = p0 + pp;
        float2 P = POW[(i + 1) * 64 + pq];
        float c_r = p.in[34][((size_t)g * 16 + hh) * 64 + pq], c_i = p.in[35][((size_t)g * 16 + hh) * 64 + pq];
        v[2 * pp] = c_r * P.x - c_i * P.y; v[2 * pp + 1] = -(c_r * P.y + c_i * P.x);
      }
      *(uint4*)(WS + ((size_t)i * 16 + hh) * 128 + kq) = make_uint4(pack2(v[0], v[1]), pack2(v[2], v[3]), pack2(v[4], v[5]), pack2(v[6], v[7]));
    }
  } else {
    int j = it - 1088, gd = j >> 3, p8 = j & 7;
    int jj = tid >> 2, hq = tid & 3;
    const float2* POW = POWa + (size_t)gd * 65 * 64;
    const float2* BP = BPa + (size_t)gd * 64 * 16;
    u16* WB = (u16*)(p.ws + O_WB) + (size_t)gd * 128 * 1024;
    for (int pp = 0; pp < 8; ++pp) {
      int pq = p8 * 8 + pp;
      float2 P = POW[(63 - jj) * 64 + pq];
      float re[4], im[4];
#pragma unroll
      for (int h4 = 0; h4 < 4; ++h4) { float2 B = BP[pq * 16 + hq * 4 + h4]; re[h4] = P.x * B.x - P.y * B.y; im[h4] = P.x * B.y + P.y * B.x; }
      *(uint2*)(WB + (size_t)(2 * pq) * 1024 + jj * 16 + hq * 4) = make_uint2(pack2(re[0], re[1]), pack2(re[2], re[3]));
      *(uint2*)(WB + (size_t)(2 * pq + 1) * 1024 + jj * 16 + hq * 4) = make_uint2(pack2(im[0], im[1]), pack2(im[2], im[3]));
    }
  }
}

DEVI void s5A_mfma_item(const Params& p, int it) {
  int gd = it / 34, nt = it % 34, g = gd >> 1, dir = gd & 1;
  int lane = TIDX & 63, w = TIDX >> 6, fr = lane & 15, fq = lane >> 4;
  int col = nt * 16 + fr, b = col / 68, chunk = col % 68;
  const u16* U = (const u16*)(p.ws + O_U);
  const u16* WB = (const u16*)(p.ws + O_WB) + (size_t)gd * 128 * 1024;
  f32x4 acc[2] = {(f32x4){0.f, 0.f, 0.f, 0.f}, (f32x4){0.f, 0.f, 0.f, 0.f}};
#pragma unroll 8
  for (int js = 0; js < 32; ++js) {
    int j = 2 * js + (fq >> 1);
    size_t row = seq_row(chunk * 64 + j, b, dir);
    bf16x8 bfrag = *(const bf16x8*)(U + row * 3072 + 1536 + g * 16 + (fq & 1) * 8);
#pragma unroll
    for (int m = 0; m < 2; ++m) {
      bf16x8 afrag = *(const bf16x8*)(WB + (size_t)((2 * w + m) * 16 + fr) * 1024 + js * 32 + fq * 8);
      acc[m] = __builtin_amdgcn_mfma_f32_16x16x32_bf16(afrag, bfrag, acc[m], 0, 0, 0);
    }
  }
  int sq = b * 64 + gd;
  float* HSf = (float*)(p.ws + O_S5H) + ((size_t)sq * 68 + chunk) * 128;
#pragma unroll
  for (int m = 0; m < 2; ++m) *(float4*)(HSf + (2 * w + m) * 16 + 4 * fq) = make_float4(acc[m][0], acc[m][1], acc[m][2], acc[m][3]);
}

DEVI void s5C_mfma_item(const Params& p, int it, u16* KTl) {
  int gd = it >> 3, ng = it & 7, g = gd >> 1, dir = gd & 1;
  int tid = TIDX, lane = tid & 63, w = tid >> 6, fr = lane & 15, fq = lane >> 4;
  {
    const uint4* src = (const uint4*)((const u16*)(p.ws + O_KT) + (size_t)gd * 65 * 256);
    for (int i = tid; i < 2080; i += 256) ((uint4*)KTl)[i] = src[i];
  }
  __syncthreads();
  int col = (ng * 4 + w) * 16 + fr, b = col >> 6, chunk = 4 + (col & 63);
  const u16* U = (const u16*)(p.ws + O_U);
  u16* Yo = (u16*)(p.ws + (dir ? O_Y5B : O_Y5F));
  bf16x8 ub[32];
#pragma unroll
  for (int js = 0; js < 32; ++js) {
    size_t row = seq_row(chunk * 64 + 2 * js + (fq >> 1), b, dir);
    ub[js] = *(const bf16x8*)(U + row * 3072 + 1536 + g * 16 + (fq & 1) * 8);
  }
  bf16x8 hb[4];
  {
    int sq = b * 64 + gd;
    const float* HSf = (const float*)(p.ws + O_S5H) + ((size_t)sq * 68 + chunk) * 128;
#pragma unroll
    for (int ks = 0; ks < 4; ++ks) {
      float4 a = *(const float4*)(HSf + ks * 32 + 8 * fq), c = *(const float4*)(HSf + ks * 32 + 8 * fq + 4);
      uint4 pk = make_uint4(pack2(a.x, a.y), pack2(a.z, a.w), pack2(c.x, c.y), pack2(c.z, c.w));
      __builtin_memcpy(&hb[ks], &pk, 16);
    }
  }
  const u16* WS = (const u16*)(p.ws + O_WST) + (size_t)gd * 64 * 16 * 128;
  int tsl = 1 - (fq >> 1);
  const u16* KTp = KTl + fr * 16 + (fq & 1) * 8;
#pragma unroll 1
  for (int i = 0; i < 64; ++i) {
    f32x4 a0 = (f32x4){0.f, 0.f, 0.f, 0.f}, a1 = (f32x4){0.f, 0.f, 0.f, 0.f};
    const u16* WSi = WS + ((size_t)i * 16 + fr) * 128 + 8 * fq;
#pragma unroll
    for (int ks = 0; ks < 4; ++ks) {
      bf16x8 a = *(const bf16x8*)(WSi + ks * 32);
      if (ks & 1) a1 = __builtin_amdgcn_mfma_f32_16x16x32_bf16(a, hb[ks], a1, 0, 0, 0);
      else a0 = __builtin_amdgcn_mfma_f32_16x16x32_bf16(a, hb[ks], a0, 0, 0, 0);
    }
#pragma unroll
    for (int js = 0; js < 32; ++js) {
      if (2 * js > i) break;
      int ts = i - 2 * js + tsl;
      bf16x8 a = *(const bf16x8*)(KTp + ts * 256);
      if (js & 1) a1 = __builtin_amdgcn_mfma_f32_16x16x32_bf16(a, ub[js], a1, 0, 0, 0);
      else a0 = __builtin_amdgcn_mfma_f32_16x16x32_bf16(a, ub[js], a0, 0, 0, 0);
    }
    size_t row = seq_row(chunk * 64 + i, b, dir);
    uint2 o; o.x = pack2(a0[0] + a1[0], a0[1] + a1[1]); o.y = pack2(a0[2] + a1[2], a0[3] + a1[3]);
    *(uint2*)(Yo + row * 512 + g * 16 + 4 * fq) = o;
  }
  __syncthreads();
}

#define XB_TMO      128
#define XB_XCNT(j)  (256  + 64 * (j))
#define XB_XSUB(j)  (1280 + 64 * (j))
#define XB_XGEN(j)  (2304 + 64 * (j))
#define XB_TOP      3328
#define XB_TOPGEN   3392
#define XCD_BAR_WORDS 3456
#define XB_SPIN_CAP (1u << 18)
#define LAS __attribute__((address_space(3)))
__device__ __forceinline__ unsigned xb_ld(unsigned* p)              { return __hip_atomic_load(p, __ATOMIC_RELAXED, __HIP_MEMORY_SCOPE_AGENT); }
__device__ __forceinline__ unsigned xb_add(unsigned* p, unsigned v) { return __hip_atomic_fetch_add(p, v, __ATOMIC_RELAXED, __HIP_MEMORY_SCOPE_AGENT); }
__device__ __forceinline__ unsigned xb_xcc_id() { return (unsigned)__builtin_amdgcn_s_getreg((3 << 11) | 20) & 0xFu; }
#define XB_SPIN(cond, bar) do { unsigned _sp = 0; while (cond) { __builtin_amdgcn_s_sleep(1); \
    if ((++_sp & 255u) == 0u) { if (xb_ld(&(bar)[XB_TMO])) break; if (_sp > XB_SPIN_CAP) { atomicAdd(&(bar)[XB_TMO], 1u); break; } } } } while (0)
struct XcdBarrier { unsigned* bar; unsigned x; volatile LAS unsigned* st; };
__device__ __forceinline__ XcdBarrier xcd_barrier_post(unsigned* bar, volatile LAS unsigned* st) {
  XcdBarrier b; b.bar = bar; b.x = xb_xcc_id(); b.st = st;
  if (threadIdx.x == 0) (void)xb_add(&bar[XB_XCNT(b.x)], 1u);
  return b;
}
__device__ __forceinline__ void xcd_barrier_complete(unsigned* bar, unsigned x, unsigned& nloc, unsigned& nx) {
  const unsigned G = gridDim.x * gridDim.y * gridDim.z;
  unsigned sum, cnt, mine, sp = 0u;
  for (;;) {
    sum = 0u; cnt = 0u; mine = 0u;
#pragma unroll
    for (unsigned j = 0; j < 16; ++j) { const unsigned c = xb_ld(&bar[XB_XCNT(j)]); sum += c; cnt += (c > 0u) ? 1u : 0u; mine = (j == x) ? c : mine; }
    if (sum == G) break;
    __builtin_amdgcn_s_sleep(1);
    if ((++sp & 255u) == 0u) { if (xb_ld(&bar[XB_TMO])) break; if (sp > XB_SPIN_CAP) { atomicAdd(&bar[XB_TMO], 1u); break; } }
  }
  nloc = mine > 0u ? mine : 1u; nx = cnt > 0u ? cnt : 1u;
}
__device__ __forceinline__ void xcd_barrier(const XcdBarrier& b) {
  asm volatile("s_waitcnt vmcnt(0)" ::: "memory");
  __syncthreads();
  if (threadIdx.x == 0) {
    unsigned* bar = b.bar;
    __builtin_amdgcn_s_waitcnt(0);
    unsigned nloc = b.st[0], nx = b.st[1];
    if (nloc == 0u) { xcd_barrier_complete(bar, b.x, nloc, nx); b.st[0] = nloc; b.st[1] = nx; }
    const unsigned old = xb_add(&bar[XB_XSUB(b.x)], 1u);
    const unsigned gen = old / nloc;
    if (old + 1u == (gen + 1u) * nloc) {
      __builtin_amdgcn_fence(__ATOMIC_RELEASE, "agent");
      asm volatile("s_waitcnt vmcnt(0)" ::: "memory");
      const unsigned og = xb_add(&bar[XB_TOP], 1u);
      const unsigned tg = og / nx;
      if (og + 1u == (tg + 1u) * nx) xb_add(&bar[XB_TOPGEN], 1u);
      else XB_SPIN(xb_ld(&bar[XB_TOPGEN]) == tg, bar);
      __builtin_amdgcn_fence(__ATOMIC_ACQUIRE, "agent");
      xb_add(&bar[XB_XGEN(b.x)], 1u);
      asm volatile("s_waitcnt vmcnt(0)" ::: "memory");
    } else {
      XB_SPIN(xb_ld(&bar[XB_XGEN(b.x)]) == gen, bar);
      __builtin_amdgcn_fence(__ATOMIC_ACQUIRE, "agent");
      asm volatile("s_waitcnt vmcnt(0)" ::: "memory");
    }
  }
  __syncthreads();
}
DEVI void ph_gemm_glu(const Params& p, u16* sm) {
  const u16* Y5 = (const u16*)(p.ws + O_Y5);
  const u16* Wt = (const u16*)(p.ws + O_WGLU);
  u16* Ym = (u16*)(p.ws + O_HB);
  int nitems = 256 * 2;
  int tid = TIDX, lane = tid & 63, wid = tid >> 6, wr = wid >> 1, wc = wid & 1, fr = lane & 15, fq = lane >> 4;
  int lr = tid >> 3, kc = (tid & 7) * 8;
  for (int it = vbid(); it < nitems; it += gridDim.x) {
    int m0 = (it / 2) * 128, n0 = (it % 2) * 256;
    uint32_t pa[4], pb0 = (uint32_t)(n0 + lr) * 512u + kc;
#pragma unroll
    for (int i = 0; i < 4; ++i) pa[i] = (uint32_t)(m0 + lr + 32 * i) * 512u + kc;
    f32x4 acc[8][4];
    gemm_core<false>(sm, Y5, pa, 512u, Wt, pb0, 512u, 512, acc);
#pragma unroll
    for (int m = 0; m < 4; ++m) {
      size_t r = m0 + wr * 64 + m * 16 + fr;
#pragma unroll
      for (int n = 0; n < 8; ++n) {
        int col = n0 + wc * 128 + n * 16 + fq * 4;
        uint2 yv = *(const uint2*)(Y5 + r * 512 + col);
        float4 bv = *(const float4*)(p.in[38] + col);
        float y0 = bf2f((u16)(yv.x & 0xffff)), y1 = bf2f((u16)(yv.x >> 16)), y2 = bf2f((u16)(yv.y & 0xffff)), y3 = bf2f((u16)(yv.y >> 16));
        uint2 o;
        o.x = pack2(y0 * sigm(acc[n][m][0] + bv.x), y1 * sigm(acc[n][m][1] + bv.y));
        o.y = pack2(y2 * sigm(acc[n][m][2] + bv.z), y3 * sigm(acc[n][m][3] + bv.w));
        *(uint2*)(Ym + r * 1024 + 512 + col) = o;
      }
    }
  }
}

DEVI void run_phase(const Params& p, int ph, unsigned char* smem) {
  float* smf = (float*)smem; u16* smh = (u16*)smem;
  int bid = blockIdx.x, nb = gridDim.x;
#ifdef ONLY_PHASE
  if (ph != ONLY_PHASE) return;
  ph = ONLY_PHASE;
#endif
  switch (ph) {
    case 0: {
      for (int it = bid; it < 10704; it += nb) {
        if (it < 192) mod_item(p, it, smf);
        else if (it < 464) filt_item(p, it - 192, smf);
        else if (it < 1456) {
          int t = (it - 464) * 2;
          if (t < 640) prep_tile2(p.in[9], 1024, 2560, (u16*)(p.ws + O_WIN0), t, smf);
          else if (t < 1408) prep_tile2(p.in[26], 1024, 3072, (u16*)(p.ws + O_WIN1), t - 640, smf);
          else if (t < 1920) prep_tile2(p.in[8], 1024, 1024, (u16*)(p.ws + O_WOUT), t - 1408, smf);
          else prep_tile2(p.in[37], 512, 512, (u16*)(p.ws + O_WGLU), t - 1920, smf);
        } else if (it < 10672) prep_experts(p, 0, it - 1456, smf);
        else { int t = it - 10672; prep_tile(p.in[(t & 1) ? 14 : 12] + (size_t)(t >> 1) * 4096, 64, 64, (u16*)(p.ws + O_WLT) + (size_t)t * 4096, 0, smf); }
      }
    } break;
    case 1: {
      for (int it = bid; it < 1152; it += nb) filtfin_item(p, it, smf);
      ph_norm(p, 0, 1, true, false, false, false, smf);
    } break;
    case 2: ph_gemm_in(p, smh, (const u16*)(p.ws + O_WIN0), 2560); break;
    case 3: {
      int total = 4352 + 13056;
      for (int it = bid; it < total; it += nb) { if (it < 4352) lru_item(p, it, smem, 1); else hyconv_item(p, it - 4352, smf); }
    } break;
    case 4: {
      int total = 32 + 1536;
      for (int it = bid; it < total; it += nb) { if (it < 32) lru_combine_item(p, it); else toep_item(p, it - 32, smh, 0); }
    } break;
    case 5: {
      int total = 4352 + 1536;
      for (int it = bid; it < total; it += nb) { if (it < 1536) toep_item(p, it, smh, 1); else lru_item(p, it - 1536, smem, 3); }
    } break;
    case 26: for (int it = bid; it < 4352; it += nb) hytr_item(p, it, smh); break;
    case 6: ph_gemm_out(p, smh, 0); break;
    case 7: { for (int it = bid; it < 16; it += nb) s5pow_item(p, it); ph_norm(p, 0, 2, true, false, true, false, smf); } break;
    case 8: for (int it = bid; it < 256 + 1600; it += nb) { if (it < 256) topk_item(p, it, (int*)smem); else s5tab_item(p, it - 256); } break;
    case 9: ph_moe_up(p, smh, 34); break;
    case 10: ph_moe_down(p, smh, 0, 34); break;
    case 11: {
      for (int it = bid; it < 9216; it += nb) prep_experts(p, 1, it, smf);
      ph_norm(p, 1, 1, true, true, false, true, smf);
    } break;
    case 12: {
      ph_gemm_in(p, smh, (const u16*)(p.ws + O_WIN1), 3072);
    } break;
    case 13: for (int it = bid; it < 4352 + 2176; it += nb) { if (it < 2176) s5A_mfma_item(p, it); else hgrnA_item(p, it - 2176, smem); } break;
    case 24: for (int it = bid; it < 2176; it += nb) s5A_mfma_item(p, it); break;
    case 22: {
      int total = 512 + 128;
      for (int it = bid; it < total; it += nb) { if (it < 512) hgrnB_item(p, it); else s5B_item(p, it - 512); }
    } break;
    case 23: for (int it = bid; it < 2048 + 512; it += nb) { if (it < 512) s5C_mfma_item(p, it, smh); else hgrnC_item(p, it - 512, smem); } break;
    case 25: for (int it = bid; it < 512; it += nb) s5C_mfma_item(p, it, smh); break;
    case 14: ph_l1_finalize(p); break;
    case 15: ph_gemm_glu(p, smh); break;
    case 16: ph_gemm_out(p, smh, 1); break;
    case 17: ph_norm(p, 1, 2, false, false, true, false, smf); break;
    case 18: for (int it = bid; it < 128; it += nb) topk_item(p, it, (int*)smem); break;
    case 19: ph_moe_up(p, smh, 32); break;
    case 20: ph_moe_down(p, smh, 1, 32); break;
    case 21: ph_final(p); break;
  }
}

__global__ void __launch_bounds__(256, 2) mega(Params p, int ph_lo, int ph_hi) {
  extern __shared__ __attribute__((aligned(16))) unsigned char smem[];
  cg::grid_group grid = cg::this_grid();
  __shared__ __attribute__((aligned(16))) unsigned xb_words[4];
  if (threadIdx.x < 4) xb_words[threadIdx.x] = 0u;
  __syncthreads();
  XcdBarrier xb = xcd_barrier_post((unsigned*)(p.ws + O_BAR), (volatile LAS unsigned*)&xb_words);
  if (ph_lo > ph_hi) grid.sync();
#define GSYNC(POS) { xcd_barrier(xb); }
#ifdef PROBE_LO
  long long pt0 = 0;
#define PHC(POS, N) { if (POS > 0) GSYNC(POS) \
    if (POS == PROBE_HI + 1) { long long t1 = wall_clock64(); long long dl = t1 - pt0; while (wall_clock64() - t1 < dl) {} } \
    if (POS == PROBE_LO) pt0 = wall_clock64(); run_phase(p, N, smem); }
#else
#define PHC(POS, N) { if (POS > 0) GSYNC(POS) run_phase(p, N, smem); }
#endif
  PHC(0, 0) PHC(1, 1) PHC(2, 2) PHC(3, 3) PHC(4, 4) PHC(5, 5) PHC(6, 26) PHC(7, 6) PHC(8, 7) PHC(9, 8) PHC(10, 9) PHC(11, 10) PHC(12, 11)
  PHC(13, 12) PHC(14, 13) PHC(15, 22) PHC(16, 23) PHC(17, 14) PHC(18, 15) PHC(19, 16) PHC(20, 17)
  PHC(21, 18) PHC(22, 19) PHC(23, 20) PHC(24, 21)
#ifdef PROBE_LO
  PHC(25, 99)
#endif
#undef PHC
}

extern "C" void kernel_launch(void* const* d_in, const int* in_sizes, int n_in, void* d_out, int out_size,
                              void* d_ws, size_t ws_size, hipStream_t stream) {
  static int grid_blocks = 0;
  if (!grid_blocks) {
    int dev = 0, cus = 0, per_cu = 0;
    (void)hipGetDevice(&dev);
    (void)hipDeviceGetAttribute(&cus, hipDeviceAttributeMultiprocessorCount, dev);
    (void)hipFuncSetAttribute((const void*)mega, hipFuncAttributeMaxDynamicSharedMemorySize, SMEM_BYTES);
    (void)hipOccupancyMaxActiveBlocksPerMultiprocessor(&per_cu, mega, 256, SMEM_BYTES);
    if (per_cu > 2) per_cu = 2;
    if (per_cu < 1) per_cu = 1;
    grid_blocks = cus * per_cu;
  }
  Params p{};
  for (int i = 0; i < 44; ++i) p.in[i] = (const float*)d_in[i];
  p.out = (float*)d_out; p.ws = (unsigned char*)d_ws;
  int lo = 0, hi = 23;
  (void)hipMemsetAsync((unsigned char*)d_ws + O_BAR, 0, XCD_BAR_WORDS * 4, stream);
  void* args[] = {&p, &lo, &hi};
  hipError_t e = hipLaunchCooperativeKernel((void*)mega, dim3(grid_blocks), dim3(256), args, SMEM_BYTES, stream);
  if (e != hipSuccess) fprintf(stderr, "cooperative launch failed: %s (grid %d)\n", hipGetErrorString(e), grid_blocks);
}
```

```cpp
#include <hip/hip_runtime.h>
#include <hip/hip_bf16.h>
#include <hip/hip_cooperative_groups.h>
#include <cstdio>
#include <cstdint>
namespace cg = cooperative_groups;

typedef unsigned short u16;
using bf16x8 = __attribute__((ext_vector_type(8))) short;
using f32x4 = __attribute__((ext_vector_type(4))) float;
using u32x4 = __attribute__((ext_vector_type(4))) uint32_t;
#define DEVI __device__ __forceinline__
__device__ __forceinline__ int tid_opaque() { int t = threadIdx.x; asm volatile("" : "+v"(t)); return t; }
#define TIDX tid_opaque()

constexpr int NL = 32768, NC = 2048, NT = 34816;
constexpr size_t AL(size_t x) { return (x + 255) & ~(size_t)255; }
constexpr size_t EXPSZ = 16ull * 1536 * 1024;
constexpr size_t O_WIN0 = 0;
constexpr size_t O_WIN1 = O_WIN0 + AL(2560ull * 1024 * 2);
constexpr size_t O_WOUT = O_WIN1 + AL(3072ull * 1024 * 2);
constexpr size_t O_WGLU = O_WOUT + AL(2ull * 1024 * 1024 * 2);
constexpr size_t O_WEXP = O_WGLU + AL(512ull * 512 * 2);
constexpr size_t O_MOD = O_WEXP + AL(3 * EXPSZ * 2);
constexpr size_t O_HB = O_MOD + AL(2ull * 9 * 6144 * 4);
constexpr size_t O_U = O_HB + AL((size_t)NT * 1024 * 2);
constexpr size_t O_XC = O_U + AL((size_t)NT * 3072 * 2);
constexpr size_t O_VXL = O_XC + AL((size_t)NC * 1024 * 4);
constexpr size_t O_VXC = O_VXL + AL(3ull * 8 * 512 * 4096 * 2);
constexpr size_t O_Z1L = O_VXC + AL(3ull * 8 * 512 * 256 * 2);
constexpr size_t O_Z1C = O_Z1L + AL(8ull * 512 * 4096 * 2);
constexpr size_t O_HYEND = O_Z1C + AL(8ull * 512 * 256 * 2);
constexpr size_t O_OF = O_VXL;
constexpr size_t O_OB = O_OF + (size_t)NL * 512 * 4;
static_assert(O_OB + (size_t)NL * 512 * 4 <= O_HYEND, "alias");
constexpr size_t O_FRAWL = O_HYEND;
constexpr size_t O_FRAWC = O_FRAWL + AL(4096ull * 1024 * 4);
constexpr size_t O_CSUM = O_FRAWC + AL(256ull * 1024 * 4);
constexpr int GLS = 4096 + 128, GCS = 256 + 128;
constexpr size_t O_GL = O_CSUM + AL(272ull * 1024 * 4);
constexpr size_t O_GC = O_GL + AL(2ull * 1024 * GLS * 2);
constexpr size_t O_Y5F = O_GC + AL(2ull * 1024 * GCS * 2);
constexpr size_t O_Y5B = O_Y5F + AL((size_t)NL * 512 * 2);
constexpr size_t O_Y5 = O_Y5B + AL((size_t)NL * 512 * 2);
constexpr size_t O_AFF = O_Y5 + AL((size_t)NL * 512 * 2);
constexpr size_t O_STOK = O_AFF + AL((size_t)NT * 16 * 4);
constexpr size_t O_SGATE = O_STOK + AL(16ull * 4352 * 4);
constexpr size_t O_AGP = O_SGATE + AL(16ull * 4352 * 4);
constexpr size_t O_AGS = O_AGP + AL(2ull * 544 * 512 * 4);
constexpr size_t O_HS = O_AGS + AL(2ull * 544 * 512 * 4);
constexpr size_t O_END = O_HS + AL(2ull * 544 * 512 * 4);
constexpr size_t O_OUTB = O_VXL;
constexpr size_t O_INV = O_END;
constexpr size_t O_WLT = O_INV + AL((size_t)NT * 16 * 4);
constexpr size_t O_END1 = O_WLT + AL(2ull * 8 * 128 * 64 * 2);
constexpr int SMEM_BYTES = 71680;

struct Params {
  const float* in[44];
  float* out;
  unsigned char* ws;
};

DEVI u16 f2bf(float f) { uint32_t u = __float_as_uint(f); u += 0x7fffu + ((u >> 16) & 1u); return (u16)(u >> 16); }
DEVI float bf2f(u16 h) { return __uint_as_float(((uint32_t)h) << 16); }
DEVI uint32_t pack2(float a, float b) { return (uint32_t)f2bf(a) | ((uint32_t)f2bf(b) << 16); }
DEVI void unpack8(const uint4& x, float (&v)[8]) {
  v[0] = bf2f((u16)(x.x & 0xffff)); v[1] = bf2f((u16)(x.x >> 16)); v[2] = bf2f((u16)(x.y & 0xffff)); v[3] = bf2f((u16)(x.y >> 16));
  v[4] = bf2f((u16)(x.z & 0xffff)); v[5] = bf2f((u16)(x.z >> 16)); v[6] = bf2f((u16)(x.w & 0xffff)); v[7] = bf2f((u16)(x.w >> 16));
}

DEVI float sigm(float x) { return 1.f / (1.f + __expf(-x)); }
DEVI float siluf(float x) { return x * sigm(x); }
DEVI float geluf(float x) { float u = 0.7978845608028654f * (x + 0.044715f * x * x * x); return 0.5f * x * (1.f + tanhf(u)); }
DEVI float wsum(float v) { for (int o = 32; o > 0; o >>= 1) v += __shfl_xor(v, o); return v; }

DEVI void prep_tile(const float* src, int K, int N, u16* dst, int tile_id, float* tile) {
  int tpm = (K / 64) * (N / 64);
  int mat = tile_id / tpm, t = tile_id % tpm;
  int kt = t / (N / 64), nt = t % (N / 64);
  src += (size_t)mat * K * N; dst += (size_t)mat * K * N;
  int k0 = kt * 64, n0 = nt * 64, tid = TIDX;
  int r = tid >> 4, c4 = (tid & 15) * 4;
#pragma unroll
  for (int i = 0; i < 4; ++i) {
    int k = r + 16 * i;
    float4 v = *(const float4*)(src + (size_t)(k0 + k) * N + n0 + c4);
    tile[k * 65 + c4 + 0] = v.x; tile[k * 65 + c4 + 1] = v.y; tile[k * 65 + c4 + 2] = v.z; tile[k * 65 + c4 + 3] = v.w;
  }
  __syncthreads();
  int n = tid >> 3, kc = (tid & 7) * 8;
#pragma unroll
  for (int i = 0; i < 2; ++i) {
    int nn = n + 32 * i;
    uint4 o;
    o.x = pack2(tile[(kc + 0) * 65 + nn], tile[(kc + 1) * 65 + nn]);
    o.y = pack2(tile[(kc + 2) * 65 + nn], tile[(kc + 3) * 65 + nn]);
    o.z = pack2(tile[(kc + 4) * 65 + nn], tile[(kc + 5) * 65 + nn]);
    o.w = pack2(tile[(kc + 6) * 65 + nn], tile[(kc + 7) * 65 + nn]);
    *(uint4*)(dst + (size_t)(n0 + nn) * K + k0 + kc) = o;
  }
  __syncthreads();
}

DEVI void prep_tile128(const float* src, int K, int N, u16* dst, int tile_id, float* tile) {
  int tpm = (K / 128) * (N / 128);
  int mat = tile_id / tpm, t = tile_id % tpm;
  int kt = t / (N / 128), nt = t % (N / 128);
  src += (size_t)mat * K * N; dst += (size_t)mat * K * N;
  int k0 = kt * 128, n0 = nt * 128, tid = TIDX;
  int r = tid >> 5, c4 = (tid & 31) * 4;
#pragma unroll 4
  for (int i = 0; i < 16; ++i) {
    int k = r + 8 * i;
    float4 v = *(const float4*)(src + (size_t)(k0 + k) * N + n0 + c4);
    tile[k * 129 + c4 + 0] = v.x; tile[k * 129 + c4 + 1] = v.y; tile[k * 129 + c4 + 2] = v.z; tile[k * 129 + c4 + 3] = v.w;
  }
  __syncthreads();
  int n = tid >> 4, kc = (tid & 15) * 8;
#pragma unroll 2
  for (int i = 0; i < 8; ++i) {
    int nn = n + 16 * i;
    uint4 o;
    o.x = pack2(tile[(kc + 0) * 129 + nn], tile[(kc + 1) * 129 + nn]);
    o.y = pack2(tile[(kc + 2) * 129 + nn], tile[(kc + 3) * 129 + nn]);
    o.z = pack2(tile[(kc + 4) * 129 + nn], tile[(kc + 5) * 129 + nn]);
    o.w = pack2(tile[(kc + 6) * 129 + nn], tile[(kc + 7) * 129 + nn]);
    *(uint4*)(dst + (size_t)(n0 + nn) * K + k0 + kc) = o;
  }
  __syncthreads();
}

DEVI void prep_experts(const Params& p, int layer, int it, float* tile) {
  u16* wexp = (u16*)(p.ws + O_WEXP);
  int kind = it / 6144, t = it % 6144;
  if (kind == 0) prep_tile(p.in[40] + (size_t)layer * EXPSZ, 1024, 1536, wexp, t, tile);
  else if (kind == 1) prep_tile(p.in[41] + (size_t)layer * EXPSZ, 1024, 1536, wexp + EXPSZ, t, tile);
  else prep_tile(p.in[42] + (size_t)layer * EXPSZ, 1536, 1024, wexp + 2 * EXPSZ, t, tile);
}

DEVI void mod_item(const Params& p, int it, float* sm) {
  int l = it / 96, j0 = (it % 96) * 64, tid = TIDX;
  float* sc = sm;
  float* red = sm + 9 * 1024;
  for (int i = tid; i < 9 * 1024; i += 256) {
    int r = i >> 10, k = i & 1023;
    float v = (r < 8) ? p.in[1][r * 1024 + k] : p.in[3][k];
    sc[i] = siluf(v);
  }
  __syncthreads();
  int col = tid & 63, kq = tid >> 6;
  float acc[9];
#pragma unroll
  for (int r = 0; r < 9; ++r) acc[r] = 0.f;
  const float* w = p.in[4] + (size_t)l * 1024 * 6144 + j0 + col;
#pragma unroll 8
  for (int k = kq * 256; k < kq * 256 + 256; ++k) {
    float wv = w[(size_t)k * 6144];
#pragma unroll
    for (int r = 0; r < 9; ++r) acc[r] += sc[r * 1024 + k] * wv;
  }
#pragma unroll
  for (int r = 0; r < 9; ++r) red[(kq * 9 + r) * 64 + col] = acc[r];
  __syncthreads();
  float* mod = (float*)(p.ws + O_MOD);
  for (int i = tid; i < 9 * 64; i += 256) {
    int r = i >> 6, c = i & 63;
    float s = red[(0 * 9 + r) * 64 + c] + red[(1 * 9 + r) * 64 + c] + red[(2 * 9 + r) * 64 + c] + red[(3 * 9 + r) * 64 + c];
    mod[((size_t)l * 9 + r) * 6144 + j0 + c] = s + p.in[5][l * 6144 + j0 + c];
  }
  __syncthreads();
}

DEVI void filt_item(const Params& p, int it, float* sm) {
  int L, t0, blk; float* fraw;
  if (it < 256) { L = 4096; t0 = it * 16; blk = it; fraw = (float*)(p.ws + O_FRAWL); }
  else { L = 256; t0 = (it - 256) * 16; blk = it; fraw = (float*)(p.ws + O_FRAWC); }
  float* z = sm;
  float* h1 = sm + 16 * 33;
  float* h2 = h1 + 16 * 64;
  int tid = TIDX;
  const float* w1 = p.in[19]; const float* b1 = p.in[20]; const float* w2 = p.in[21]; const float* b2 = p.in[22];
  const float* w3 = p.in[23]; const float* fr = p.in[24];
  for (int i = tid; i < 16 * 33; i += 256) {
    int pos = i / 33, c = i % 33;
    float t = (float)(t0 + pos);
    float v;
    if (c == 0) v = t / (float)(L - 1);
    else {
      int bi = (c - 1) & 15;
      float band = 1e-4f + (float)bi * ((15.f - 1e-4f) / 15.f);
      float ang = ((6.283185307179586f / (float)L) * t) * band;
      v = (c <= 16) ? cosf(ang) : -sinf(ang);
    }
    z[i] = v;
  }
  __syncthreads();
  for (int i = tid; i < 16 * 64; i += 256) {
    int pos = i >> 6, j = i & 63;
    float s = b1[j];
#pragma unroll 3
    for (int k = 0; k < 33; ++k) s += z[pos * 33 + k] * w1[k * 64 + j];
    h1[i] = sinf(fr[j] * s);
  }
  __syncthreads();
  for (int i = tid; i < 16 * 64; i += 256) {
    int pos = i >> 6, j = i & 63;
    float s = b2[j];
#pragma unroll 4
    for (int k = 0; k < 64; ++k) s += h1[pos * 64 + k] * w2[k * 64 + j];
    h2[i] = sinf(fr[j] * s);
  }
  __syncthreads();
  float* csum = (float*)(p.ws + O_CSUM);
  const float dmin = -3.0701134573253946f, dmax = -15.350567286626973f;
#pragma unroll 1
  for (int cc = 0; cc < 4; ++cc) {
    int col = tid + 256 * cc;
    float acc[16];
#pragma unroll
    for (int q = 0; q < 16; ++q) acc[q] = 0.f;
#pragma unroll 8
    for (int k = 0; k < 64; ++k) {
      float wv = w3[k * 1024 + col];
#pragma unroll
      for (int q = 0; q < 16; ++q) acc[q] += h2[q * 64 + k] * wv;
    }
    float delta = fabsf(dmin + (float)col * ((dmax - dmin) / 1023.f));
    float ss = 0.f;
#pragma unroll
    for (int q = 0; q < 16; ++q) {
      float t = (float)(t0 + q);
      float dist = fabsf(t - (float)(L / 2)) / ((float)L * 0.5f);
      float v = acc[q] * expf(-dist * delta);
      fraw[(size_t)(t0 + q) * 1024 + col] = v;
      ss += v * v;
    }
    csum[(size_t)blk * 1024 + col] = ss;
  }
  __syncthreads();
}

DEVI void filtfin_item(const Params& p, int it, float* sm) {
  int L, gs, ct, mt, nb, b0; const float* fraw; u16* G;
  if (it < 16 * 66) { L = 4096; gs = GLS; ct = it / 66; mt = it % 66; nb = 256; b0 = 0; fraw = (const float*)(p.ws + O_FRAWL); G = (u16*)(p.ws + O_GL); }
  else { int j = it - 16 * 66; L = 256; gs = GCS; ct = j / 6; mt = j % 6; nb = 16; b0 = 256; fraw = (const float*)(p.ws + O_FRAWC); G = (u16*)(p.ws + O_GC); }
  float* scale = sm;
  float* red = sm + 64;
  float* tile = sm + 64 + 256;
  int tid = TIDX, c0 = ct * 64, m0 = mt * 64;
  const float* csum = (const float*)(p.ws + O_CSUM);
  {
    int c = tid & 63, q = tid >> 6;
    float s = 0.f;
#pragma unroll 8
    for (int b = q; b < nb; b += 4) s += csum[(size_t)(b0 + b) * 1024 + c0 + c];
    red[q * 64 + c] = s;
  }
  __syncthreads();
  if (tid < 64) scale[tid] = rsqrtf(red[tid] + red[64 + tid] + red[128 + tid] + red[192 + tid] + 1e-6f);
  int thi = L + 63 - m0;
  for (int i = tid; i < 65 * 64; i += 256) {
    int rr = i >> 6, c = i & 63;
    int t = thi - rr;
    tile[rr * 65 + c] = (t >= 0 && t < L) ? fraw[(size_t)t * 1024 + c0 + c] : 0.f;
  }
  __syncthreads();
  for (int i = tid; i < 2 * 64 * 8; i += 256) {
    int m8 = (i & 7) * 8, c = (i >> 3) & 63, par = i >> 9;
    float sc = scale[c];
    uint4 o;
    o.x = pack2(tile[(m8 + 0 + par) * 65 + c] * sc, tile[(m8 + 1 + par) * 65 + c] * sc);
    o.y = pack2(tile[(m8 + 2 + par) * 65 + c] * sc, tile[(m8 + 3 + par) * 65 + c] * sc);
    o.z = pack2(tile[(m8 + 4 + par) * 65 + c] * sc, tile[(m8 + 5 + par) * 65 + c] * sc);
    o.w = pack2(tile[(m8 + 6 + par) * 65 + c] * sc, tile[(m8 + 7 + par) * 65 + c] * sc);
    *(uint4*)(G + ((size_t)par * 1024 + c0 + c) * gs + m0 + m8) = o;
  }
  __syncthreads();
}

DEVI void moe_combine(const Params& p, int r, int lane, float4 (&v)[4]) {
  const int* inv = (const int*)(p.ws + O_INV) + (size_t)r * 16;
  const u16* ob = (const u16*)(p.ws + O_OUTB);
  int myslot = (lane < 16) ? inv[lane] : -1;
  unsigned long long mask = __ballot(myslot >= 0);
  while (mask) {
    int e0 = __ffsll((long long)mask) - 1; mask &= mask - 1;
    int s0 = __shfl(myslot, e0);
    int e1 = -1, s1 = 0;
    if (mask) { e1 = __ffsll((long long)mask) - 1; mask &= mask - 1; s1 = __shfl(myslot, e1); }
    const u16* r0 = ob + ((size_t)e0 * 4352 + s0) * 1024 + lane * 4;
    uint2 q0[4], q1[4];
#pragma unroll
    for (int i = 0; i < 4; ++i) q0[i] = *(const uint2*)(r0 + 256 * i);
    if (e1 >= 0) {
      const u16* r1 = ob + ((size_t)e1 * 4352 + s1) * 1024 + lane * 4;
#pragma unroll
      for (int i = 0; i < 4; ++i) q1[i] = *(const uint2*)(r1 + 256 * i);
    } else {
#pragma unroll
      for (int i = 0; i < 4; ++i) q1[i] = make_uint2(0u, 0u);
    }
#pragma unroll
    for (int i = 0; i < 4; ++i) {
      v[i].x += bf2f((u16)(q0[i].x & 0xffff)); v[i].y += bf2f((u16)(q0[i].x >> 16)); v[i].z += bf2f((u16)(q0[i].y & 0xffff)); v[i].w += bf2f((u16)(q0[i].y >> 16));
      v[i].x += bf2f((u16)(q1[i].x & 0xffff)); v[i].y += bf2f((u16)(q1[i].x >> 16)); v[i].z += bf2f((u16)(q1[i].y & 0xffff)); v[i].w += bf2f((u16)(q1[i].y >> 16));
    }
  }
}

DEVI void ph_norm(const Params& p, int layer, int which, bool with_ctx, bool perm, bool router, bool combine, float* smf) {
  const float* xl = (layer == 0 && which == 1) ? p.in[0] : p.out;
  const float* xc = (layer == 0 && which == 1) ? p.in[2] : (const float*)(p.ws + O_XC);
  const float* g = p.in[which == 1 ? 6 : 7] + layer * 1024;
  const float* mod = (const float*)(p.ws + O_MOD) + (size_t)layer * 9 * 6144;
  int sh = (which == 1) ? 0 : 3;
  u16* hb = (u16*)(p.ws + O_HB);
  float* aff = (float*)(p.ws + O_AFF);
  const float* rw = p.in[39] + (size_t)layer * 1024 * 16;
  int lane = TIDX & 63, wave = TIDX >> 6;
  int nrows = with_ctx ? NT : NL;
  float4* rws = (float4*)smf;
  if (router) {
    for (int i = TIDX; i < 4096; i += 256) {
      int k = i >> 2, e4 = i & 3;
      rws[((e4 * 4 + (k & 3)) * 4 + (k >> 8)) * 64 + ((k >> 2) & 63)] = *(const float4*)(rw + (size_t)k * 16 + e4 * 4);
    }
    __syncthreads();
  }
  for (int r = blockIdx.x * 4 + wave; r < nrows; r += gridDim.x * 4) {
    const float* src; int mr; size_t drow;
    if (r < NL) {
      src = xl + (size_t)r * 1024; mr = r >> 12;
      if (perm) { int t = r & 4095; drow = (size_t)(r & ~4095) + (t & 63) * 64 + (t >> 6); } else drow = r;
    } else { src = xc + (size_t)(r - NL) * 1024; mr = 8; drow = r; }
    float4 v[4]; float ss = 0.f;
#pragma unroll
    for (int i = 0; i < 4; ++i) v[i] = *(const float4*)(src + lane * 4 + 256 * i);
    if (combine) {
      moe_combine(p, r, lane, v);
      float* wb = (float*)src;
#pragma unroll
      for (int i = 0; i < 4; ++i) *(float4*)(wb + lane * 4 + 256 * i) = v[i];
    }
#pragma unroll
    for (int i = 0; i < 4; ++i) ss += v[i].x * v[i].x + v[i].y * v[i].y + v[i].z * v[i].z + v[i].w * v[i].w;
    ss = wsum(ss);
    float rs = rsqrtf(ss * (1.f / 1024.f) + 1e-6f);
    const float* shp = mod + (size_t)mr * 6144 + sh * 1024;
    const float* scp = shp + 1024;
    float lg[16];
    if (router) {
#pragma unroll
      for (int e = 0; e < 16; ++e) lg[e] = 0.f;
    }
#pragma unroll
    for (int i = 0; i < 4; ++i) {
      int k = lane * 4 + 256 * i;
      float4 gg = *(const float4*)(g + k), s4 = *(const float4*)(shp + k), c4 = *(const float4*)(scp + k);
      float h0 = (v[i].x * rs * gg.x) * (1.f + c4.x) + s4.x;
      float h1 = (v[i].y * rs * gg.y) * (1.f + c4.y) + s4.y;
      float h2 = (v[i].z * rs * gg.z) * (1.f + c4.z) + s4.z;
      float h3 = (v[i].w * rs * gg.w) * (1.f + c4.w) + s4.w;
      uint2 o; o.x = pack2(h0, h1); o.y = pack2(h2, h3);
      *(uint2*)(hb + drow * 1024 + k) = o;
      if (router) {
        float hh[4] = {h0, h1, h2, h3};
#pragma unroll
        for (int q = 0; q < 4; ++q) {
#pragma unroll
          for (int e4 = 0; e4 < 4; ++e4) {
            float4 w = rws[((e4 * 4 + q) * 4 + i) * 64 + lane];
            lg[e4 * 4 + 0] += hh[q] * w.x; lg[e4 * 4 + 1] += hh[q] * w.y; lg[e4 * 4 + 2] += hh[q] * w.z; lg[e4 * 4 + 3] += hh[q] * w.w;
          }
          __builtin_amdgcn_sched_barrier(0);
        }
      }
    }
    if (router) {
      float mx = -1e30f;
#pragma unroll
      for (int e = 0; e < 16; ++e) { lg[e] = wsum(lg[e]); mx = fmaxf(mx, lg[e]); }
      float den = 0.f;
#pragma unroll
      for (int e = 0; e < 16; ++e) { lg[e] = expf(lg[e] - mx); den += lg[e]; }
      float inv = 1.f / den;
      float mine = 0.f;
#pragma unroll
      for (int e = 0; e < 16; ++e) if (lane == e) mine = lg[e] * inv;
      if (lane < 16) aff[(size_t)r * 16 + lane] = mine;
    }
  }
}

DEVI int vbid() { int nb = gridDim.x; return ((nb & 7) == 0) ? (int)((blockIdx.x & 7) * (nb >> 3) + (blockIdx.x >> 3)) : (int)blockIdx.x; }

DEVI uint32_t gemm_boff(int i, uint32_t ldb) { return ldb ? (uint32_t)i * 32u * ldb : (((i & 3) < 2) ? 0u : (uint32_t)EXPSZ) + (uint32_t)((i >> 2) * 64 + 32 * (i & 1)) * 1024u; }
template <bool GATHER>
DEVI void gemm_core(u16* sm, const u16* Ab, const uint32_t (&pa)[4], uint32_t lda, const u16* Bb, uint32_t pb0, uint32_t ldb, int K, f32x4 (&acc)[8][4]) {
  u16* As = sm; u16* Bs = sm + 128 * 72;
  int tid = TIDX, lane = tid & 63, wid = tid >> 6, wr = wid >> 1, wc = wid & 1;
  int fr = lane & 15, fq = lane >> 4;
  int lrow = tid >> 3, lkc = (tid & 7) * 8;
  u32x4 ra[4], rb[8];
#pragma unroll
  for (int i = 0; i < 4; ++i) ra[i] = *(const u32x4*)(Ab + (GATHER ? pa[i] : pa[0] + (uint32_t)i * 32u * lda));
#pragma unroll
  for (int i = 0; i < 8; ++i) rb[i] = *(const u32x4*)(Bb + pb0 + gemm_boff(i, ldb));
#pragma unroll
  for (int a = 0; a < 8; ++a)
#pragma unroll
    for (int b = 0; b < 4; ++b) acc[a][b] = (f32x4){0.f, 0.f, 0.f, 0.f};
  int nk = K >> 6;
  for (int kt = 0; kt < nk; ++kt) {
    __syncthreads();
#pragma unroll
    for (int i = 0; i < 4; ++i) *(u32x4*)(As + (lrow + 32 * i) * 72 + lkc) = ra[i];
#pragma unroll
    for (int i = 0; i < 8; ++i) *(u32x4*)(Bs + (lrow + 32 * i) * 72 + lkc) = rb[i];
    __syncthreads();
    if (kt + 1 < nk) {
#pragma unroll
      for (int i = 0; i < 4; ++i) ra[i] = *(const u32x4*)(Ab + (GATHER ? pa[i] : pa[0] + (uint32_t)i * 32u * lda) + (kt + 1) * 64);
#pragma unroll
      for (int i = 0; i < 8; ++i) rb[i] = *(const u32x4*)(Bb + pb0 + gemm_boff(i, ldb) + (kt + 1) * 64);
    }
    __builtin_amdgcn_sched_barrier(0);
#pragma unroll
    for (int ks = 0; ks < 2; ++ks) {
      bf16x8 af[4];
#pragma unroll
      for (int m = 0; m < 4; ++m) af[m] = *(const bf16x8*)(As + (wr * 64 + m * 16 + fr) * 72 + ks * 32 + fq * 8);
#pragma unroll
      for (int nh = 0; nh < 4; ++nh) {
        bf16x8 bfm[2];
#pragma unroll
        for (int n = 0; n < 2; ++n) bfm[n] = *(const bf16x8*)(Bs + (wc * 128 + (nh * 2 + n) * 16 + fr) * 72 + ks * 32 + fq * 8);
#pragma unroll
        for (int n = 0; n < 2; ++n)
#pragma unroll
          for (int m = 0; m < 4; ++m) acc[nh * 2 + n][m] = __builtin_amdgcn_mfma_f32_16x16x32_bf16(bfm[n], af[m], acc[nh * 2 + n][m], 0, 0, 0);
      }
      __builtin_amdgcn_sched_barrier(0);
    }
  }
  __syncthreads();
}

DEVI void ph_gemm_in(const Params& p, u16* sm, const u16* Wt, int N) {
  const u16* H = (const u16*)(p.ws + O_HB);
  u16* U = (u16*)(p.ws + O_U);
  int ntl = N / 256, nitems = 272 * ntl;
  int tid = TIDX, lane = tid & 63, wid = tid >> 6, wr = wid >> 1, wc = wid & 1, fr = lane & 15, fq = lane >> 4;
  int lr = tid >> 3, kc = (tid & 7) * 8;
  int gsz = (ntl == 10) ? 5 : 4;
  for (int it = vbid(); it < nitems; it += gridDim.x) {
    int ng = it / (272 * gsz), rem = it % (272 * gsz);
    int m0 = (rem / gsz) * 128, n0 = (ng * gsz + rem % gsz) * 256;
    uint32_t pa[4], pb0 = (uint32_t)(n0 + lr) * 1024u + kc;
#pragma unroll
    for (int i = 0; i < 4; ++i) pa[i] = (uint32_t)(m0 + lr + 32 * i) * 1024u + kc;
    f32x4 acc[8][4];
    gemm_core<false>(sm, H, pa, 1024u, Wt, pb0, 1024u, 1024, acc);
#pragma unroll
    for (int n = 0; n < 8; ++n)
#pragma unroll
      for (int m = 0; m < 4; ++m) {
        int row = m0 + wr * 64 + m * 16 + fr, col = n0 + wc * 128 + n * 16 + fq * 4;
        uint2 o; o.x = pack2(acc[n][m][0], acc[n][m][1]); o.y = pack2(acc[n][m][2], acc[n][m][3]);
        *(uint2*)(U + (size_t)row * N + col) = o;
      }
  }
}

DEVI void ph_gemm_out(const Params& p, u16* sm, int layer) {
  const u16* Y = (const u16*)(p.ws + O_HB);
  const u16* Wt = (const u16*)(p.ws + O_WOUT) + (size_t)layer * 1024 * 1024;
  const float* mod = (const float*)(p.ws + O_MOD) + (size_t)layer * 9 * 6144 + 2 * 1024;
  float* xcw = (float*)(p.ws + O_XC);
  int mtiles = (layer == 0) ? 272 : 256, nitems = mtiles * 4;
  int tid = TIDX, lane = tid & 63, wid = tid >> 6, wr = wid >> 1, wc = wid & 1, fr = lane & 15, fq = lane >> 4;
  int lr = tid >> 3, kc = (tid & 7) * 8;
  for (int it = vbid(); it < nitems; it += gridDim.x) {
    int m0 = (it / 4) * 128, n0 = (it % 4) * 256;
    uint32_t pa[4], pb0 = (uint32_t)(n0 + lr) * 1024u + kc;
#pragma unroll
    for (int i = 0; i < 4; ++i) pa[i] = (uint32_t)(m0 + lr + 32 * i) * 1024u + kc;
    f32x4 acc[8][4];
    gemm_core<false>(sm, Y, pa, 1024u, Wt, pb0, 1024u, 1024, acc);
#pragma unroll
    for (int m = 0; m < 4; ++m) {
      int r = m0 + wr * 64 + m * 16 + fr;
      const float* xin; float* dst; int mr;
      if (r < NL) {
        mr = r >> 12; size_t tok = r;
        if (layer == 1) { int pp = r & 4095; tok = (size_t)(r & ~4095) + (pp & 63) * 64 + (pp >> 6); }
        xin = ((layer == 0) ? p.in[0] : (const float*)p.out) + tok * 1024; dst = p.out + tok * 1024;
      } else { mr = 8; size_t cr = r - NL; xin = p.in[2] + cr * 1024; dst = xcw + cr * 1024; }
      const float* gl = mod + (size_t)mr * 6144;
#pragma unroll
      for (int n = 0; n < 8; ++n) {
        int col = n0 + wc * 128 + n * 16 + fq * 4;
        float4 xv = *(const float4*)(xin + col), gv = *(const float4*)(gl + col);
        float4 o = make_float4(xv.x + gv.x * acc[n][m][0], xv.y + gv.y * acc[n][m][1], xv.z + gv.z * acc[n][m][2], xv.w + gv.w * acc[n][m][3]);
        *(float4*)(dst + col) = o;
      }
    }
  }
}
DEVI void lru_gates(const Params& p, const float* xh, const u16* xhb, float* z, int dir, int h, int j, int tg, float (&a)[16], float (&bb)[16]) {
  int lane = TIDX & 63, w = TIDX >> 6, fr = lane & 15, fq = lane >> 4;
  const u16* WL = (const u16*)(p.ws + O_WLT) + (size_t)((dir * 8 + h) * 128) * 64;
  f32x4 acc[2][4];
#pragma unroll
  for (int n = 0; n < 2; ++n)
#pragma unroll
    for (int m = 0; m < 4; ++m) acc[n][m] = (f32x4){0.f, 0.f, 0.f, 0.f};
#pragma unroll
  for (int ks = 0; ks < 2; ++ks) {
    bf16x8 wf[2], xf[4];
#pragma unroll
    for (int n = 0; n < 2; ++n) wf[n] = *(const bf16x8*)(WL + ((2 * w + n) * 16 + fr) * 64 + ks * 32 + fq * 8);
#pragma unroll
    for (int m = 0; m < 4; ++m) xf[m] = *(const bf16x8*)(xhb + (m * 16 + fr) * 72 + ks * 32 + fq * 8);
#pragma unroll
    for (int n = 0; n < 2; ++n)
#pragma unroll
      for (int m = 0; m < 4; ++m) acc[n][m] = __builtin_amdgcn_mfma_f32_16x16x32_bf16(wf[n], xf[m], acc[n][m], 0, 0, 0);
  }
#pragma unroll
  for (int n = 0; n < 2; ++n)
#pragma unroll
    for (int m = 0; m < 4; ++m)
      *(float4*)(z + (m * 16 + fr) * 132 + (2 * w + n) * 16 + 4 * fq) = make_float4(acc[n][m][0], acc[n][m][1], acc[n][m][2], acc[n][m][3]);
  __syncthreads();
  int gi = (dir * 8 + h) * 64 + j;
  float bav = p.in[13][gi], bxv = p.in[15][gi], lam = p.in[16][gi];
  float sp = log1pf(expf(-lam));
#pragma unroll
  for (int q = 0; q < 16; ++q) {
    int tok = tg * 16 + q;
    float r = sigm(z[tok * 132 + j] + bav), ig = sigm(z[tok * 132 + 64 + j] + bxv);
    float la = -8.f * r * sp;
    a[q] = __expf(la);
    bb[q] = sqrtf(1.f - __expf(2.f * la)) * ig * xh[tok * 64 + j];
  }
  __syncthreads();
}

DEVI void lru_item(const Params& p, int it, unsigned char* smem, int mode) {
  int ci = it >> 3, h = it & 7;
  int rowbase, t0, slen;
  if (ci < 512) { rowbase = (ci >> 6) * 4096; t0 = (ci & 63) * 64; slen = 4096; }
  else { int cc = ci - 512; rowbase = NL + (cc >> 2) * 256; t0 = (cc & 3) * 64; slen = 256; }
  const u16* U = (const u16*)(p.ws + O_U);
  float* xh = (float*)smem;
  u16* xhb = (u16*)(smem + 16384);
  float* z = (float*)(smem + 25600);
  float* xraw = z;
  float* agg = (float*)(smem + 59392);
  int tid = TIDX, j = tid & 63, tg = tid >> 6;
  for (int i = tid; i < 67 * 8; i += 256) {
    int rr = i >> 3, c8 = (i & 7) * 8, t = t0 - 1 + rr;
    float v8[8];
    if (t >= 0 && t < slen) unpack8(*(const uint4*)(U + (size_t)(rowbase + t) * 2560 + h * 64 + c8), v8);
    else { for (int k = 0; k < 8; ++k) v8[k] = 0.f; }
#pragma unroll
    for (int k = 0; k < 8; ++k) xraw[rr * 64 + c8 + k] = v8[k];
  }
  __syncthreads();
  {
    const float* cw = p.in[10]; int ch = h * 64 + j;
    float w0 = cw[ch], w1 = cw[512 + ch], w2 = cw[1024 + ch], w3 = cw[1536 + ch], cb = p.in[11][ch];
#pragma unroll
    for (int q = 0; q < 16; ++q) {
      int t = tg * 16 + q;
      float v = cb + w0 * xraw[t * 64 + j] + w1 * xraw[(t + 1) * 64 + j] + w2 * xraw[(t + 2) * 64 + j] + w3 * xraw[(t + 3) * 64 + j];
      xh[t * 64 + j] = v; xhb[t * 72 + j] = f2bf(v);
    }
  }
  __syncthreads();
  float af[16], bf_[16], ab[16], bk[16];
  lru_gates(p, xh, xhb, z, 0, h, j, tg, af, bf_);
  lru_gates(p, xh, xhb, z, 1, h, j, tg, ab, bk);
  {
    float P = 1.f, S = 0.f;
#pragma unroll
    for (int q = 0; q < 16; ++q) { S = af[q] * S + bf_[q]; P *= af[q]; }
    agg[((0 * 4 + tg) * 2 + 0) * 64 + j] = P; agg[((0 * 4 + tg) * 2 + 1) * 64 + j] = S;
    P = 1.f; S = 0.f;
#pragma unroll
    for (int q = 15; q >= 0; --q) { S = ab[q] * S + bk[q]; P *= ab[q]; }
    agg[((1 * 4 + tg) * 2 + 0) * 64 + j] = P; agg[((1 * 4 + tg) * 2 + 1) * 64 + j] = S;
  }
  __syncthreads();
  int ch = h * 64 + j;
  if (mode == 1) {
    if (tg == 0) {
      float* agp = (float*)(p.ws + O_AGP); float* ags = (float*)(p.ws + O_AGS);
      float P = 1.f, S = 0.f;
      for (int g = 0; g < 4; ++g) { float pg = agg[((0 * 4 + g) * 2 + 0) * 64 + j], sg = agg[((0 * 4 + g) * 2 + 1) * 64 + j]; S = pg * S + sg; P *= pg; }
      agp[((size_t)0 * 544 + ci) * 512 + ch] = P; ags[((size_t)0 * 544 + ci) * 512 + ch] = S;
      P = 1.f; S = 0.f;
      for (int g = 3; g >= 0; --g) { float pg = agg[((1 * 4 + g) * 2 + 0) * 64 + j], sg = agg[((1 * 4 + g) * 2 + 1) * 64 + j]; S = pg * S + sg; P *= pg; }
      agp[((size_t)1 * 544 + ci) * 512 + ch] = P; ags[((size_t)1 * 544 + ci) * 512 + ch] = S;
    }
  } else {
    const float* hs = (const float*)(p.ws + O_HS);
    u16* Y = (u16*)(p.ws + O_HB);
    float s = hs[((size_t)0 * 544 + ci) * 512 + ch];
    for (int g = 0; g < tg; ++g) s = agg[((0 * 4 + g) * 2 + 0) * 64 + j] * s + agg[((0 * 4 + g) * 2 + 1) * 64 + j];
    float hf[16];
#pragma unroll
    for (int q = 0; q < 16; ++q) { s = af[q] * s + bf_[q]; hf[q] = s; }
    s = hs[((size_t)1 * 544 + ci) * 512 + ch];
    for (int g = 3; g > tg; --g) s = agg[((1 * 4 + g) * 2 + 0) * 64 + j] * s + agg[((1 * 4 + g) * 2 + 1) * 64 + j];
#pragma unroll
    for (int q = 15; q >= 0; --q) {
      s = ab[q] * s + bk[q];
      size_t row = (size_t)(rowbase + t0 + tg * 16 + q);
      float xg = bf2f(U[row * 2560 + 512 + ch]);
      Y[row * 1024 + ch] = f2bf((hf[q] + s) * geluf(xg));
    }
  }
  __syncthreads();
}

DEVI void lru_combine_item(const Params& p, int it) {
  int gt = it * 256 + TIDX;
  int dir = gt >> 12, b = (gt >> 9) & 7, ch = gt & 511;
  const float* agp = (const float*)(p.ws + O_AGP) + (size_t)dir * 544 * 512 + ch;
  const float* ags = (const float*)(p.ws + O_AGS) + (size_t)dir * 544 * 512 + ch;
  float* hs = (float*)(p.ws + O_HS) + (size_t)dir * 544 * 512 + ch;
  float s = 0.f;
#pragma unroll 1
  for (int kb = 0; kb < 68; kb += 17) {
    float P[17], S[17]; int ci[17];
#pragma unroll
    for (int q = 0; q < 17; ++q) {
      int k = kb + q;
      ci[q] = (k < 4) ? (512 + b * 4 + (dir ? 3 - k : k)) : (b * 64 + (dir ? 67 - k : k - 4));
      P[q] = agp[(size_t)ci[q] * 512]; S[q] = ags[(size_t)ci[q] * 512];
    }
#pragma unroll
    for (int q = 0; q < 17; ++q) { hs[(size_t)ci[q] * 512] = s; s = P[q] * s + S[q]; }
  }
}

DEVI void hyconv_item(const Params& p, int it, float* sm) {
  int ci = it / 24, ct = it % 24;
  int rowbase, t0, slen, b; u16* dst; int L;
  if (ci < 512) { b = ci >> 6; rowbase = b * 4096; t0 = (ci & 63) * 64; slen = 4096; dst = (u16*)(p.ws + O_VXL); L = 4096; }
  else { int cc = ci - 512; b = cc >> 2; rowbase = NL + b * 256; t0 = (cc & 3) * 64; slen = 256; dst = (u16*)(p.ws + O_VXC); L = 256; }
  const u16* U = (const u16*)(p.ws + O_U);
  float* xs = sm;
  int tid = TIDX, c0 = ct * 64;
  for (int i = tid; i < 66 * 8; i += 256) {
    int rr = i >> 3, c8 = (i & 7) * 8, t = t0 - 1 + rr;
    float v8[8];
    if (t >= 0 && t < slen) unpack8(*(const uint4*)(U + (size_t)(rowbase + t) * 2560 + 1024 + c0 + c8), v8);
    else { for (int k = 0; k < 8; ++k) v8[k] = 0.f; }
#pragma unroll
    for (int k = 0; k < 8; ++k) xs[rr * 65 + c8 + k] = v8[k];
  }
  __syncthreads();
  int c = tid >> 2, tq = tid & 3, ch = c0 + c;
  const float* hw = p.in[17];
  float w0 = hw[ch], w1 = hw[1536 + ch], w2 = hw[3072 + ch], cb = p.in[18][ch];
  int which = ch >> 9, cc = ch & 511;
  uint32_t o[8];
#pragma unroll
  for (int q = 0; q < 8; ++q) {
    int tl = tq * 16 + 2 * q;
    float y0 = cb + w0 * xs[tl * 65 + c] + w1 * xs[(tl + 1) * 65 + c] + w2 * xs[(tl + 2) * 65 + c];
    float y1 = cb + w0 * xs[(tl + 1) * 65 + c] + w1 * xs[(tl + 2) * 65 + c] + w2 * xs[(tl + 3) * 65 + c];
    o[q] = pack2(y0, y1);
  }
  u16* d = dst + ((size_t)(which * 8 + b) * 512 + cc) * L + t0 + tq * 16;
  *(uint4*)d = make_uint4(o[0], o[1], o[2], o[3]);
  *(uint4*)(d + 8) = make_uint4(o[4], o[5], o[6], o[7]);
  __syncthreads();
}

DEVI void toep_item(const Params& p, int it, u16* Xs, int order) {
  int c, half, L, gs; const u16* G; const u16* vx; const u16* z1; u16* z1w;
  if (it < 1024) { c = it >> 1; half = it & 1; L = 4096; gs = GLS; G = (const u16*)(p.ws + O_GL); vx = (const u16*)(p.ws + O_VXL); z1 = (const u16*)(p.ws + O_Z1L); z1w = (u16*)(p.ws + O_Z1L); }
  else { c = it - 1024; half = 0; L = 256; gs = GCS; G = (const u16*)(p.ws + O_GC); vx = (const u16*)(p.ws + O_VXC); z1 = (const u16*)(p.ws + O_Z1C); z1w = (u16*)(p.ws + O_Z1C); }
  int T1 = L >> 6, ntiles = T1 >> 1, XS = L + 8;
  int tid = TIDX, lane = tid & 63, w = tid >> 6, fr = lane & 15, fq = lane >> 4;
  const u16* xsrc = (order == 0) ? vx : z1;
  int l8 = L >> 3;
  for (int i = tid; i < 8 * l8; i += 256) {
    int b = i / l8, k8 = i % l8;
    *(uint4*)(Xs + b * XS + k8 * 8) = *(const uint4*)(xsrc + ((size_t)b * 512 + c) * L + k8 * 8);
  }
  __syncthreads();
  f32x4 acc[4][4];
#pragma unroll
  for (int a = 0; a < 4; ++a)
#pragma unroll
    for (int b = 0; b < 4; ++b) acc[a][b] = (f32x4){0.f, 0.f, 0.f, 0.f};
  const u16* Gp = G + (size_t)(order * 512 + c) * gs;
  size_t parstride = (size_t)1024 * gs;
  int bq = fr & 7, t1off = fr >> 3;
  int dmax = L >> 7;
  int base = (L >> 1) + 63 - fr + 8 * fq, par = base & 1;
  const u16* wp = Gp + par * parstride + (base - par);
  auto ldw = [&](int u) { bf16x8 r; uint32_t t4[4]; __builtin_memcpy(t4, (const uint32_t*)(wp + 16 * u), 16); __builtin_memcpy(&r, t4, 16); return r; };
  bf16x8 W[6], Nw[4];
  int t1lo = 2 * (half * 16 + w * 4);
  int dlo = max(-dmax, t1lo - (T1 - 1)), dhi = min(dmax, t1lo + 7);
#pragma unroll
  for (int j = 0; j < 6; ++j) W[j] = ldw(-4 * dlo - 3 + j);
#pragma unroll 1
  for (int d = dlo; d <= dhi; ++d) {
    if (d < dhi) {
#pragma unroll
      for (int j = 0; j < 4; ++j) Nw[j] = ldw(-4 * (d + 1) - 3 + j);
    }
#pragma unroll
    for (int n = 0; n < 4; ++n) {
      int Tn = half * 16 + w * 4 + n;
      int s1 = 2 * Tn + t1off - d;
      bool valid = (Tn < ntiles) && (s1 >= 0) && (s1 < T1);
      int s1c = valid ? s1 : 0;
#pragma unroll
      for (int ks = 0; ks < 2; ++ks) {
        bf16x8 bfrag = *(const bf16x8*)(Xs + bq * XS + s1c * 64 + 32 * ks + 8 * fq);
        if (!valid) bfrag = (bf16x8){0, 0, 0, 0, 0, 0, 0, 0};
#pragma unroll
        for (int m = 0; m < 4; ++m) acc[n][m] = __builtin_amdgcn_mfma_f32_16x16x32_bf16(W[3 - m + 2 * ks], bfrag, acc[n][m], 0, 0, 0);
      }
    }
    W[4] = W[0]; W[5] = W[1];
#pragma unroll
    for (int j = 0; j < 4; ++j) W[j] = Nw[j];
  }
  float skip = p.in[25][order * 512 + c];
#pragma unroll
  for (int n = 0; n < 4; ++n) {
    int Tn = half * 16 + w * 4 + n;
    if (Tn < ntiles) {
      int t1 = 2 * Tn + t1off;
#pragma unroll
      for (int m = 0; m < 4; ++m) {
        int t = 64 * t1 + 16 * m + 4 * fq;
        uint2 xin = *(const uint2*)(Xs + bq * XS + t);
        uint2 xm = *(const uint2*)(vx + ((size_t)((order + 1) * 8 + bq) * 512 + c) * L + t);
        float u0 = bf2f((u16)(xin.x & 0xffff)), u1 = bf2f((u16)(xin.x >> 16)), u2 = bf2f((u16)(xin.y & 0xffff)), u3 = bf2f((u16)(xin.y >> 16));
        float m0 = bf2f((u16)(xm.x & 0xffff)), m1 = bf2f((u16)(xm.x >> 16)), m2 = bf2f((u16)(xm.y & 0xffff)), m3 = bf2f((u16)(xm.y >> 16));
        float r0 = m0 * (acc[n][m][0] + skip * u0), r1 = m1 * (acc[n][m][1] + skip * u1);
        float r2 = m2 * (acc[n][m][2] + skip * u2), r3 = m3 * (acc[n][m][3] + skip * u3);
        {
          uint2 o; o.x = pack2(r0, r1); o.y = pack2(r2, r3);
          u16* dstz = (order == 0) ? z1w : (u16*)vx;
          *(uint2*)(dstz + ((size_t)bq * 512 + c) * L + t) = o;
        }
      }
    }
  }
  __syncthreads();
}

DEVI void hytr_item(const Params& p, int it, u16* sm) {
  int ci = it >> 3, c0 = (it & 7) * 64;
  int rowbase, t0, b, L; const u16* z2;
  if (ci < 512) { b = ci >> 6; rowbase = b * 4096; t0 = (ci & 63) * 64; L = 4096; z2 = (const u16*)(p.ws + O_VXL); }
  else { int cc = ci - 512; b = cc >> 2; rowbase = NL + b * 256; t0 = (cc & 3) * 64; L = 256; z2 = (const u16*)(p.ws + O_VXC); }
  int tid = TIDX;
  for (int i = tid; i < 64 * 8; i += 256) {
    int c = i >> 3, t8 = (i & 7) * 8;
    *(uint4*)(sm + c * 72 + t8) = *(const uint4*)(z2 + ((size_t)b * 512 + c0 + c) * L + t0 + t8);
  }
  __syncthreads();
  u16* Y = (u16*)(p.ws + O_HB);
  for (int i = tid; i < 64 * 8; i += 256) {
    int t = i >> 3, c8 = (i & 7) * 8;
    uint32_t o[4];
#pragma unroll
    for (int k = 0; k < 4; ++k) o[k] = (uint32_t)sm[(c8 + 2 * k) * 72 + t] | ((uint32_t)sm[(c8 + 2 * k + 1) * 72 + t] << 16);
    *(uint4*)(Y + (size_t)(rowbase + t0 + t) * 1024 + 512 + c0 + c8) = make_uint4(o[0], o[1], o[2], o[3]);
  }
  __syncthreads();
}

DEVI int blk_count(int c, int* cnts, int& flip) {
  for (int o = 32; o > 0; o >>= 1) c += __shfl_xor(c, o);
  int* s = cnts + (flip & 1) * 4;
  if ((TIDX & 63) == 0) s[TIDX >> 6] = c;
  __syncthreads();
  int tot = s[0] + s[1] + s[2] + s[3];
  flip ^= 1;
  return tot;
}

DEVI void topk_item(const Params& p, int it, int* smi) {
  int e = it & 15, seq = it >> 4;
  int n, cap, rowbase, slotbase, ept;
  if (seq < 8) { n = 4096; cap = 512; rowbase = seq * 4096; slotbase = seq * 512; ept = 16; }
  else { int b = seq - 8; n = 256; cap = 32; rowbase = NL + b * 256; slotbase = 4096 + b * 32; ept = 1; }
  const float* aff = (const float*)(p.ws + O_AFF);
  int* stok = (int*)(p.ws + O_STOK) + e * 4352 + slotbase;
  float* sgate = (float*)(p.ws + O_SGATE) + e * 4352 + slotbase;
  int* cnts = smi;
  int* wt = smi + 8;
  int tid = TIDX, flip = 0;
  uint32_t v[16];
#pragma unroll
  for (int j = 0; j < 16; ++j) v[j] = (j < ept) ? __float_as_uint(aff[(size_t)(rowbase + tid * ept + j) * 16 + e]) : 0u;
  uint32_t T = 0;
  for (int bit = 30; bit >= 0; --bit) {
    uint32_t cand = T | (1u << bit);
    int c = 0;
#pragma unroll
    for (int j = 0; j < 16; ++j) c += (j < ept && v[j] >= cand) ? 1 : 0;
    int tot = blk_count(c, cnts, flip);
    if (tot >= cap) T = cand;
  }
  int ngt = 0, neq = 0;
#pragma unroll
  for (int j = 0; j < 16; ++j) { if (j < ept) { ngt += (v[j] > T) ? 1 : 0; neq += (v[j] == T) ? 1 : 0; } }
  int cnt_gt = blk_count(ngt, cnts, flip);
  int need_eq = cap - cnt_gt;
  int comb = ngt | (neq << 16);
  int inc = comb;
  int lane = tid & 63, wv = tid >> 6;
  for (int o = 1; o < 64; o <<= 1) { int t = __shfl_up(inc, o); if (lane >= o) inc += t; }
  __syncthreads();
  if (lane == 63) wt[wv] = inc;
  __syncthreads();
  int pre = 0;
  for (int q = 0; q < wv; ++q) pre += wt[q];
  int ex = pre + inc - comb;
  int pg = ex & 0xffff, pe = ex >> 16;
#pragma unroll
  for (int j = 0; j < 16; ++j) {
    if (j < ept) {
      int slot = -1;
      if (v[j] > T) slot = pg++;
      else if (v[j] == T) { if (pe < need_eq) slot = cnt_gt + pe; pe++; }
      if (slot >= 0) { stok[slot] = rowbase + tid * ept + j; sgate[slot] = __uint_as_float(v[j]); }
      ((int*)(p.ws + O_INV))[(size_t)(rowbase + tid * ept + j) * 16 + e] = (slot >= 0) ? (slotbase + slot) : -1;
    }
  }
  __syncthreads();
}

DEVI void ph_moe_up(const Params& p, u16* sm, int mtl) {
  const u16* Hn = (const u16*)(p.ws + O_HB);
  const u16* Wg = (const u16*)(p.ws + O_WEXP);
  u16* Act = (u16*)(p.ws + O_U);
  const int* stok = (const int*)(p.ws + O_STOK);
  int nitems = 16 * 12 * mtl;
  int tid = TIDX, lane = tid & 63, wid = tid >> 6, wr = wid >> 1, wc = wid & 1, fr = lane & 15, fq = lane >> 4;
  int lr = tid >> 3, kc = (tid & 7) * 8;
  for (int it = vbid(); it < nitems; it += gridDim.x) {
    int e = it / (12 * mtl), rem = it % (12 * mtl);
    int fg = rem / (4 * mtl), r2 = rem % (4 * mtl);
    int f0 = (fg * 4 + (r2 & 3)) * 128, m0 = (r2 >> 2) * 128;
    uint32_t pa[4], pb0 = (uint32_t)(e * 1536 + f0 + lr) * 1024u + kc;
#pragma unroll
    for (int i = 0; i < 4; ++i) {
      int tok = stok[e * 4352 + m0 + lr + 32 * i];
      pa[i] = (uint32_t)tok * 1024u + kc;
    }
    f32x4 acc[8][4];
    gemm_core<true>(sm, Hn, pa, 0u, Wg, pb0, 0u, 1024, acc);
#pragma unroll
    for (int m = 0; m < 4; ++m) {
      int slot = m0 + wr * 64 + m * 16 + fr;
#pragma unroll
      for (int n = 0; n < 4; ++n) {
        int f = f0 + wc * 64 + n * 16 + fq * 4;
        float v0 = siluf(acc[n][m][0]) * acc[n + 4][m][0], v1 = siluf(acc[n][m][1]) * acc[n + 4][m][1];
        float v2 = siluf(acc[n][m][2]) * acc[n + 4][m][2], v3 = siluf(acc[n][m][3]) * acc[n + 4][m][3];
        uint2 o; o.x = pack2(v0, v1); o.y = pack2(v2, v3);
        *(uint2*)(Act + ((size_t)e * 4352 + slot) * 1536 + f) = o;
      }
    }
  }
}

DEVI void ph_moe_down(const Params& p, u16* sm, int layer, int mtl) {
  const u16* Act = (const u16*)(p.ws + O_U);
  const u16* Wd = (const u16*)(p.ws + O_WEXP) + 2 * EXPSZ;
  const int* stok = (const int*)(p.ws + O_STOK);
  const float* sgate = (const float*)(p.ws + O_SGATE);
  const float* mod = (const float*)(p.ws + O_MOD) + (size_t)layer * 9 * 6144 + 5 * 1024;
  int nitems = 16 * 4 * mtl;
  int tid = TIDX, lane = tid & 63, wid = tid >> 6, wr = wid >> 1, wc = wid & 1, fr = lane & 15, fq = lane >> 4;
  int lr = tid >> 3, kc = (tid & 7) * 8;
  for (int it = vbid(); it < nitems; it += gridDim.x) {
    int e = it / (4 * mtl), rem = it % (4 * mtl);
    int n0 = (rem & 3) * 256, m0 = (rem >> 2) * 128;
    uint32_t pa[4], pb0 = (uint32_t)(e * 1024 + n0 + lr) * 1536u + kc;
#pragma unroll
    for (int i = 0; i < 4; ++i) pa[i] = (uint32_t)(e * 4352 + m0 + lr + 32 * i) * 1536u + kc;
    f32x4 acc[8][4];
    gemm_core<false>(sm, Act, pa, 1536u, Wd, pb0, 1536u, 1536, acc);
#pragma unroll
    for (int m = 0; m < 4; ++m) {
      int slot = m0 + wr * 64 + m * 16 + fr;
      int tok = stok[e * 4352 + slot];
      float gt = sgate[e * 4352 + slot];
      int mr = (tok < NL) ? (tok >> 12) : 8;
      const float* gl = mod + (size_t)mr * 6144;
      u16* dst = (u16*)(p.ws + O_OUTB) + ((size_t)e * 4352 + slot) * 1024;
#pragma unroll
      for (int n = 0; n < 8; ++n) {
        int col = n0 + wc * 128 + n * 16 + fq * 4;
        float4 gv = *(const float4*)(gl + col);
        uint2 o; o.x = pack2(acc[n][m][0] * gt * gv.x, acc[n][m][1] * gt * gv.y); o.y = pack2(acc[n][m][2] * gt * gv.z, acc[n][m][3] * gt * gv.w);
        *(uint2*)(dst + col) = o;
      }
    }
  }
}

DEVI void ph_final(const Params& p) {
  int lane = TIDX & 63, wave = TIDX >> 6;
  const float* g = p.in[43];
  for (int r = blockIdx.x * 4 + wave; r < NL; r += gridDim.x * 4) {
    float* row = p.out + (size_t)r * 1024;
    float4 v[4]; float ss = 0.f;
#pragma unroll
    for (int i = 0; i < 4; ++i) v[i] = *(const float4*)(row + lane * 4 + 256 * i);
    moe_combine(p, r, lane, v);
#pragma unroll
    for (int i = 0; i < 4; ++i) ss += v[i].x * v[i].x + v[i].y * v[i].y + v[i].z * v[i].z + v[i].w * v[i].w;
    ss = wsum(ss);
    float rs = rsqrtf(ss * (1.f / 1024.f) + 1e-6f);
#pragma unroll
    for (int i = 0; i < 4; ++i) {
      float4 gg = *(const float4*)(g + lane * 4 + 256 * i);
      *(float4*)(row + lane * 4 + 256 * i) = make_float4(v[i].x * rs * gg.x, v[i].y * rs * gg.y, v[i].z * rs * gg.z, v[i].w * rs * gg.w);
    }
  }
}
constexpr size_t O_SB = O_VXL;
constexpr size_t O_S5H = O_FRAWL;
constexpr size_t O_HDEC = O_S5H + AL(512ull * 68 * 64 * 8);
static_assert(O_SB + 4352ull * 16384 * 2 <= O_HYEND, "sb");
static_assert(O_HDEC + 4352ull * 128 * 4 <= O_Y5F, "hdec");

DEVI size_t seq_row(int s, int b, int dir) {
  if (s < 256) return (size_t)NL + b * 256 + (dir ? 255 - s : s);
  int q = s - 256;
  return (size_t)b * 4096 + (dir ? 4095 - q : q);
}
DEVI float hg_lb_val(const Params& p, int ch) {
  float l0 = p.in[27][ch], l1 = p.in[27][512 + ch];
  float mx = fmaxf(l0, l1), e0 = expf(l0 - mx), e1 = expf(l1 - mx);
  return fminf(fmaxf(e1 / (e0 + e1), 0.f), 1.f - 1e-4f);
}
DEVI void hgrnA_item(const Params& p, int it, unsigned char* smem) {
  int seq = it / 68, c = it % 68;
  int b = seq >> 3, h = (seq >> 1) & 3, dir = seq & 1;
  float* G = (float*)smem;
  u16* KdT = (u16*)(smem + 33280);
  u16* VT = (u16*)(smem + 51712);
  float* lbs = (float*)(smem + 70144);
  int tid = TIDX, lane = tid & 63, w = tid >> 6, fr = lane & 15, fq = lane >> 4;
  if (tid < 128) lbs[tid] = hg_lb_val(p, h * 128 + tid);
  __syncthreads();
  const u16* U = (const u16*)(p.ws + O_U);
  int i = tid >> 2, part = tid & 3;
  const u16* ur = U + seq_row(c * 64 + i, b, dir) * 3072;
  {
    const uint4* src = (const uint4*)(ur + dir * 512 + h * 128 + part * 32);
    const uint4* srv = (const uint4*)(ur + 1024 + h * 128 + part * 32);
#pragma unroll
    for (int q4 = 0; q4 < 4; ++q4) {
      uint4 x = src[q4], y = srv[q4];
      float fv[8]; unpack8(x, fv);
      uint32_t yw[4] = {y.x, y.y, y.z, y.w};
#pragma unroll
      for (int k = 0; k < 8; ++k) {
        int d = part * 32 + q4 * 8 + k;
        float lb = lbs[d];
        G[i * 129 + d] = __logf(lb + (1.f - lb) * sigm(fv[k]));
        VT[d * 72 + i] = (u16)((k & 1) ? (yw[k >> 1] >> 16) : (yw[k >> 1] & 0xffff));
      }
    }
  }
  __syncthreads();
  if (tid < 128) { float a = 0.f; for (int ii = 0; ii < 64; ++ii) { a += G[ii * 129 + tid]; G[ii * 129 + tid] = a; } }
  __syncthreads();
#pragma unroll 8
  for (int k = 0; k < 32; ++k) {
    int d = part * 32 + k;
    float bc = G[i * 129 + d], bp = (i > 0) ? G[(i - 1) * 129 + d] : 0.f, bl = G[63 * 129 + d];
    float f = __expf(bc - bp);
    KdT[d * 72 + i] = f2bf((1.f - f) * __expf(bl - bc));
  }
  if (tid < 128) ((float*)(p.ws + O_HDEC))[(size_t)it * 128 + tid] = __expf(G[63 * 129 + tid]);
  __syncthreads();
  f32x4 acc[2][8];
#pragma unroll
  for (int m = 0; m < 2; ++m)
#pragma unroll
    for (int n = 0; n < 8; ++n) acc[m][n] = (f32x4){0.f, 0.f, 0.f, 0.f};
#pragma unroll
  for (int ks = 0; ks < 2; ++ks) {
    bf16x8 af[2];
#pragma unroll
    for (int m = 0; m < 2; ++m) af[m] = *(const bf16x8*)(KdT + ((2 * w + m) * 16 + fr) * 72 + ks * 32 + fq * 8);
#pragma unroll
    for (int n = 0; n < 8; ++n) {
      bf16x8 bv = *(const bf16x8*)(VT + (n * 16 + fr) * 72 + ks * 32 + fq * 8);
#pragma unroll
      for (int m = 0; m < 2; ++m) acc[m][n] = __builtin_amdgcn_mfma_f32_16x16x32_bf16(af[m], bv, acc[m][n], 0, 0, 0);
    }
  }
  u16* SB = (u16*)(p.ws + O_SB) + (size_t)it * 16384;
#pragma unroll
  for (int m = 0; m < 2; ++m)
#pragma unroll
    for (int n = 0; n < 8; ++n) {
      uint2 o; o.x = pack2(acc[m][n][0], acc[m][n][1]); o.y = pack2(acc[m][n][2], acc[m][n][3]);
      *(uint2*)(SB + (n * 16 + fr) * 128 + (2 * w + m) * 16 + 4 * fq) = o;
    }
  __syncthreads();
}

DEVI void hgrnB_item(const Params& p, int it) {
  int gt = it * 256 + TIDX;
  int seq = gt >> 11, idx = (gt & 2047) * 8, d0 = idx & 127;
  u16* SB = (u16*)(p.ws + O_SB) + (size_t)seq * 68 * 16384 + idx;
  const float* DEC = (const float*)(p.ws + O_HDEC) + (size_t)seq * 68 * 128 + d0;
  float carry[8];
#pragma unroll
  for (int k = 0; k < 8; ++k) carry[k] = 0.f;
#pragma unroll 1
  for (int cb = 0; cb < 68; cb += 4) {
    uint4 kvq[4]; float4 da[4], db[4];
#pragma unroll
    for (int q = 0; q < 4; ++q) {
      kvq[q] = *(const uint4*)(SB + (size_t)(cb + q) * 16384);
      da[q] = *(const float4*)(DEC + (cb + q) * 128); db[q] = *(const float4*)(DEC + (cb + q) * 128 + 4);
    }
#pragma unroll
    for (int q = 0; q < 4; ++q) {
      float kv[8]; unpack8(kvq[q], kv);
      float dd[8] = {da[q].x, da[q].y, da[q].z, da[q].w, db[q].x, db[q].y, db[q].z, db[q].w};
      uint4 o;
      o.x = pack2(carry[0], carry[1]); o.y = pack2(carry[2], carry[3]); o.z = pack2(carry[4], carry[5]); o.w = pack2(carry[6], carry[7]);
      *(uint4*)(SB + (size_t)(cb + q) * 16384) = o;
#pragma unroll
      for (int k = 0; k < 8; ++k) carry[k] = dd[k] * carry[k] + kv[k];
    }
  }
}

DEVI void hgrnC_item(const Params& p, int it, unsigned char* smem) {
  int pb = it & 63, h = (it >> 6) & 3, b = it >> 8;
  u16* Qs = (u16*)smem;
  u16* Kt = (u16*)(smem + 17408);
  float* G = (float*)(smem + 34816);
  u16* VT = (u16*)(smem + 34816);
  u16* At = (u16*)(smem + 34816 + 18432);
  float* lbs = (float*)(smem + 68096);
  float* ssum = lbs + 128;
  int tid = TIDX, lane = tid & 63, w = tid >> 6, fr = lane & 15, fq = lane >> 4;
  if (tid < 128) lbs[tid] = hg_lb_val(p, h * 128 + tid);
  __syncthreads();
  const u16* U = (const u16*)(p.ws + O_U);
  size_t row0 = (size_t)b * 4096 + pb * 64;
  int i = tid >> 2, part = tid & 3;
  const u16* ur = U + (row0 + i) * 3072;
  f32x4 o[4][2];
#pragma unroll
  for (int m = 0; m < 4; ++m)
#pragma unroll
    for (int n = 0; n < 2; ++n) o[m][n] = (f32x4){0.f, 0.f, 0.f, 0.f};
#pragma unroll 1
  for (int dir = 0; dir < 2; ++dir) {
    {
      const uint4* src = (const uint4*)(ur + dir * 512 + h * 128 + part * 32);
#pragma unroll
      for (int q4 = 0; q4 < 4; ++q4) {
        float fv[8]; unpack8(src[q4], fv);
#pragma unroll
        for (int k = 0; k < 8; ++k) { int d = part * 32 + q4 * 8 + k; float lb = lbs[d]; G[i * 129 + d] = __logf(lb + (1.f - lb) * sigm(fv[k])); }
      }
    }
    __syncthreads();
    if (tid < 128) {
      float a = 0.f;
      if (dir == 0) { for (int ii = 0; ii < 64; ++ii) { a += G[ii * 129 + tid]; G[ii * 129 + tid] = a; } }
      else { for (int ii = 63; ii >= 0; --ii) { a += G[ii * 129 + tid]; G[ii * 129 + tid] = a; } }
    }
    __syncthreads();
    {
      const uint4* srq = (const uint4*)(ur + 2048 + h * 128 + part * 32);
      int ip = (dir == 0) ? i - 1 : i + 1;
      bool edge = (dir == 0) ? (i == 0) : (i == 63);
#pragma unroll
      for (int q4 = 0; q4 < 4; ++q4) {
        float qv[8]; unpack8(srq[q4], qv);
        uint32_t qo[4], ko[4];
#pragma unroll
        for (int k2 = 0; k2 < 4; ++k2) {
          float qq[2], kk[2];
#pragma unroll
          for (int z = 0; z < 2; ++z) {
            int d = part * 32 + q4 * 8 + k2 * 2 + z;
            float bc = G[i * 129 + d], bp = edge ? 0.f : G[ip * 129 + d];
            float f = __expf(bc - bp);
            qq[z] = siluf(qv[k2 * 2 + z]) * __expf(bc);
            kk[z] = (1.f - f) * __expf(-bc);
          }
          qo[k2] = pack2(qq[0], qq[1]); ko[k2] = pack2(kk[0], kk[1]);
        }
        *(uint4*)(Qs + i * 136 + part * 32 + q4 * 8) = make_uint4(qo[0], qo[1], qo[2], qo[3]);
        *(uint4*)(Kt + i * 136 + part * 32 + q4 * 8) = make_uint4(ko[0], ko[1], ko[2], ko[3]);
      }
    }
    __syncthreads();
    {
      const uint4* srv = (const uint4*)(ur + 1024 + h * 128 + part * 32);
#pragma unroll
      for (int q4 = 0; q4 < 4; ++q4) {
        uint4 y = srv[q4];
        uint32_t yw[4] = {y.x, y.y, y.z, y.w};
#pragma unroll
        for (int k = 0; k < 8; ++k) VT[(part * 32 + q4 * 8 + k) * 72 + i] = (u16)((k & 1) ? (yw[k >> 1] >> 16) : (yw[k >> 1] & 0xffff));
      }
    }
    int seq = (b * 4 + h) * 2 + dir, c = 4 + (dir ? 63 - pb : pb);
    const u16* SB = (const u16*)(p.ws + O_SB) + ((size_t)seq * 68 + c) * 16384;
#pragma unroll
    for (int ks = 0; ks < 4; ++ks) {
      bf16x8 sf[2];
#pragma unroll
      for (int n = 0; n < 2; ++n) sf[n] = *(const bf16x8*)(SB + ((2 * w + n) * 16 + fr) * 128 + ks * 32 + fq * 8);
#pragma unroll
      for (int m = 0; m < 4; ++m) {
        bf16x8 qf = *(const bf16x8*)(Qs + (m * 16 + fr) * 136 + ks * 32 + fq * 8);
#pragma unroll
        for (int n = 0; n < 2; ++n) o[m][n] = __builtin_amdgcn_mfma_f32_16x16x32_bf16(qf, sf[n], o[m][n], 0, 0, 0);
      }
    }
    {
      f32x4 at[4];
#pragma unroll
      for (int m = 0; m < 4; ++m) at[m] = (f32x4){0.f, 0.f, 0.f, 0.f};
#pragma unroll
      for (int ks = 0; ks < 4; ++ks) {
        bf16x8 kf = *(const bf16x8*)(Kt + (w * 16 + fr) * 136 + ks * 32 + fq * 8);
#pragma unroll
        for (int m = 0; m < 4; ++m) {
          bf16x8 qf = *(const bf16x8*)(Qs + (m * 16 + fr) * 136 + ks * 32 + fq * 8);
          at[m] = __builtin_amdgcn_mfma_f32_16x16x32_bf16(kf, qf, at[m], 0, 0, 0);
        }
      }
#pragma unroll
      for (int m = 0; m < 4; ++m) {
        int ii = m * 16 + fr, j0 = w * 16 + 4 * fq;
        float a4[4];
#pragma unroll
        for (int r = 0; r < 4; ++r) { int j = j0 + r; bool keep = (dir == 0) ? (j <= ii) : (j >= ii); a4[r] = keep ? at[m][r] : 0.f; }
        uint2 ov; ov.x = pack2(a4[0], a4[1]); ov.y = pack2(a4[2], a4[3]);
        *(uint2*)(At + ii * 72 + j0) = ov;
      }
    }
    __syncthreads();
#pragma unroll
    for (int ks = 0; ks < 2; ++ks) {
      bf16x8 vf[2];
#pragma unroll
      for (int n = 0; n < 2; ++n) vf[n] = *(const bf16x8*)(VT + ((2 * w + n) * 16 + fr) * 72 + ks * 32 + fq * 8);
#pragma unroll
      for (int m = 0; m < 4; ++m) {
        bf16x8 af = *(const bf16x8*)(At + (m * 16 + fr) * 72 + ks * 32 + fq * 8);
#pragma unroll
        for (int n = 0; n < 2; ++n) o[m][n] = __builtin_amdgcn_mfma_f32_16x16x32_bf16(af, vf[n], o[m][n], 0, 0, 0);
      }
    }
    __syncthreads();
  }
#pragma unroll
  for (int m = 0; m < 4; ++m)
#pragma unroll
    for (int r = 0; r < 4; ++r) {
      float s = o[m][0][r] * o[m][0][r] + o[m][1][r] * o[m][1][r];
      s += __shfl_xor(s, 1); s += __shfl_xor(s, 2); s += __shfl_xor(s, 4); s += __shfl_xor(s, 8);
      if (fr == 0) ssum[w * 64 + m * 16 + 4 * fq + r] = s;
    }
  __syncthreads();
  u16* Ym = (u16*)(p.ws + O_HB);
#pragma unroll
  for (int m = 0; m < 4; ++m)
#pragma unroll
    for (int r = 0; r < 4; ++r) {
      int ii = m * 16 + 4 * fq + r;
      float tot = ssum[ii] + ssum[64 + ii] + ssum[128 + ii] + ssum[192 + ii];
      float rs = rsqrtf(tot * (1.f / 128.f) + 1e-6f);
      size_t row = row0 + ii;
#pragma unroll
      for (int n = 0; n < 2; ++n) {
        int e = (2 * w + n) * 16 + fr;
        float g = bf2f(U[row * 3072 + 2560 + h * 128 + e]);
        Ym[row * 1024 + h * 128 + e] = f2bf(o[m][n][r] * rs * p.in[28][e] * siluf(g));
      }
    }
  __syncthreads();
}

DEVI void wave_lds_sync() { __builtin_amdgcn_fence(__ATOMIC_RELEASE, "wavefront"); __builtin_amdgcn_wave_barrier(); __builtin_amdgcn_fence(__ATOMIC_ACQUIRE, "wavefront"); }

DEVI void s5_wave(const Params& p, int sq, int c, int mode, float* wsm) {
  int dir = sq & 1, g = (sq >> 1) & 31, b = sq >> 6;
  int lane = TIDX & 63;
  const u16* U = (const u16*)(p.ws + O_U);
  u16* Yo = (u16*)(p.ws + (dir ? O_Y5B : O_Y5F));
  float2* HS = (float2*)(p.ws + O_S5H) + ((size_t)sq * 68 + c) * 64;
  float* Cre = wsm;
  float* Cim = wsm + 1024;
  float* Hre = wsm + 2048;
  float* Him = Hre + 8 * 68;
  if (mode == 1) { for (int i = lane; i < 1024; i += 64) { Cre[i] = p.in[34][(size_t)g * 1024 + i]; Cim[i] = p.in[35][(size_t)g * 1024 + i]; } }
  float lre = fminf(p.in[29][(dir * 32 + g) * 64 + lane], -1e-4f), lim = p.in[30][(dir * 32 + g) * 64 + lane];
  float dt = expf(p.in[31][dir * 32 + g]);
  float mag = expf(lre * dt), lbr = mag * cosf(lim * dt), lbi = mag * sinf(lim * dt);
  float xr = lbr - 1.f, xi = lbi, den = 1.f / (lre * lre + lim * lim);
  float cr = (xr * lre + xi * lim) * den, ci = (xi * lre - xr * lim) * den;
  float Br[16], Bi[16];
#pragma unroll
  for (int q = 0; q < 16; ++q) {
    float br = p.in[32][((size_t)g * 64 + lane) * 16 + q], bi = p.in[33][((size_t)g * 64 + lane) * 16 + q];
    Br[q] = cr * br - ci * bi; Bi[q] = cr * bi + ci * br;
  }
  float hr = 0.f, hi = 0.f;
  if (mode == 1) { float2 h0 = HS[lane]; hr = h0.x; hi = h0.y; }
  wave_lds_sync();
  for (int s0 = c * 64; s0 < c * 64 + 64; s0 += 8) {
#pragma unroll
    for (int s8 = 0; s8 < 8; ++s8) {
      size_t row = seq_row(s0 + s8, b, dir);
      const uint4* up = (const uint4*)(U + row * 3072 + 1536 + g * 16);
      float ua[8], ub[8]; unpack8(up[0], ua); unpack8(up[1], ub);
      float bur = 0.f, bui = 0.f;
#pragma unroll
      for (int q = 0; q < 8; ++q) { bur += Br[q] * ua[q] + Br[8 + q] * ub[q]; bui += Bi[q] * ua[q] + Bi[8 + q] * ub[q]; }
      float nr = lbr * hr - lbi * hi + bur, ni = lbr * hi + lbi * hr + bui;
      hr = nr; hi = ni;
      if (mode == 1) { Hre[s8 * 68 + lane] = hr; Him[s8 * 68 + lane] = hi; }
    }
    if (mode == 1) {
      wave_lds_sync();
      int s8 = lane >> 3, hp = lane & 7;
      float y0 = 0.f, y1 = 0.f;
#pragma unroll
      for (int p4 = 0; p4 < 16; ++p4) {
        float4 a = *(const float4*)(Hre + s8 * 68 + p4 * 4), bq = *(const float4*)(Him + s8 * 68 + p4 * 4);
        float4 c0 = *(const float4*)(Cre + (hp * 2) * 64 + p4 * 4), d0 = *(const float4*)(Cim + (hp * 2) * 64 + p4 * 4);
        float4 c1 = *(const float4*)(Cre + (hp * 2 + 1) * 64 + p4 * 4), d1 = *(const float4*)(Cim + (hp * 2 + 1) * 64 + p4 * 4);
        y0 += a.x * c0.x - bq.x * d0.x + a.y * c0.y - bq.y * d0.y + a.z * c0.z - bq.z * d0.z + a.w * c0.w - bq.w * d0.w;
        y1 += a.x * c1.x - bq.x * d1.x + a.y * c1.y - bq.y * d1.y + a.z * c1.z - bq.z * d1.z + a.w * c1.w - bq.w * d1.w;
      }
      size_t row = seq_row(s0 + s8, b, dir);
      *(uint32_t*)(Yo + row * 512 + g * 16 + hp * 2) = pack2(y0, y1);
      wave_lds_sync();
    }
  }
  if (mode == 0) HS[lane] = make_float2(hr, hi);
}

DEVI void s5B_item(const Params& p, int it) {
  int gt = it * 256 + TIDX;
  int sq = gt >> 6, lane = gt & 63;
  int dir = sq & 1, g = (sq >> 1) & 31;
  float lre = fminf(p.in[29][(dir * 32 + g) * 64 + lane], -1e-4f), lim = p.in[30][(dir * 32 + g) * 64 + lane];
  float dt = expf(p.in[31][dir * 32 + g]);
  float mag = expf(lre * dt), ar = mag * cosf(lim * dt), ai = mag * sinf(lim * dt);
#pragma unroll
  for (int k = 0; k < 6; ++k) { float nr = ar * ar - ai * ai, ni = 2.f * ar * ai; ar = nr; ai = ni; }
  float2* HS = (float2*)(p.ws + O_S5H) + (size_t)sq * 68 * 64 + lane;
  float cr = 0.f, ci = 0.f;
#pragma unroll 1
  for (int cb = 0; cb < 68; cb += 17) {
    float2 v[17];
#pragma unroll
    for (int q = 0; q < 17; ++q) v[q] = HS[(cb + q) * 64];
#pragma unroll
    for (int q = 0; q < 17; ++q) {
      HS[(cb + q) * 64] = make_float2(cr, ci);
      float nr = ar * cr - ai * ci + v[q].x, ni = ar * ci + ai * cr + v[q].y;
      cr = nr; ci = ni;
    }
  }
}

DEVI void ph_l1_finalize(const Params& p) {
  int lane = TIDX & 63, wave = TIDX >> 6;
  const u16* U = (const u16*)(p.ws + O_U);
  const u16* Yf = (const u16*)(p.ws + O_Y5F); const u16* Yb = (const u16*)(p.ws + O_Y5B);
  u16* Y5 = (u16*)(p.ws + O_Y5);
  int ch = lane * 8;
  for (int r = blockIdx.x * 4 + wave; r < NL; r += gridDim.x * 4) {
    size_t ro = (size_t)r;
    float a[8], bb[8], uu[8];
    unpack8(*(const uint4*)(Yf + ro * 512 + ch), a); unpack8(*(const uint4*)(Yb + ro * 512 + ch), bb); unpack8(*(const uint4*)(U + ro * 3072 + 1536 + ch), uu);
    uint32_t ow[4];
#pragma unroll
    for (int q = 0; q < 4; ++q) {
      float y0 = a[2 * q] + bb[2 * q] + uu[2 * q] * p.in[36][ch + 2 * q];
      float y1 = a[2 * q + 1] + bb[2 * q + 1] + uu[2 * q + 1] * p.in[36][ch + 2 * q + 1];
      ow[q] = pack2(geluf(y0), geluf(y1));
    }
    *(uint4*)(Y5 + ro * 512 + ch) = make_uint4(ow[0], ow[1], ow[2], ow[3]);
  }
}
constexpr size_t O_POW = O_END1;
constexpr size_t O_BP = O_POW + AL(64ull * 65 * 64 * 8);
constexpr size_t O_KT = O_BP + AL(64ull * 64 * 16 * 8);
constexpr size_t O_WST = O_KT + AL(64ull * 65 * 256 * 2);
constexpr size_t O_WB = O_WST + AL(64ull * 64 * 16 * 128 * 2);
constexpr size_t O_END2 = O_WB + AL(64ull * 128 * 1024 * 2);
constexpr size_t O_BAR = O_END2;
static_assert(O_BAR + 16384 < 800000000ull, "workspace budget");

DEVI void s5pow_item(const Params& p, int it) {
  int gt = it * 256 + TIDX;
  int gd = gt >> 6, lane = gt & 63, g = gd >> 1, dir = gd & 1;
  float lre = fminf(p.in[29][(dir * 32 + g) * 64 + lane], -1e-4f), lim = p.in[30][(dir * 32 + g) * 64 + lane];
  float dt = expf(p.in[31][dir * 32 + g]);
  float mag = expf(lre * dt), lbr = mag * cosf(lim * dt), lbi = mag * sinf(lim * dt);
  float xr = lbr - 1.f, xi = lbi, den = 1.f / (lre * lre + lim * lim);
  float cr = (xr * lre + xi * lim) * den, ci = (xi * lre - xr * lim) * den;
  float2* POW = (float2*)(p.ws + O_POW) + (size_t)gd * 65 * 64 + lane;
  float pr = 1.f, pi = 0.f;
  for (int t = 0; t < 65; ++t) { POW[t * 64] = make_float2(pr, pi); float nr = pr * lbr - pi * lbi, ni = pr * lbi + pi * lbr; pr = nr; pi = ni; }
  float2* BP = (float2*)(p.ws + O_BP) + ((size_t)gd * 64 + lane) * 16;
  for (int q = 0; q < 16; ++q) {
    float br = p.in[32][((size_t)g * 64 + lane) * 16 + q], bi = p.in[33][((size_t)g * 64 + lane) * 16 + q];
    BP[q] = make_float2(cr * br - ci * bi, cr * bi + ci * br);
  }
}

DEVI void s5tab_item(const Params& p, int it) {
  const float2* POWa = (const float2*)(p.ws + O_POW);
  const float2* BPa = (const float2*)(p.ws + O_BP);
  int tid = TIDX;
  if (it < 576) {
    int gd = it / 9, t8 = it % 9, g = gd >> 1;
    int hh = tid >> 4, hp = tid & 15;
    const float2* POW = POWa + (size_t)gd * 65 * 64;
    const float2* BP = BPa + (size_t)gd * 64 * 16;
    const float* Cr = p.in[34] + ((size_t)g * 16 + hh) * 64; const float* Ci = p.in[35] + ((size_t)g * 16 + hh) * 64;
    u16* KT = (u16*)(p.ws + O_KT) + (size_t)gd * 65 * 256;
    for (int ts = t8 * 8; ts < t8 * 8 + 8 && ts < 65; ++ts) {
      float acc = 0.f;
      if (ts >= 1) {
        for (int pp = 0; pp < 64; ++pp) {
          float2 P = POW[(ts - 1) * 64 + pp], B = BP[pp * 16 + hp];
          float c_r = Cr[pp], c_i = Ci[pp];
          float cpr = c_r * P.x - c_i * P.y, cpi = c_r * P.y + c_i * P.x;
          acc += cpr * B.x - cpi * B.y;
        }
      }
      KT[ts * 256 + hh * 16 + hp] = f2bf(acc);
    }
  } else if (it < 576 + 512) {
    int j = it - 576, gd = j >> 3, i8 = j & 7, g = gd >> 1;
    int hh = tid >> 4, kq = (tid & 15) * 8, p0 = kq >> 1;
    const float2* POW = POWa + (size_t)gd * 65 * 64;
    u16* WS = (u16*)(p.ws + O_WST) + (size_t)gd * 64 * 16 * 128;
    for (int ii = 0; ii < 8; ++ii) {
      int i = i8 * 8 + ii;
      float v[8];
#pragma unroll
      for (int pp = 0; pp < 4; ++pp) {
        int pq = p0 + pp;
        float2 P = POW[(i + 1) * 64 + pq];
        float c_r = p.in[34][((size_t)g * 16 + hh) * 64 + pq], c_i = p.in[35][((size_t)g * 16 + hh) * 64 + pq];
        v[2 * pp] = c_r * P.x - c_i * P.y; v[2 * pp + 1] = -(c_r * P.y + c_i * P.x);
      }
      *(uint4*)(WS + ((size_t)i * 16 + hh) * 128 + kq) = make_uint4(pack2(v[0], v[1]), pack2(v[2], v[3]), pack2(v[4], v[5]), pack2(v[6], v[7]));
    }
  } else {
    int j = it - 1088, gd = j >> 3, p8 = j & 7;
    int jj = tid >> 2, hq = tid & 3;
    const float2* POW = POWa + (size_t)gd * 65 * 64;
    const float2* BP = BPa + (size_t)gd * 64 * 16;
    u16* WB = (u16*)(p.ws + O_WB) + (size_t)gd * 128 * 1024;
    for (int pp = 0; pp < 8; ++pp) {
      int pq = p8 * 8 + pp;
      float2 P = POW[(63 - jj) * 64 + pq];
      float re[4], im[4];
#pragma unroll
      for (int h4 = 0; h4 < 4; ++h4) { float2 B = BP[pq * 16 + hq * 4 + h4]; re[h4] = P.x * B.x - P.y * B.y; im[h4] = P.x * B.y + P.y * B.x; }
      *(uint2*)(WB + (size_t)(2 * pq) * 1024 + jj * 16 + hq * 4) = make_uint2(pack2(re[0], re[1]), pack2(re[2], re[3]));
      *(uint2*)(WB + (size_t)(2 * pq + 1) * 1024 + jj * 16 + hq * 4) = make_uint2(pack2(im[0], im[1]), pack2(im[2], im[3]));
    }
  }
}

DEVI void s5A_mfma_item(const Params& p, int it) {
  int gd = it / 34, nt = it % 34, g = gd >> 1, dir = gd & 1;
  int lane = TIDX & 63, w = TIDX >> 6, fr = lane & 15, fq = lane >> 4;
  int col = nt * 16 + fr, b = col / 68, chunk = col % 68;
  const u16* U = (const u16*)(p.ws + O_U);
  const u16* WB = (const u16*)(p.ws + O_WB) + (size_t)gd * 128 * 1024;
  f32x4 acc[2] = {(f32x4){0.f, 0.f, 0.f, 0.f}, (f32x4){0.f, 0.f, 0.f, 0.f}};
#pragma unroll 8
  for (int js = 0; js < 32; ++js) {
    int j = 2 * js + (fq >> 1);
    size_t row = seq_row(chunk * 64 + j, b, dir);
    bf16x8 bfrag = *(const bf16x8*)(U + row * 3072 + 1536 + g * 16 + (fq & 1) * 8);
#pragma unroll
    for (int m = 0; m < 2; ++m) {
      bf16x8 afrag = *(const bf16x8*)(WB + (size_t)((2 * w + m) * 16 + fr) * 1024 + js * 32 + fq * 8);
      acc[m] = __builtin_amdgcn_mfma_f32_16x16x32_bf16(afrag, bfrag, acc[m], 0, 0, 0);
    }
  }
  int sq = b * 64 + gd;
  float* HSf = (float*)(p.ws + O_S5H) + ((size_t)sq * 68 + chunk) * 128;
#pragma unroll
  for (int m = 0; m < 2; ++m) *(float4*)(HSf + (2 * w + m) * 16 + 4 * fq) = make_float4(acc[m][0], acc[m][1], acc[m][2], acc[m][3]);
}

DEVI void s5C_mfma_item(const Params& p, int it, u16* KTl) {
  int gd = it >> 3, ng = it & 7, g = gd >> 1, dir = gd & 1;
  int tid = TIDX, lane = tid & 63, w = tid >> 6, fr = lane & 15, fq = lane >> 4;
  {
    const uint4* src = (const uint4*)((const u16*)(p.ws + O_KT) + (size_t)gd * 65 * 256);
    for (int i = tid; i < 2080; i += 256) ((uint4*)KTl)[i] = src[i];
  }
  __syncthreads();
  int col = (ng * 4 + w) * 16 + fr, b = col >> 6, chunk = 4 + (col & 63);
  const u16* U = (const u16*)(p.ws + O_U);
  u16* Yo = (u16*)(p.ws + (dir ? O_Y5B : O_Y5F));
  bf16x8 ub[32];
#pragma unroll
  for (int js = 0; js < 32; ++js) {
    size_t row = seq_row(chunk * 64 + 2 * js + (fq >> 1), b, dir);
    ub[js] = *(const bf16x8*)(U + row * 3072 + 1536 + g * 16 + (fq & 1) * 8);
  }
  bf16x8 hb[4];
  {
    int sq = b * 64 + gd;
    const float* HSf = (const float*)(p.ws + O_S5H) + ((size_t)sq * 68 + chunk) * 128;
#pragma unroll
    for (int ks = 0; ks < 4; ++ks) {
      float4 a = *(const float4*)(HSf + ks * 32 + 8 * fq), c = *(const float4*)(HSf + ks * 32 + 8 * fq + 4);
      uint4 pk = make_uint4(pack2(a.x, a.y), pack2(a.z, a.w), pack2(c.x, c.y), pack2(c.z, c.w));
      __builtin_memcpy(&hb[ks], &pk, 16);
    }
  }
  const u16* WS = (const u16*)(p.ws + O_WST) + (size_t)gd * 64 * 16 * 128;
  int tsl = 1 - (fq >> 1);
  const u16* KTp = KTl + fr * 16 + (fq & 1) * 8;
#pragma unroll 1
  for (int i = 0; i < 64; ++i) {
    f32x4 a0 = (f32x4){0.f, 0.f, 0.f, 0.f}, a1 = (f32x4){0.f, 0.f, 0.f, 0.f};
    const u16* WSi = WS + ((size_t)i * 16 + fr) * 128 + 8 * fq;
#pragma unroll
    for (int ks = 0; ks < 4; ++ks) {
      bf16x8 a = *(const bf16x8*)(WSi + ks * 32);
      if (ks & 1) a1 = __builtin_amdgcn_mfma_f32_16x16x32_bf16(a, hb[ks], a1, 0, 0, 0);
      else a0 = __builtin_amdgcn_mfma_f32_16x16x32_bf16(a, hb[ks], a0, 0, 0, 0);
    }
#pragma unroll
    for (int js = 0; js < 32; ++js) {
      if (2 * js > i) break;
      int ts = i - 2 * js + tsl;
      bf16x8 a = *(const bf16x8*)(KTp + ts * 256);
      if (js & 1) a1 = __builtin_amdgcn_mfma_f32_16x16x32_bf16(a, ub[js], a1, 0, 0, 0);
      else a0 = __builtin_amdgcn_mfma_f32_16x16x32_bf16(a, ub[js], a0, 0, 0, 0);
    }
    size_t row = seq_row(chunk * 64 + i, b, dir);
    uint2 o; o.x = pack2(a0[0] + a1[0], a0[1] + a1[1]); o.y = pack2(a0[2] + a1[2], a0[3] + a1[3]);
    *(uint2*)(Yo + row * 512 + g * 16 + 4 * fq) = o;
  }
  __syncthreads();
}

#define XB_TMO      128
#define XB_XCNT(j)  (256  + 64 * (j))
#define XB_XSUB(j)  (1280 + 64 * (j))
#define XB_XGEN(j)  (2304 + 64 * (j))
#define XB_TOP      3328
#define XB_TOPGEN   3392
#define XCD_BAR_WORDS 3456
#define XB_SPIN_CAP (1u << 18)
#define LAS __attribute__((address_space(3)))
__device__ __forceinline__ unsigned xb_ld(unsigned* p)              { return __hip_atomic_load(p, __ATOMIC_RELAXED, __HIP_MEMORY_SCOPE_AGENT); }
__device__ __forceinline__ unsigned xb_add(unsigned* p, unsigned v) { return __hip_atomic_fetch_add(p, v, __ATOMIC_RELAXED, __HIP_MEMORY_SCOPE_AGENT); }
__device__ __forceinline__ unsigned xb_xcc_id() { return (unsigned)__builtin_amdgcn_s_getreg((3 << 11) | 20) & 0xFu; }
#define XB_SPIN(cond, bar) do { unsigned _sp = 0; while (cond) { __builtin_amdgcn_s_sleep(1); \
    if ((++_sp & 255u) == 0u) { if (xb_ld(&(bar)[XB_TMO])) break; if (_sp > XB_SPIN_CAP) { atomicAdd(&(bar)[XB_TMO], 1u); break; } } } } while (0)
struct XcdBarrier { unsigned* bar; unsigned x; volatile LAS unsigned* st; };
__device__ __forceinline__ XcdBarrier xcd_barrier_post(unsigned* bar, volatile LAS unsigned* st) {
  XcdBarrier b; b.bar = bar; b.x = xb_xcc_id(); b.st = st;
  if (threadIdx.x == 0) (void)xb_add(&bar[XB_XCNT(b.x)], 1u);
  return b;
}
__device__ __forceinline__ void xcd_barrier_complete(unsigned* bar, unsigned x, unsigned& nloc, unsigned& nx) {
  const unsigned G = gridDim.x * gridDim.y * gridDim.z;
  unsigned sum, cnt, mine, sp = 0u;
  for (;;) {
    sum = 0u; cnt = 0u; mine = 0u;
#pragma unroll
    for (unsigned j = 0; j < 16; ++j) { const unsigned c = xb_ld(&bar[XB_XCNT(j)]); sum += c; cnt += (c > 0u) ? 1u : 0u; mine = (j == x) ? c : mine; }
    if (sum == G) break;
    __builtin_amdgcn_s_sleep(1);
    if ((++sp & 255u) == 0u) { if (xb_ld(&bar[XB_TMO])) break; if (sp > XB_SPIN_CAP) { atomicAdd(&bar[XB_TMO], 1u); break; } }
  }
  nloc = mine > 0u ? mine : 1u; nx = cnt > 0u ? cnt : 1u;
}
__device__ __forceinline__ void xcd_barrier(const XcdBarrier& b) {
  asm volatile("s_waitcnt vmcnt(0)" ::: "memory");
  __syncthreads();
  if (threadIdx.x == 0) {
    unsigned* bar = b.bar;
    __builtin_amdgcn_s_waitcnt(0);
    unsigned nloc = b.st[0], nx = b.st[1];
    if (nloc == 0u) { xcd_barrier_complete(bar, b.x, nloc, nx); b.st[0] = nloc; b.st[1] = nx; }
    const unsigned old = xb_add(&bar[XB_XSUB(b.x)], 1u);
    const unsigned gen = old / nloc;
    if (old + 1u == (gen + 1u) * nloc) {
      __builtin_amdgcn_fence(__ATOMIC_RELEASE, "agent");
      asm volatile("s_waitcnt vmcnt(0)" ::: "memory");
      const unsigned og = xb_add(&bar[XB_TOP], 1u);
      const unsigned tg = og / nx;
      if (og + 1u == (tg + 1u) * nx) xb_add(&bar[XB_TOPGEN], 1u);
      else XB_SPIN(xb_ld(&bar[XB_TOPGEN]) == tg, bar);
      __builtin_amdgcn_fence(__ATOMIC_ACQUIRE, "agent");
      xb_add(&bar[XB_XGEN(b.x)], 1u);
      asm volatile("s_waitcnt vmcnt(0)" ::: "memory");
    } else {
      XB_SPIN(xb_ld(&bar[XB_XGEN(b.x)]) == gen, bar);
      __builtin_amdgcn_fence(__ATOMIC_ACQUIRE, "agent");
      asm volatile("s_waitcnt vmcnt(0)" ::: "memory");
    }
  }
  __syncthreads();
}
DEVI void ph_gemm_glu(const Params& p, u16* sm) {
  const u16* Y5 = (const u16*)(p.ws + O_Y5);
  const u16* Wt = (const u16*)(p.ws + O_WGLU);
  u16* Ym = (u16*)(p.ws + O_HB);
  int nitems = 256 * 2;
  int tid = TIDX, lane = tid & 63, wid = tid >> 6, wr = wid >> 1, wc = wid & 1, fr = lane & 15, fq = lane >> 4;
  int lr = tid >> 3, kc = (tid & 7) * 8;
  for (int it = vbid(); it < nitems; it += gridDim.x) {
    int m0 = (it / 2) * 128, n0 = (it % 2) * 256;
    uint32_t pa[4], pb0 = (uint32_t)(n0 + lr) * 512u + kc;
#pragma unroll
    for (int i = 0; i < 4; ++i) pa[i] = (uint32_t)(m0 + lr + 32 * i) * 512u + kc;
    f32x4 acc[8][4];
    gemm_core<false>(sm, Y5, pa, 512u, Wt, pb0, 512u, 512, acc);
#pragma unroll
    for (int m = 0; m < 4; ++m) {
      size_t r = m0 + wr * 64 + m * 16 + fr;
#pragma unroll
      for (int n = 0; n < 8; ++n) {
        int col = n0 + wc * 128 + n * 16 + fq * 4;
        uint2 yv = *(const uint2*)(Y5 + r * 512 + col);
        float4 bv = *(const float4*)(p.in[38] + col);
        float y0 = bf2f((u16)(yv.x & 0xffff)), y1 = bf2f((u16)(yv.x >> 16)), y2 = bf2f((u16)(yv.y & 0xffff)), y3 = bf2f((u16)(yv.y >> 16));
        uint2 o;
        o.x = pack2(y0 * sigm(acc[n][m][0] + bv.x), y1 * sigm(acc[n][m][1] + bv.y));
        o.y = pack2(y2 * sigm(acc[n][m][2] + bv.z), y3 * sigm(acc[n][m][3] + bv.w));
        *(uint2*)(Ym + r * 1024 + 512 + col) = o;
      }
    }
  }
}

DEVI void run_phase(const Params& p, int ph, unsigned char* smem) {
  float* smf = (float*)smem; u16* smh = (u16*)smem;
  int bid = blockIdx.x, nb = gridDim.x;
#ifdef ONLY_PHASE
  if (ph != ONLY_PHASE) return;
  ph = ONLY_PHASE;
#endif
  switch (ph) {
    case 0: {
      int total = 192 + 272 + 1984 + 18432 + 32;
      for (int it = bid; it < total; it += nb) {
        if (it >= 20880) { int t = it - 20880; prep_tile(p.in[(t & 1) ? 14 : 12] + (size_t)(t >> 1) * 4096, 64, 64, (u16*)(p.ws + O_WLT) + (size_t)t * 4096, 0, smf); }
        else if (it < 192) mod_item(p, it, smf);
        else if (it < 464) filt_item(p, it - 192, smf);
        else if (it < 464 + 1984) {
          int t = it - 464;
          if (t < 640) prep_tile(p.in[9], 1024, 2560, (u16*)(p.ws + O_WIN0), t, smf);
          else if (t < 1408) prep_tile(p.in[26], 1024, 3072, (u16*)(p.ws + O_WIN1), t - 640, smf);
          else if (t < 1920) prep_tile(p.in[8], 1024, 1024, (u16*)(p.ws + O_WOUT), t - 1408, smf);
          else prep_tile(p.in[37], 512, 512, (u16*)(p.ws + O_WGLU), t - 1920, smf);
        } else prep_experts(p, 0, it - 2448, smf);
      }
    } break;
    case 1: {
      for (int it = bid; it < 1152; it += nb) filtfin_item(p, it, smf);
      ph_norm(p, 0, 1, true, false, false, false, smf);
    } break;
    case 2: ph_gemm_in(p, smh, (const u16*)(p.ws + O_WIN0), 2560); break;
    case 3: {
      int total = 4352 + 13056;
      for (int it = bid; it < total; it += nb) { if (it < 4352) lru_item(p, it, smem, 1); else hyconv_item(p, it - 4352, smf); }
    } break;
    case 4: {
      int total = 32 + 1536;
      for (int it = bid; it < total; it += nb) { if (it < 32) lru_combine_item(p, it); else toep_item(p, it - 32, smh, 0); }
    } break;
    case 5: {
      int total = 4352 + 1536;
      for (int it = bid; it < total; it += nb) { if (it < 1536) toep_item(p, it, smh, 1); else lru_item(p, it - 1536, smem, 3); }
    } break;
    case 26: for (int it = bid; it < 4352; it += nb) hytr_item(p, it, smh); break;
    case 6: ph_gemm_out(p, smh, 0); break;
    case 7: { for (int it = bid; it < 16; it += nb) s5pow_item(p, it); ph_norm(p, 0, 2, true, false, true, false, smf); } break;
    case 8: for (int it = bid; it < 256 + 1600; it += nb) { if (it < 256) topk_item(p, it, (int*)smem); else s5tab_item(p, it - 256); } break;
    case 9: ph_moe_up(p, smh, 34); break;
    case 10: ph_moe_down(p, smh, 0, 34); break;
    case 11: {
      for (int it = bid; it < 18432; it += nb) prep_experts(p, 1, it, smf);
      ph_norm(p, 1, 1, true, true, false, true, smf);
    } break;
    case 12: {
      ph_gemm_in(p, smh, (const u16*)(p.ws + O_WIN1), 3072);
    } break;
    case 13: for (int it = bid; it < 4352 + 2176; it += nb) { if (it < 2176) s5A_mfma_item(p, it); else hgrnA_item(p, it - 2176, smem); } break;
    case 24: for (int it = bid; it < 2176; it += nb) s5A_mfma_item(p, it); break;
    case 22: {
      int total = 512 + 128;
      for (int it = bid; it < total; it += nb) { if (it < 512) hgrnB_item(p, it); else s5B_item(p, it - 512); }
    } break;
    case 23: for (int it = bid; it < 2048 + 512; it += nb) { if (it < 512) s5C_mfma_item(p, it, smh); else hgrnC_item(p, it - 512, smem); } break;
    case 25: for (int it = bid; it < 512; it += nb) s5C_mfma_item(p, it, smh); break;
    case 14: ph_l1_finalize(p); break;
    case 15: ph_gemm_glu(p, smh); break;
    case 16: ph_gemm_out(p, smh, 1); break;
    case 17: ph_norm(p, 1, 2, false, false, true, false, smf); break;
    case 18: for (int it = bid; it < 128; it += nb) topk_item(p, it, (int*)smem); break;
    case 19: ph_moe_up(p, smh, 32); break;
    case 20: ph_moe_down(p, smh, 1, 32); break;
    case 21: ph_final(p); break;
  }
}

__global__ void __launch_bounds__(256, 2) mega(Params p, int ph_lo, int ph_hi) {
  extern __shared__ __attribute__((aligned(16))) unsigned char smem[];
  cg::grid_group grid = cg::this_grid();
  __shared__ __attribute__((aligned(16))) unsigned xb_words[4];
  if (threadIdx.x < 4) xb_words[threadIdx.x] = 0u;
  __syncthreads();
  XcdBarrier xb = xcd_barrier_post((unsigned*)(p.ws + O_BAR), (volatile LAS unsigned*)&xb_words);
  if (ph_lo > ph_hi) grid.sync();
#define GSYNC(POS) { xcd_barrier(xb); }
#ifdef PROBE_LO
  long long pt0 = 0;
#define PHC(POS, N) { if (POS > 0) GSYNC(POS) \
    if (POS == PROBE_HI + 1) { long long t1 = wall_clock64(); long long dl = t1 - pt0; while (wall_clock64() - t1 < dl) {} } \
    if (POS == PROBE_LO) pt0 = wall_clock64(); run_phase(p, N, smem); }
#else
#define PHC(POS, N) { if (POS > 0) GSYNC(POS) run_phase(p, N, smem); }
#endif
  PHC(0, 0) PHC(1, 1) PHC(2, 2) PHC(3, 3) PHC(4, 4) PHC(5, 5) PHC(6, 26) PHC(7, 6) PHC(8, 7) PHC(9, 8) PHC(10, 9) PHC(11, 10) PHC(12, 11)
  PHC(13, 12) PHC(14, 13) PHC(15, 22) PHC(16, 23) PHC(17, 14) PHC(18, 15) PHC(19, 16) PHC(20, 17)
  PHC(21, 18) PHC(22, 19) PHC(23, 20) PHC(24, 21)
#ifdef PROBE_LO
  PHC(25, 99)
#endif
#undef PHC
}

extern "C" void kernel_launch(void* const* d_in, const int* in_sizes, int n_in, void* d_out, int out_size,
                              void* d_ws, size_t ws_size, hipStream_t stream) {
  static int grid_blocks = 0;
  if (!grid_blocks) {
    int dev = 0, cus = 0, per_cu = 0;
    (void)hipGetDevice(&dev);
    (void)hipDeviceGetAttribute(&cus, hipDeviceAttributeMultiprocessorCount, dev);
    (void)hipFuncSetAttribute((const void*)mega, hipFuncAttributeMaxDynamicSharedMemorySize, SMEM_BYTES);
    (void)hipOccupancyMaxActiveBlocksPerMultiprocessor(&per_cu, mega, 256, SMEM_BYTES);
    if (per_cu > 2) per_cu = 2;
    if (per_cu < 1) per_cu = 1;
    grid_blocks = cus * per_cu;
  }
  Params p{};
  for (int i = 0; i < 44; ++i) p.in[i] = (const float*)d_in[i];
  p.out = (float*)d_out; p.ws = (unsigned char*)d_ws;
  int lo = 0, hi = 23;
  (void)hipMemsetAsync((unsigned char*)d_ws + O_BAR, 0, XCD_BAR_WORDS * 4, stream);
  void* args[] = {&p, &lo, &hi};
  hipError_t e = hipLaunchCooperativeKernel((void*)mega, dim3(grid_blocks), dim3(256), args, SMEM_BYTES, stream);
  if (e != hipSuccess) fprintf(stderr, "cooperative launch failed: %s (grid %d)\n", hipGetErrorString(e), grid_blocks);
}
```

```cpp
#include <hip/hip_runtime.h>
#include <hip/hip_bf16.h>
#include <hip/hip_cooperative_groups.h>
#include <cstdio>
#include <cstdint>
namespace cg = cooperative_groups;

typedef unsigned short u16;
using bf16x8 = __attribute__((ext_vector_type(8))) short;
using f32x4 = __attribute__((ext_vector_type(4))) float;
using u32x4 = __attribute__((ext_vector_type(4))) uint32_t;
#define DEVI __device__ __forceinline__
__device__ __forceinline__ int tid_opaque() { int t = threadIdx.x; asm volatile("" : "+v"(t)); return t; }
#define TIDX tid_opaque()

constexpr int NL = 32768, NC = 2048, NT = 34816;
constexpr size_t AL(size_t x) { return (x + 255) & ~(size_t)255; }
constexpr size_t EXPSZ = 16ull * 1536 * 1024;
constexpr size_t O_WIN0 = 0;
constexpr size_t O_WIN1 = O_WIN0 + AL(2560ull * 1024 * 2);
constexpr size_t O_WOUT = O_WIN1 + AL(3072ull * 1024 * 2);
constexpr size_t O_WGLU = O_WOUT + AL(2ull * 1024 * 1024 * 2);
constexpr size_t O_WEXP = O_WGLU + AL(512ull * 512 * 2);
constexpr size_t O_MOD = O_WEXP + AL(3 * EXPSZ * 2);
constexpr size_t O_HB = O_MOD + AL(2ull * 9 * 6144 * 4);
constexpr size_t O_U = O_HB + AL((size_t)NT * 1024 * 2);
constexpr size_t O_XC = O_U + AL((size_t)NT * 3072 * 2);
constexpr size_t O_VXL = O_XC + AL((size_t)NC * 1024 * 4);
constexpr size_t O_VXC = O_VXL + AL(3ull * 8 * 512 * 4096 * 2);
constexpr size_t O_Z1L = O_VXC + AL(3ull * 8 * 512 * 256 * 2);
constexpr size_t O_Z1C = O_Z1L + AL(8ull * 512 * 4096 * 2);
constexpr size_t O_HYEND = O_Z1C + AL(8ull * 512 * 256 * 2);
constexpr size_t O_OF = O_VXL;
constexpr size_t O_OB = O_OF + (size_t)NL * 512 * 4;
static_assert(O_OB + (size_t)NL * 512 * 4 <= O_HYEND, "alias");
constexpr size_t O_FRAWL = O_HYEND;
constexpr size_t O_FRAWC = O_FRAWL + AL(4096ull * 1024 * 4);
constexpr size_t O_CSUM = O_FRAWC + AL(256ull * 1024 * 4);
constexpr int GLS = 4096 + 128, GCS = 256 + 128;
constexpr size_t O_GL = O_CSUM + AL(272ull * 1024 * 4);
constexpr size_t O_GC = O_GL + AL(2ull * 1024 * GLS * 2);
constexpr size_t O_Y5F = O_GC + AL(2ull * 1024 * GCS * 2);
constexpr size_t O_Y5B = O_Y5F + AL((size_t)NL * 512 * 2);
constexpr size_t O_Y5 = O_Y5B + AL((size_t)NL * 512 * 2);
constexpr size_t O_AFF = O_Y5 + AL((size_t)NL * 512 * 2);
constexpr size_t O_STOK = O_AFF + AL((size_t)NT * 16 * 4);
constexpr size_t O_SGATE = O_STOK + AL(16ull * 4352 * 4);
constexpr size_t O_AGP = O_SGATE + AL(16ull * 4352 * 4);
constexpr size_t O_AGS = O_AGP + AL(2ull * 544 * 512 * 4);
constexpr size_t O_HS = O_AGS + AL(2ull * 544 * 512 * 4);
constexpr size_t O_END = O_HS + AL(2ull * 544 * 512 * 4);
constexpr size_t O_OUTB = O_VXL;
constexpr size_t O_INV = O_END;
constexpr size_t O_WLT = O_INV + AL((size_t)NT * 16 * 4);
constexpr size_t O_END1 = O_WLT + AL(2ull * 8 * 128 * 64 * 2);
constexpr int SMEM_BYTES = 71680;

struct Params {
  const float* in[44];
  float* out;
  unsigned char* ws;
};

DEVI u16 f2bf(float f) { uint32_t u = __float_as_uint(f); u += 0x7fffu + ((u >> 16) & 1u); return (u16)(u >> 16); }
DEVI float bf2f(u16 h) { return __uint_as_float(((uint32_t)h) << 16); }
DEVI uint32_t pack2(float a, float b) { return (uint32_t)f2bf(a) | ((uint32_t)f2bf(b) << 16); }
DEVI void unpack8(const uint4& x, float (&v)[8]) {
  v[0] = bf2f((u16)(x.x & 0xffff)); v[1] = bf2f((u16)(x.x >> 16)); v[2] = bf2f((u16)(x.y & 0xffff)); v[3] = bf2f((u16)(x.y >> 16));
  v[4] = bf2f((u16)(x.z & 0xffff)); v[5] = bf2f((u16)(x.z >> 16)); v[6] = bf2f((u16)(x.w & 0xffff)); v[7] = bf2f((u16)(x.w >> 16));
}

DEVI float sigm(float x) { return 1.f / (1.f + __expf(-x)); }
DEVI float siluf(float x) { return x * sigm(x); }
DEVI float geluf(float x) { float u = 0.7978845608028654f * (x + 0.044715f * x * x * x); return 0.5f * x * (1.f + tanhf(u)); }
DEVI float wsum(float v) { for (int o = 32; o > 0; o >>= 1) v += __shfl_xor(v, o); return v; }

DEVI void prep_tile(const float* src, int K, int N, u16* dst, int tile_id, float* tile) {
  int tpm = (K / 64) * (N / 64);
  int mat = tile_id / tpm, t = tile_id % tpm;
  int kt = t / (N / 64), nt = t % (N / 64);
  src += (size_t)mat * K * N; dst += (size_t)mat * K * N;
  int k0 = kt * 64, n0 = nt * 64, tid = TIDX;
  int r = tid >> 4, c4 = (tid & 15) * 4;
#pragma unroll
  for (int i = 0; i < 4; ++i) {
    int k = r + 16 * i;
    float4 v = *(const float4*)(src + (size_t)(k0 + k) * N + n0 + c4);
    tile[k * 65 + c4 + 0] = v.x; tile[k * 65 + c4 + 1] = v.y; tile[k * 65 + c4 + 2] = v.z; tile[k * 65 + c4 + 3] = v.w;
  }
  __syncthreads();
  int n = tid >> 3, kc = (tid & 7) * 8;
#pragma unroll
  for (int i = 0; i < 2; ++i) {
    int nn = n + 32 * i;
    uint4 o;
    o.x = pack2(tile[(kc + 0) * 65 + nn], tile[(kc + 1) * 65 + nn]);
    o.y = pack2(tile[(kc + 2) * 65 + nn], tile[(kc + 3) * 65 + nn]);
    o.z = pack2(tile[(kc + 4) * 65 + nn], tile[(kc + 5) * 65 + nn]);
    o.w = pack2(tile[(kc + 6) * 65 + nn], tile[(kc + 7) * 65 + nn]);
    *(uint4*)(dst + (size_t)(n0 + nn) * K + k0 + kc) = o;
  }
  __syncthreads();
}

DEVI void prep_tile128(const float* src, int K, int N, u16* dst, int tile_id, float* tile) {
  int tpm = (K / 128) * (N / 128);
  int mat = tile_id / tpm, t = tile_id % tpm;
  int kt = t / (N / 128), nt = t % (N / 128);
  src += (size_t)mat * K * N; dst += (size_t)mat * K * N;
  int k0 = kt * 128, n0 = nt * 128, tid = TIDX;
  int r = tid >> 5, c4 = (tid & 31) * 4;
#pragma unroll 4
  for (int i = 0; i < 16; ++i) {
    int k = r + 8 * i;
    float4 v = *(const float4*)(src + (size_t)(k0 + k) * N + n0 + c4);
    tile[k * 129 + c4 + 0] = v.x; tile[k * 129 + c4 + 1] = v.y; tile[k * 129 + c4 + 2] = v.z; tile[k * 129 + c4 + 3] = v.w;
  }
  __syncthreads();
  int n = tid >> 4, kc = (tid & 15) * 8;
#pragma unroll 2
  for (int i = 0; i < 8; ++i) {
    int nn = n + 16 * i;
    uint4 o;
    o.x = pack2(tile[(kc + 0) * 129 + nn], tile[(kc + 1) * 129 + nn]);
    o.y = pack2(tile[(kc + 2) * 129 + nn], tile[(kc + 3) * 129 + nn]);
    o.z = pack2(tile[(kc + 4) * 129 + nn], tile[(kc + 5) * 129 + nn]);
    o.w = pack2(tile[(kc + 6) * 129 + nn], tile[(kc + 7) * 129 + nn]);
    *(uint4*)(dst + (size_t)(n0 + nn) * K + k0 + kc) = o;
  }
  __syncthreads();
}

DEVI void prep_experts(const Params& p, int layer, int it, float* tile) {
  u16* wexp = (u16*)(p.ws + O_WEXP);
  int kind = it / 6144, t = it % 6144;
  if (kind == 0) prep_tile(p.in[40] + (size_t)layer * EXPSZ, 1024, 1536, wexp, t, tile);
  else if (kind == 1) prep_tile(p.in[41] + (size_t)layer * EXPSZ, 1024, 1536, wexp + EXPSZ, t, tile);
  else prep_tile(p.in[42] + (size_t)layer * EXPSZ, 1536, 1024, wexp + 2 * EXPSZ, t, tile);
}

DEVI void mod_item(const Params& p, int it, float* sm) {
  int l = it / 96, j0 = (it % 96) * 64, tid = TIDX;
  float* sc = sm;
  float* red = sm + 9 * 1024;
  for (int i = tid; i < 9 * 1024; i += 256) {
    int r = i >> 10, k = i & 1023;
    float v = (r < 8) ? p.in[1][r * 1024 + k] : p.in[3][k];
    sc[i] = siluf(v);
  }
  __syncthreads();
  int col = tid & 63, kq = tid >> 6;
  float acc[9];
#pragma unroll
  for (int r = 0; r < 9; ++r) acc[r] = 0.f;
  const float* w = p.in[4] + (size_t)l * 1024 * 6144 + j0 + col;
#pragma unroll 8
  for (int k = kq * 256; k < kq * 256 + 256; ++k) {
    float wv = w[(size_t)k * 6144];
#pragma unroll
    for (int r = 0; r < 9; ++r) acc[r] += sc[r * 1024 + k] * wv;
  }
#pragma unroll
  for (int r = 0; r < 9; ++r) red[(kq * 9 + r) * 64 + col] = acc[r];
  __syncthreads();
  float* mod = (float*)(p.ws + O_MOD);
  for (int i = tid; i < 9 * 64; i += 256) {
    int r = i >> 6, c = i & 63;
    float s = red[(0 * 9 + r) * 64 + c] + red[(1 * 9 + r) * 64 + c] + red[(2 * 9 + r) * 64 + c] + red[(3 * 9 + r) * 64 + c];
    mod[((size_t)l * 9 + r) * 6144 + j0 + c] = s + p.in[5][l * 6144 + j0 + c];
  }
  __syncthreads();
}

DEVI void filt_item(const Params& p, int it, float* sm) {
  int L, t0, blk; float* fraw;
  if (it < 256) { L = 4096; t0 = it * 16; blk = it; fraw = (float*)(p.ws + O_FRAWL); }
  else { L = 256; t0 = (it - 256) * 16; blk = it; fraw = (float*)(p.ws + O_FRAWC); }
  float* z = sm;
  float* h1 = sm + 16 * 33;
  float* h2 = h1 + 16 * 64;
  int tid = TIDX;
  const float* w1 = p.in[19]; const float* b1 = p.in[20]; const float* w2 = p.in[21]; const float* b2 = p.in[22];
  const float* w3 = p.in[23]; const float* fr = p.in[24];
  for (int i = tid; i < 16 * 33; i += 256) {
    int pos = i / 33, c = i % 33;
    float t = (float)(t0 + pos);
    float v;
    if (c == 0) v = t / (float)(L - 1);
    else {
      int bi = (c - 1) & 15;
      float band = 1e-4f + (float)bi * ((15.f - 1e-4f) / 15.f);
      float ang = ((6.283185307179586f / (float)L) * t) * band;
      v = (c <= 16) ? cosf(ang) : -sinf(ang);
    }
    z[i] = v;
  }
  __syncthreads();
  for (int i = tid; i < 16 * 64; i += 256) {
    int pos = i >> 6, j = i & 63;
    float s = b1[j];
#pragma unroll 3
    for (int k = 0; k < 33; ++k) s += z[pos * 33 + k] * w1[k * 64 + j];
    h1[i] = sinf(fr[j] * s);
  }
  __syncthreads();
  for (int i = tid; i < 16 * 64; i += 256) {
    int pos = i >> 6, j = i & 63;
    float s = b2[j];
#pragma unroll 4
    for (int k = 0; k < 64; ++k) s += h1[pos * 64 + k] * w2[k * 64 + j];
    h2[i] = sinf(fr[j] * s);
  }
  __syncthreads();
  float* csum = (float*)(p.ws + O_CSUM);
  const float dmin = -3.0701134573253946f, dmax = -15.350567286626973f;
#pragma unroll 1
  for (int cc = 0; cc < 4; ++cc) {
    int col = tid + 256 * cc;
    float acc[16];
#pragma unroll
    for (int q = 0; q < 16; ++q) acc[q] = 0.f;
#pragma unroll 8
    for (int k = 0; k < 64; ++k) {
      float wv = w3[k * 1024 + col];
#pragma unroll
      for (int q = 0; q < 16; ++q) acc[q] += h2[q * 64 + k] * wv;
    }
    float delta = fabsf(dmin + (float)col * ((dmax - dmin) / 1023.f));
    float ss = 0.f;
#pragma unroll
    for (int q = 0; q < 16; ++q) {
      float t = (float)(t0 + q);
      float dist = fabsf(t - (float)(L / 2)) / ((float)L * 0.5f);
      float v = acc[q] * expf(-dist * delta);
      fraw[(size_t)(t0 + q) * 1024 + col] = v;
      ss += v * v;
    }
    csum[(size_t)blk * 1024 + col] = ss;
  }
  __syncthreads();
}

DEVI void filtfin_item(const Params& p, int it, float* sm) {
  int L, gs, ct, mt, nb, b0; const float* fraw; u16* G;
  if (it < 16 * 66) { L = 4096; gs = GLS; ct = it / 66; mt = it % 66; nb = 256; b0 = 0; fraw = (const float*)(p.ws + O_FRAWL); G = (u16*)(p.ws + O_GL); }
  else { int j = it - 16 * 66; L = 256; gs = GCS; ct = j / 6; mt = j % 6; nb = 16; b0 = 256; fraw = (const float*)(p.ws + O_FRAWC); G = (u16*)(p.ws + O_GC); }
  float* scale = sm;
  float* red = sm + 64;
  float* tile = sm + 64 + 256;
  int tid = TIDX, c0 = ct * 64, m0 = mt * 64;
  const float* csum = (const float*)(p.ws + O_CSUM);
  {
    int c = tid & 63, q = tid >> 6;
    float s = 0.f;
#pragma unroll 8
    for (int b = q; b < nb; b += 4) s += csum[(size_t)(b0 + b) * 1024 + c0 + c];
    red[q * 64 + c] = s;
  }
  __syncthreads();
  if (tid < 64) scale[tid] = rsqrtf(red[tid] + red[64 + tid] + red[128 + tid] + red[192 + tid] + 1e-6f);
  int thi = L + 63 - m0;
  for (int i = tid; i < 65 * 64; i += 256) {
    int rr = i >> 6, c = i & 63;
    int t = thi - rr;
    tile[rr * 65 + c] = (t >= 0 && t < L) ? fraw[(size_t)t * 1024 + c0 + c] : 0.f;
  }
  __syncthreads();
  for (int i = tid; i < 2 * 64 * 8; i += 256) {
    int m8 = (i & 7) * 8, c = (i >> 3) & 63, par = i >> 9;
    float sc = scale[c];
    uint4 o;
    o.x = pack2(tile[(m8 + 0 + par) * 65 + c] * sc, tile[(m8 + 1 + par) * 65 + c] * sc);
    o.y = pack2(tile[(m8 + 2 + par) * 65 + c] * sc, tile[(m8 + 3 + par) * 65 + c] * sc);
    o.z = pack2(tile[(m8 + 4 + par) * 65 + c] * sc, tile[(m8 + 5 + par) * 65 + c] * sc);
    o.w = pack2(tile[(m8 + 6 + par) * 65 + c] * sc, tile[(m8 + 7 + par) * 65 + c] * sc);
    *(uint4*)(G + ((size_t)par * 1024 + c0 + c) * gs + m0 + m8) = o;
  }
  __syncthreads();
}

DEVI void moe_combine(const Params& p, int r, int lane, float4 (&v)[4]) {
  const int* inv = (const int*)(p.ws + O_INV) + (size_t)r * 16;
  const u16* ob = (const u16*)(p.ws + O_OUTB);
  int myslot = (lane < 16) ? inv[lane] : -1;
  unsigned long long mask = __ballot(myslot >= 0);
  while (mask) {
    int e0 = __ffsll((long long)mask) - 1; mask &= mask - 1;
    int s0 = __shfl(myslot, e0);
    int e1 = -1, s1 = 0;
    if (mask) { e1 = __ffsll((long long)mask) - 1; mask &= mask - 1; s1 = __shfl(myslot, e1); }
    const u16* r0 = ob + ((size_t)e0 * 4352 + s0) * 1024 + lane * 4;
    uint2 q0[4], q1[4];
#pragma unroll
    for (int i = 0; i < 4; ++i) q0[i] = *(const uint2*)(r0 + 256 * i);
    if (e1 >= 0) {
      const u16* r1 = ob + ((size_t)e1 * 4352 + s1) * 1024 + lane * 4;
#pragma unroll
      for (int i = 0; i < 4; ++i) q1[i] = *(const uint2*)(r1 + 256 * i);
    } else {
#pragma unroll
      for (int i = 0; i < 4; ++i) q1[i] = make_uint2(0u, 0u);
    }
#pragma unroll
    for (int i = 0; i < 4; ++i) {
      v[i].x += bf2f((u16)(q0[i].x & 0xffff)); v[i].y += bf2f((u16)(q0[i].x >> 16)); v[i].z += bf2f((u16)(q0[i].y & 0xffff)); v[i].w += bf2f((u16)(q0[i].y >> 16));
      v[i].x += bf2f((u16)(q1[i].x & 0xffff)); v[i].y += bf2f((u16)(q1[i].x >> 16)); v[i].z += bf2f((u16)(q1[i].y & 0xffff)); v[i].w += bf2f((u16)(q1[i].y >> 16));
    }
  }
}

DEVI void ph_norm(const Params& p, int layer, int which, bool with_ctx, bool perm, bool router, bool combine, float* smf) {
  const float* xl = (layer == 0 && which == 1) ? p.in[0] : p.out;
  const float* xc = (layer == 0 && which == 1) ? p.in[2] : (const float*)(p.ws + O_XC);
  const float* g = p.in[which == 1 ? 6 : 7] + layer * 1024;
  const float* mod = (const float*)(p.ws + O_MOD) + (size_t)layer * 9 * 6144;
  int sh = (which == 1) ? 0 : 3;
  u16* hb = (u16*)(p.ws + O_HB);
  float* aff = (float*)(p.ws + O_AFF);
  const float* rw = p.in[39] + (size_t)layer * 1024 * 16;
  int lane = TIDX & 63, wave = TIDX >> 6;
  int nrows = with_ctx ? NT : NL;
  float4* rws = (float4*)smf;
  if (router) {
    for (int i = TIDX; i < 4096; i += 256) {
      int k = i >> 2, e4 = i & 3;
      rws[((e4 * 4 + (k & 3)) * 4 + (k >> 8)) * 64 + ((k >> 2) & 63)] = *(const float4*)(rw + (size_t)k * 16 + e4 * 4);
    }
    __syncthreads();
  }
  for (int r = blockIdx.x * 4 + wave; r < nrows; r += gridDim.x * 4) {
    const float* src; int mr; size_t drow;
    if (r < NL) {
      src = xl + (size_t)r * 1024; mr = r >> 12;
      if (perm) { int t = r & 4095; drow = (size_t)(r & ~4095) + (t & 63) * 64 + (t >> 6); } else drow = r;
    } else { src = xc + (size_t)(r - NL) * 1024; mr = 8; drow = r; }
    float4 v[4]; float ss = 0.f;
#pragma unroll
    for (int i = 0; i < 4; ++i) v[i] = *(const float4*)(src + lane * 4 + 256 * i);
    if (combine) {
      moe_combine(p, r, lane, v);
      float* wb = (float*)src;
#pragma unroll
      for (int i = 0; i < 4; ++i) *(float4*)(wb + lane * 4 + 256 * i) = v[i];
    }
#pragma unroll
    for (int i = 0; i < 4; ++i) ss += v[i].x * v[i].x + v[i].y * v[i].y + v[i].z * v[i].z + v[i].w * v[i].w;
    ss = wsum(ss);
    float rs = rsqrtf(ss * (1.f / 1024.f) + 1e-6f);
    const float* shp = mod + (size_t)mr * 6144 + sh * 1024;
    const float* scp = shp + 1024;
    float lg[16];
    if (router) {
#pragma unroll
      for (int e = 0; e < 16; ++e) lg[e] = 0.f;
    }
#pragma unroll
    for (int i = 0; i < 4; ++i) {
      int k = lane * 4 + 256 * i;
      float4 gg = *(const float4*)(g + k), s4 = *(const float4*)(shp + k), c4 = *(const float4*)(scp + k);
      float h0 = (v[i].x * rs * gg.x) * (1.f + c4.x) + s4.x;
      float h1 = (v[i].y * rs * gg.y) * (1.f + c4.y) + s4.y;
      float h2 = (v[i].z * rs * gg.z) * (1.f + c4.z) + s4.z;
      float h3 = (v[i].w * rs * gg.w) * (1.f + c4.w) + s4.w;
      uint2 o; o.x = pack2(h0, h1); o.y = pack2(h2, h3);
      *(uint2*)(hb + drow * 1024 + k) = o;
      if (router) {
        float hh[4] = {h0, h1, h2, h3};
#pragma unroll
        for (int q = 0; q < 4; ++q) {
#pragma unroll
          for (int e4 = 0; e4 < 4; ++e4) {
            float4 w = rws[((e4 * 4 + q) * 4 + i) * 64 + lane];
            lg[e4 * 4 + 0] += hh[q] * w.x; lg[e4 * 4 + 1] += hh[q] * w.y; lg[e4 * 4 + 2] += hh[q] * w.z; lg[e4 * 4 + 3] += hh[q] * w.w;
          }
          __builtin_amdgcn_sched_barrier(0);
        }
      }
    }
    if (router) {
      float mx = -1e30f;
#pragma unroll
      for (int e = 0; e < 16; ++e) { lg[e] = wsum(lg[e]); mx = fmaxf(mx, lg[e]); }
      float den = 0.f;
#pragma unroll
      for (int e = 0; e < 16; ++e) { lg[e] = expf(lg[e] - mx); den += lg[e]; }
      float inv = 1.f / den;
      float mine = 0.f;
#pragma unroll
      for (int e = 0; e < 16; ++e) if (lane == e) mine = lg[e] * inv;
      if (lane < 16) aff[(size_t)r * 16 + lane] = mine;
    }
  }
}

DEVI int vbid() { int nb = gridDim.x; return ((nb & 7) == 0) ? (int)((blockIdx.x & 7) * (nb >> 3) + (blockIdx.x >> 3)) : (int)blockIdx.x; }

DEVI uint32_t gemm_boff(int i, uint32_t ldb) { return ldb ? (uint32_t)i * 32u * ldb : (((i & 3) < 2) ? 0u : (uint32_t)EXPSZ) + (uint32_t)((i >> 2) * 64 + 32 * (i & 1)) * 1024u; }
template <bool GATHER>
DEVI void gemm_core(u16* sm, const u16* Ab, const uint32_t (&pa)[4], uint32_t lda, const u16* Bb, uint32_t pb0, uint32_t ldb, int K, f32x4 (&acc)[8][4]) {
  u16* As = sm; u16* Bs = sm + 128 * 72;
  int tid = TIDX, lane = tid & 63, wid = tid >> 6, wr = wid >> 1, wc = wid & 1;
  int fr = lane & 15, fq = lane >> 4;
  int lrow = tid >> 3, lkc = (tid & 7) * 8;
  u32x4 ra[4], rb[8];
#pragma unroll
  for (int i = 0; i < 4; ++i) ra[i] = *(const u32x4*)(Ab + (GATHER ? pa[i] : pa[0] + (uint32_t)i * 32u * lda));
#pragma unroll
  for (int i = 0; i < 8; ++i) rb[i] = *(const u32x4*)(Bb + pb0 + gemm_boff(i, ldb));
#pragma unroll
  for (int a = 0; a < 8; ++a)
#pragma unroll
    for (int b = 0; b < 4; ++b) acc[a][b] = (f32x4){0.f, 0.f, 0.f, 0.f};
  int nk = K >> 6;
  for (int kt = 0; kt < nk; ++kt) {
    __syncthreads();
#pragma unroll
    for (int i = 0; i < 4; ++i) *(u32x4*)(As + (lrow + 32 * i) * 72 + lkc) = ra[i];
#pragma unroll
    for (int i = 0; i < 8; ++i) *(u32x4*)(Bs + (lrow + 32 * i) * 72 + lkc) = rb[i];
    __syncthreads();
    if (kt + 1 < nk) {
#pragma unroll
      for (int i = 0; i < 4; ++i) ra[i] = *(const u32x4*)(Ab + (GATHER ? pa[i] : pa[0] + (uint32_t)i * 32u * lda) + (kt + 1) * 64);
#pragma unroll
      for (int i = 0; i < 8; ++i) rb[i] = *(const u32x4*)(Bb + pb0 + gemm_boff(i, ldb) + (kt + 1) * 64);
    }
    __builtin_amdgcn_sched_barrier(0);
#pragma unroll
    for (int ks = 0; ks < 2; ++ks) {
      bf16x8 af[4];
#pragma unroll
      for (int m = 0; m < 4; ++m) af[m] = *(const bf16x8*)(As + (wr * 64 + m * 16 + fr) * 72 + ks * 32 + fq * 8);
#pragma unroll
      for (int nh = 0; nh < 4; ++nh) {
        bf16x8 bfm[2];
#pragma unroll
        for (int n = 0; n < 2; ++n) bfm[n] = *(const bf16x8*)(Bs + (wc * 128 + (nh * 2 + n) * 16 + fr) * 72 + ks * 32 + fq * 8);
#pragma unroll
        for (int n = 0; n < 2; ++n)
#pragma unroll
          for (int m = 0; m < 4; ++m) acc[nh * 2 + n][m] = __builtin_amdgcn_mfma_f32_16x16x32_bf16(bfm[n], af[m], acc[nh * 2 + n][m], 0, 0, 0);
      }
      __builtin_amdgcn_sched_barrier(0);
    }
  }
  __syncthreads();
}

DEVI void ph_gemm_in(const Params& p, u16* sm, const u16* Wt, int N) {
  const u16* H = (const u16*)(p.ws + O_HB);
  u16* U = (u16*)(p.ws + O_U);
  int ntl = N / 256, nitems = 272 * ntl;
  int tid = TIDX, lane = tid & 63, wid = tid >> 6, wr = wid >> 1, wc = wid & 1, fr = lane & 15, fq = lane >> 4;
  int lr = tid >> 3, kc = (tid & 7) * 8;
  int gsz = (ntl == 10) ? 5 : 4;
  for (int it = vbid(); it < nitems; it += gridDim.x) {
    int ng = it / (272 * gsz), rem = it % (272 * gsz);
    int m0 = (rem / gsz) * 128, n0 = (ng * gsz + rem % gsz) * 256;
    uint32_t pa[4], pb0 = (uint32_t)(n0 + lr) * 1024u + kc;
#pragma unroll
    for (int i = 0; i < 4; ++i) pa[i] = (uint32_t)(m0 + lr + 32 * i) * 1024u + kc;
    f32x4 acc[8][4];
    gemm_core<false>(sm, H, pa, 1024u, Wt, pb0, 1024u, 1024, acc);
#pragma unroll
    for (int n = 0; n < 8; ++n)
#pragma unroll
      for (int m = 0; m < 4; ++m) {
        int row = m0 + wr * 64 + m * 16 + fr, col = n0 + wc * 128 + n * 16 + fq * 4;
        uint2 o; o.x = pack2(acc[n][m][0], acc[n][m][1]); o.y = pack2(acc[n][m][2], acc[n][m][3]);
        *(uint2*)(U + (size_t)row * N + col) = o;
      }
  }
}

DEVI void ph_gemm_out(const Params& p, u16* sm, int layer) {
  const u16* Y = (const u16*)(p.ws + O_HB);
  const u16* Wt = (const u16*)(p.ws + O_WOUT) + (size_t)layer * 1024 * 1024;
  const float* mod = (const float*)(p.ws + O_MOD) + (size_t)layer * 9 * 6144 + 2 * 1024;
  float* xcw = (float*)(p.ws + O_XC);
  int mtiles = (layer == 0) ? 272 : 256, nitems = mtiles * 4;
  int tid = TIDX, lane = tid & 63, wid = tid >> 6, wr = wid >> 1, wc = wid & 1, fr = lane & 15, fq = lane >> 4;
  int lr = tid >> 3, kc = (tid & 7) * 8;
  for (int it = vbid(); it < nitems; it += gridDim.x) {
    int m0 = (it / 4) * 128, n0 = (it % 4) * 256;
    uint32_t pa[4], pb0 = (uint32_t)(n0 + lr) * 1024u + kc;
#pragma unroll
    for (int i = 0; i < 4; ++i) pa[i] = (uint32_t)(m0 + lr + 32 * i) * 1024u + kc;
    f32x4 acc[8][4];
    gemm_core<false>(sm, Y, pa, 1024u, Wt, pb0, 1024u, 1024, acc);
#pragma unroll
    for (int m = 0; m < 4; ++m) {
      int r = m0 + wr * 64 + m * 16 + fr;
      const float* xin; float* dst; int mr;
      if (r < NL) {
        mr = r >> 12; size_t tok = r;
        if (layer == 1) { int pp = r & 4095; tok = (size_t)(r & ~4095) + (pp & 63) * 64 + (pp >> 6); }
        xin = ((layer == 0) ? p.in[0] : (const float*)p.out) + tok * 1024; dst = p.out + tok * 1024;
      } else { mr = 8; size_t cr = r - NL; xin = p.in[2] + cr * 1024; dst = xcw + cr * 1024; }
      const float* gl = mod + (size_t)mr * 6144;
#pragma unroll
      for (int n = 0; n < 8; ++n) {
        int col = n0 + wc * 128 + n * 16 + fq * 4;
        float4 xv = *(const float4*)(xin + col), gv = *(const float4*)(gl + col);
        float4 o = make_float4(xv.x + gv.x * acc[n][m][0], xv.y + gv.y * acc[n][m][1], xv.z + gv.z * acc[n][m][2], xv.w + gv.w * acc[n][m][3]);
        *(float4*)(dst + col) = o;
      }
    }
  }
}
DEVI void lru_gates(const Params& p, const float* xh, const u16* xhb, float* z, int dir, int h, int j, int tg, float (&a)[16], float (&bb)[16]) {
  int lane = TIDX & 63, w = TIDX >> 6, fr = lane & 15, fq = lane >> 4;
  const u16* WL = (const u16*)(p.ws + O_WLT) + (size_t)((dir * 8 + h) * 128) * 64;
  f32x4 acc[2][4];
#pragma unroll
  for (int n = 0; n < 2; ++n)
#pragma unroll
    for (int m = 0; m < 4; ++m) acc[n][m] = (f32x4){0.f, 0.f, 0.f, 0.f};
#pragma unroll
  for (int ks = 0; ks < 2; ++ks) {
    bf16x8 wf[2], xf[4];
#pragma unroll
    for (int n = 0; n < 2; ++n) wf[n] = *(const bf16x8*)(WL + ((2 * w + n) * 16 + fr) * 64 + ks * 32 + fq * 8);
#pragma unroll
    for (int m = 0; m < 4; ++m) xf[m] = *(const bf16x8*)(xhb + (m * 16 + fr) * 72 + ks * 32 + fq * 8);
#pragma unroll
    for (int n = 0; n < 2; ++n)
#pragma unroll
      for (int m = 0; m < 4; ++m) acc[n][m] = __builtin_amdgcn_mfma_f32_16x16x32_bf16(wf[n], xf[m], acc[n][m], 0, 0, 0);
  }
#pragma unroll
  for (int n = 0; n < 2; ++n)
#pragma unroll
    for (int m = 0; m < 4; ++m)
      *(float4*)(z + (m * 16 + fr) * 132 + (2 * w + n) * 16 + 4 * fq) = make_float4(acc[n][m][0], acc[n][m][1], acc[n][m][2], acc[n][m][3]);
  __syncthreads();
  int gi = (dir * 8 + h) * 64 + j;
  float bav = p.in[13][gi], bxv = p.in[15][gi], lam = p.in[16][gi];
  float sp = log1pf(expf(-lam));
#pragma unroll
  for (int q = 0; q < 16; ++q) {
    int tok = tg * 16 + q;
    float r = sigm(z[tok * 132 + j] + bav), ig = sigm(z[tok * 132 + 64 + j] + bxv);
    float la = -8.f * r * sp;
    a[q] = __expf(la);
    bb[q] = sqrtf(1.f - __expf(2.f * la)) * ig * xh[tok * 64 + j];
  }
  __syncthreads();
}

DEVI void lru_item(const Params& p, int it, unsigned char* smem, int mode) {
  int ci = it >> 3, h = it & 7;
  int rowbase, t0, slen;
  if (ci < 512) { rowbase = (ci >> 6) * 4096; t0 = (ci & 63) * 64; slen = 4096; }
  else { int cc = ci - 512; rowbase = NL + (cc >> 2) * 256; t0 = (cc & 3) * 64; slen = 256; }
  const u16* U = (const u16*)(p.ws + O_U);
  float* xh = (float*)smem;
  u16* xhb = (u16*)(smem + 16384);
  float* z = (float*)(smem + 25600);
  float* xraw = z;
  float* agg = (float*)(smem + 59392);
  int tid = TIDX, j = tid & 63, tg = tid >> 6;
  for (int i = tid; i < 67 * 8; i += 256) {
    int rr = i >> 3, c8 = (i & 7) * 8, t = t0 - 1 + rr;
    float v8[8];
    if (t >= 0 && t < slen) unpack8(*(const uint4*)(U + (size_t)(rowbase + t) * 2560 + h * 64 + c8), v8);
    else { for (int k = 0; k < 8; ++k) v8[k] = 0.f; }
#pragma unroll
    for (int k = 0; k < 8; ++k) xraw[rr * 64 + c8 + k] = v8[k];
  }
  __syncthreads();
  {
    const float* cw = p.in[10]; int ch = h * 64 + j;
    float w0 = cw[ch], w1 = cw[512 + ch], w2 = cw[1024 + ch], w3 = cw[1536 + ch], cb = p.in[11][ch];
#pragma unroll
    for (int q = 0; q < 16; ++q) {
      int t = tg * 16 + q;
      float v = cb + w0 * xraw[t * 64 + j] + w1 * xraw[(t + 1) * 64 + j] + w2 * xraw[(t + 2) * 64 + j] + w3 * xraw[(t + 3) * 64 + j];
      xh[t * 64 + j] = v; xhb[t * 72 + j] = f2bf(v);
    }
  }
  __syncthreads();
  float af[16], bf_[16], ab[16], bk[16];
  lru_gates(p, xh, xhb, z, 0, h, j, tg, af, bf_);
  lru_gates(p, xh, xhb, z, 1, h, j, tg, ab, bk);
  {
    float P = 1.f, S = 0.f;
#pragma unroll
    for (int q = 0; q < 16; ++q) { S = af[q] * S + bf_[q]; P *= af[q]; }
    agg[((0 * 4 + tg) * 2 + 0) * 64 + j] = P; agg[((0 * 4 + tg) * 2 + 1) * 64 + j] = S;
    P = 1.f; S = 0.f;
#pragma unroll
    for (int q = 15; q >= 0; --q) { S = ab[q] * S + bk[q]; P *= ab[q]; }
    agg[((1 * 4 + tg) * 2 + 0) * 64 + j] = P; agg[((1 * 4 + tg) * 2 + 1) * 64 + j] = S;
  }
  __syncthreads();
  int ch = h * 64 + j;
  if (mode == 1) {
    if (tg == 0) {
      float* agp = (float*)(p.ws + O_AGP); float* ags = (float*)(p.ws + O_AGS);
      float P = 1.f, S = 0.f;
      for (int g = 0; g < 4; ++g) { float pg = agg[((0 * 4 + g) * 2 + 0) * 64 + j], sg = agg[((0 * 4 + g) * 2 + 1) * 64 + j]; S = pg * S + sg; P *= pg; }
      agp[((size_t)0 * 544 + ci) * 512 + ch] = P; ags[((size_t)0 * 544 + ci) * 512 + ch] = S;
      P = 1.f; S = 0.f;
      for (int g = 3; g >= 0; --g) { float pg = agg[((1 * 4 + g) * 2 + 0) * 64 + j], sg = agg[((1 * 4 + g) * 2 + 1) * 64 + j]; S = pg * S + sg; P *= pg; }
      agp[((size_t)1 * 544 + ci) * 512 + ch] = P; ags[((size_t)1 * 544 + ci) * 512 + ch] = S;
    }
  } else {
    const float* hs = (const float*)(p.ws + O_HS);
    u16* Y = (u16*)(p.ws + O_HB);
    float s = hs[((size_t)0 * 544 + ci) * 512 + ch];
    for (int g = 0; g < tg; ++g) s = agg[((0 * 4 + g) * 2 + 0) * 64 + j] * s + agg[((0 * 4 + g) * 2 + 1) * 64 + j];
    float hf[16];
#pragma unroll
    for (int q = 0; q < 16; ++q) { s = af[q] * s + bf_[q]; hf[q] = s; }
    s = hs[((size_t)1 * 544 + ci) * 512 + ch];
    for (int g = 3; g > tg; --g) s = agg[((1 * 4 + g) * 2 + 0) * 64 + j] * s + agg[((1 * 4 + g) * 2 + 1) * 64 + j];
#pragma unroll
    for (int q = 15; q >= 0; --q) {
      s = ab[q] * s + bk[q];
      size_t row = (size_t)(rowbase + t0 + tg * 16 + q);
      float xg = bf2f(U[row * 2560 + 512 + ch]);
      Y[row * 1024 + ch] = f2bf((hf[q] + s) * geluf(xg));
    }
  }
  __syncthreads();
}

DEVI void lru_combine_item(const Params& p, int it) {
  int gt = it * 256 + TIDX;
  int dir = gt >> 12, b = (gt >> 9) & 7, ch = gt & 511;
  const float* agp = (const float*)(p.ws + O_AGP) + (size_t)dir * 544 * 512 + ch;
  const float* ags = (const float*)(p.ws + O_AGS) + (size_t)dir * 544 * 512 + ch;
  float* hs = (float*)(p.ws + O_HS) + (size_t)dir * 544 * 512 + ch;
  float s = 0.f;
#pragma unroll 1
  for (int kb = 0; kb < 68; kb += 17) {
    float P[17], S[17]; int ci[17];
#pragma unroll
    for (int q = 0; q < 17; ++q) {
      int k = kb + q;
      ci[q] = (k < 4) ? (512 + b * 4 + (dir ? 3 - k : k)) : (b * 64 + (dir ? 67 - k : k - 4));
      P[q] = agp[(size_t)ci[q] * 512]; S[q] = ags[(size_t)ci[q] * 512];
    }
#pragma unroll
    for (int q = 0; q < 17; ++q) { hs[(size_t)ci[q] * 512] = s; s = P[q] * s + S[q]; }
  }
}

DEVI void hyconv_item(const Params& p, int it, float* sm) {
  int ci = it / 24, ct = it % 24;
  int rowbase, t0, slen, b; u16* dst; int L;
  if (ci < 512) { b = ci >> 6; rowbase = b * 4096; t0 = (ci & 63) * 64; slen = 4096; dst = (u16*)(p.ws + O_VXL); L = 4096; }
  else { int cc = ci - 512; b = cc >> 2; rowbase = NL + b * 256; t0 = (cc & 3) * 64; slen = 256; dst = (u16*)(p.ws + O_VXC); L = 256; }
  const u16* U = (const u16*)(p.ws + O_U);
  float* xs = sm;
  int tid = TIDX, c0 = ct * 64;
  for (int i = tid; i < 66 * 8; i += 256) {
    int rr = i >> 3, c8 = (i & 7) * 8, t = t0 - 1 + rr;
    float v8[8];
    if (t >= 0 && t < slen) unpack8(*(const uint4*)(U + (size_t)(rowbase + t) * 2560 + 1024 + c0 + c8), v8);
    else { for (int k = 0; k < 8; ++k) v8[k] = 0.f; }
#pragma unroll
    for (int k = 0; k < 8; ++k) xs[rr * 65 + c8 + k] = v8[k];
  }
  __syncthreads();
  int c = tid >> 2, tq = tid & 3, ch = c0 + c;
  const float* hw = p.in[17];
  float w0 = hw[ch], w1 = hw[1536 + ch], w2 = hw[3072 + ch], cb = p.in[18][ch];
  int which = ch >> 9, cc = ch & 511;
  uint32_t o[8];
#pragma unroll
  for (int q = 0; q < 8; ++q) {
    int tl = tq * 16 + 2 * q;
    float y0 = cb + w0 * xs[tl * 65 + c] + w1 * xs[(tl + 1) * 65 + c] + w2 * xs[(tl + 2) * 65 + c];
    float y1 = cb + w0 * xs[(tl + 1) * 65 + c] + w1 * xs[(tl + 2) * 65 + c] + w2 * xs[(tl + 3) * 65 + c];
    o[q] = pack2(y0, y1);
  }
  u16* d = dst + ((size_t)(which * 8 + b) * 512 + cc) * L + t0 + tq * 16;
  *(uint4*)d = make_uint4(o[0], o[1], o[2], o[3]);
  *(uint4*)(d + 8) = make_uint4(o[4], o[5], o[6], o[7]);
  __syncthreads();
}

DEVI void toep_item(const Params& p, int it, u16* Xs, int order) {
  int c, half, L, gs; const u16* G; const u16* vx; const u16* z1; u16* z1w;
  if (it < 1024) { c = it >> 1; half = it & 1; L = 4096; gs = GLS; G = (const u16*)(p.ws + O_GL); vx = (const u16*)(p.ws + O_VXL); z1 = (const u16*)(p.ws + O_Z1L); z1w = (u16*)(p.ws + O_Z1L); }
  else { c = it - 1024; half = 0; L = 256; gs = GCS; G = (const u16*)(p.ws + O_GC); vx = (const u16*)(p.ws + O_VXC); z1 = (const u16*)(p.ws + O_Z1C); z1w = (u16*)(p.ws + O_Z1C); }
  int T1 = L >> 6, ntiles = T1 >> 1, XS = L + 8;
  int tid = TIDX, lane = tid & 63, w = tid >> 6, fr = lane & 15, fq = lane >> 4;
  const u16* xsrc = (order == 0) ? vx : z1;
  int l8 = L >> 3;
  for (int i = tid; i < 8 * l8; i += 256) {
    int b = i / l8, k8 = i % l8;
    *(uint4*)(Xs + b * XS + k8 * 8) = *(const uint4*)(xsrc + ((size_t)b * 512 + c) * L + k8 * 8);
  }
  __syncthreads();
  f32x4 acc[4][4];
#pragma unroll
  for (int a = 0; a < 4; ++a)
#pragma unroll
    for (int b = 0; b < 4; ++b) acc[a][b] = (f32x4){0.f, 0.f, 0.f, 0.f};
  const u16* Gp = G + (size_t)(order * 512 + c) * gs;
  size_t parstride = (size_t)1024 * gs;
  int bq = fr & 7, t1off = fr >> 3;
  int dmax = L >> 7;
  int base = (L >> 1) + 63 - fr + 8 * fq, par = base & 1;
  const u16* wp = Gp + par * parstride + (base - par);
  auto ldw = [&](int u) { bf16x8 r; uint32_t t4[4]; __builtin_memcpy(t4, (const uint32_t*)(wp + 16 * u), 16); __builtin_memcpy(&r, t4, 16); return r; };
  bf16x8 W[6], Nw[4];
  int t1lo = 2 * (half * 16 + w * 4);
  int dlo = max(-dmax, t1lo - (T1 - 1)), dhi = min(dmax, t1lo + 7);
#pragma unroll
  for (int j = 0; j < 6; ++j) W[j] = ldw(-4 * dlo - 3 + j);
#pragma unroll 1
  for (int d = dlo; d <= dhi; ++d) {
    if (d < dhi) {
#pragma unroll
      for (int j = 0; j < 4; ++j) Nw[j] = ldw(-4 * (d + 1) - 3 + j);
    }
#pragma unroll
    for (int n = 0; n < 4; ++n) {
      int Tn = half * 16 + w * 4 + n;
      int s1 = 2 * Tn + t1off - d;
      bool valid = (Tn < ntiles) && (s1 >= 0) && (s1 < T1);
      int s1c = valid ? s1 : 0;
#pragma unroll
      for (int ks = 0; ks < 2; ++ks) {
        bf16x8 bfrag = *(const bf16x8*)(Xs + bq * XS + s1c * 64 + 32 * ks + 8 * fq);
        if (!valid) bfrag = (bf16x8){0, 0, 0, 0, 0, 0, 0, 0};
#pragma unroll
        for (int m = 0; m < 4; ++m) acc[n][m] = __builtin_amdgcn_mfma_f32_16x16x32_bf16(W[3 - m + 2 * ks], bfrag, acc[n][m], 0, 0, 0);
      }
    }
    W[4] = W[0]; W[5] = W[1];
#pragma unroll
    for (int j = 0; j < 4; ++j) W[j] = Nw[j];
  }
  float skip = p.in[25][order * 512 + c];
#pragma unroll
  for (int n = 0; n < 4; ++n) {
    int Tn = half * 16 + w * 4 + n;
    if (Tn < ntiles) {
      int t1 = 2 * Tn + t1off;
#pragma unroll
      for (int m = 0; m < 4; ++m) {
        int t = 64 * t1 + 16 * m + 4 * fq;
        uint2 xin = *(const uint2*)(Xs + bq * XS + t);
        uint2 xm = *(const uint2*)(vx + ((size_t)((order + 1) * 8 + bq) * 512 + c) * L + t);
        float u0 = bf2f((u16)(xin.x & 0xffff)), u1 = bf2f((u16)(xin.x >> 16)), u2 = bf2f((u16)(xin.y & 0xffff)), u3 = bf2f((u16)(xin.y >> 16));
        float m0 = bf2f((u16)(xm.x & 0xffff)), m1 = bf2f((u16)(xm.x >> 16)), m2 = bf2f((u16)(xm.y & 0xffff)), m3 = bf2f((u16)(xm.y >> 16));
        float r0 = m0 * (acc[n][m][0] + skip * u0), r1 = m1 * (acc[n][m][1] + skip * u1);
        float r2 = m2 * (acc[n][m][2] + skip * u2), r3 = m3 * (acc[n][m][3] + skip * u3);
        {
          uint2 o; o.x = pack2(r0, r1); o.y = pack2(r2, r3);
          u16* dstz = (order == 0) ? z1w : (u16*)vx;
          *(uint2*)(dstz + ((size_t)bq * 512 + c) * L + t) = o;
        }
      }
    }
  }
  __syncthreads();
}

DEVI void hytr_item(const Params& p, int it, u16* sm) {
  int ci = it >> 3, c0 = (it & 7) * 64;
  int rowbase, t0, b, L; const u16* z2;
  if (ci < 512) { b = ci >> 6; rowbase = b * 4096; t0 = (ci & 63) * 64; L = 4096; z2 = (const u16*)(p.ws + O_VXL); }
  else { int cc = ci - 512; b = cc >> 2; rowbase = NL + b * 256; t0 = (cc & 3) * 64; L = 256; z2 = (const u16*)(p.ws + O_VXC); }
  int tid = TIDX;
  for (int i = tid; i < 64 * 8; i += 256) {
    int c = i >> 3, t8 = (i & 7) * 8;
    *(uint4*)(sm + c * 72 + t8) = *(const uint4*)(z2 + ((size_t)b * 512 + c0 + c) * L + t0 + t8);
  }
  __syncthreads();
  u16* Y = (u16*)(p.ws + O_HB);
  for (int i = tid; i < 64 * 8; i += 256) {
    int t = i >> 3, c8 = (i & 7) * 8;
    uint32_t o[4];
#pragma unroll
    for (int k = 0; k < 4; ++k) o[k] = (uint32_t)sm[(c8 + 2 * k) * 72 + t] | ((uint32_t)sm[(c8 + 2 * k + 1) * 72 + t] << 16);
    *(uint4*)(Y + (size_t)(rowbase + t0 + t) * 1024 + 512 + c0 + c8) = make_uint4(o[0], o[1], o[2], o[3]);
  }
  __syncthreads();
}

DEVI int blk_count(int c, int* cnts, int& flip) {
  for (int o = 32; o > 0; o >>= 1) c += __shfl_xor(c, o);
  int* s = cnts + (flip & 1) * 4;
  if ((TIDX & 63) == 0) s[TIDX >> 6] = c;
  __syncthreads();
  int tot = s[0] + s[1] + s[2] + s[3];
  flip ^= 1;
  return tot;
}

DEVI void topk_item(const Params& p, int it, int* smi) {
  int e = it & 15, seq = it >> 4;
  int n, cap, rowbase, slotbase, ept;
  if (seq < 8) { n = 4096; cap = 512; rowbase = seq * 4096; slotbase = seq * 512; ept = 16; }
  else { int b = seq - 8; n = 256; cap = 32; rowbase = NL + b * 256; slotbase = 4096 + b * 32; ept = 1; }
  const float* aff = (const float*)(p.ws + O_AFF);
  int* stok = (int*)(p.ws + O_STOK) + e * 4352 + slotbase;
  float* sgate = (float*)(p.ws + O_SGATE) + e * 4352 + slotbase;
  int* cnts = smi;
  int* wt = smi + 8;
  int tid = TIDX, flip = 0;
  uint32_t v[16];
#pragma unroll
  for (int j = 0; j < 16; ++j) v[j] = (j < ept) ? __float_as_uint(aff[(size_t)(rowbase + tid * ept + j) * 16 + e]) : 0u;
  uint32_t T = 0;
  for (int bit = 30; bit >= 0; --bit) {
    uint32_t cand = T | (1u << bit);
    int c = 0;
#pragma unroll
    for (int j = 0; j < 16; ++j) c += (j < ept && v[j] >= cand) ? 1 : 0;
    int tot = blk_count(c, cnts, flip);
    if (tot >= cap) T = cand;
  }
  int ngt = 0, neq = 0;
#pragma unroll
  for (int j = 0; j < 16; ++j) { if (j < ept) { ngt += (v[j] > T) ? 1 : 0; neq += (v[j] == T) ? 1 : 0; } }
  int cnt_gt = blk_count(ngt, cnts, flip);
  int need_eq = cap - cnt_gt;
  int comb = ngt | (neq << 16);
  int inc = comb;
  int lane = tid & 63, wv = tid >> 6;
  for (int o = 1; o < 64; o <<= 1) { int t = __shfl_up(inc, o); if (lane >= o) inc += t; }
  __syncthreads();
  if (lane == 63) wt[wv] = inc;
  __syncthreads();
  int pre = 0;
  for (int q = 0; q < wv; ++q) pre += wt[q];
  int ex = pre + inc - comb;
  int pg = ex & 0xffff, pe = ex >> 16;
#pragma unroll
  for (int j = 0; j < 16; ++j) {
    if (j < ept) {
      int slot = -1;
      if (v[j] > T) slot = pg++;
      else if (v[j] == T) { if (pe < need_eq) slot = cnt_gt + pe; pe++; }
      if (slot >= 0) { stok[slot] = rowbase + tid * ept + j; sgate[slot] = __uint_as_float(v[j]); }
      ((int*)(p.ws + O_INV))[(size_t)(rowbase + tid * ept + j) * 16 + e] = (slot >= 0) ? (slotbase + slot) : -1;
    }
  }
  __syncthreads();
}

DEVI void ph_moe_up(const Params& p, u16* sm, int mtl) {
  const u16* Hn = (const u16*)(p.ws + O_HB);
  const u16* Wg = (const u16*)(p.ws + O_WEXP);
  u16* Act = (u16*)(p.ws + O_U);
  const int* stok = (const int*)(p.ws + O_STOK);
  int nitems = 16 * 12 * mtl;
  int tid = TIDX, lane = tid & 63, wid = tid >> 6, wr = wid >> 1, wc = wid & 1, fr = lane & 15, fq = lane >> 4;
  int lr = tid >> 3, kc = (tid & 7) * 8;
  for (int it = vbid(); it < nitems; it += gridDim.x) {
    int e = it / (12 * mtl), rem = it % (12 * mtl);
    int fg = rem / (4 * mtl), r2 = rem % (4 * mtl);
    int f0 = (fg * 4 + (r2 & 3)) * 128, m0 = (r2 >> 2) * 128;
    uint32_t pa[4], pb0 = (uint32_t)(e * 1536 + f0 + lr) * 1024u + kc;
#pragma unroll
    for (int i = 0; i < 4; ++i) {
      int tok = stok[e * 4352 + m0 + lr + 32 * i];
      pa[i] = (uint32_t)tok * 1024u + kc;
    }
    f32x4 acc[8][4];
    gemm_core<true>(sm, Hn, pa, 0u, Wg, pb0, 0u, 1024, acc);
#pragma unroll
    for (int m = 0; m < 4; ++m) {
      int slot = m0 + wr * 64 + m * 16 + fr;
#pragma unroll
      for (int n = 0; n < 4; ++n) {
        int f = f0 + wc * 64 + n * 16 + fq * 4;
        float v0 = siluf(acc[n][m][0]) * acc[n + 4][m][0], v1 = siluf(acc[n][m][1]) * acc[n + 4][m][1];
        float v2 = siluf(acc[n][m][2]) * acc[n + 4][m][2], v3 = siluf(acc[n][m][3]) * acc[n + 4][m][3];
        uint2 o; o.x = pack2(v0, v1); o.y = pack2(v2, v3);
        *(uint2*)(Act + ((size_t)e * 4352 + slot) * 1536 + f) = o;
      }
    }
  }
}

DEVI void ph_moe_down(const Params& p, u16* sm, int layer, int mtl) {
  const u16* Act = (const u16*)(p.ws + O_U);
  const u16* Wd = (const u16*)(p.ws + O_WEXP) + 2 * EXPSZ;
  const int* stok = (const int*)(p.ws + O_STOK);
  const float* sgate = (const float*)(p.ws + O_SGATE);
  const float* mod = (const float*)(p.ws + O_MOD) + (size_t)layer * 9 * 6144 + 5 * 1024;
  int nitems = 16 * 4 * mtl;
  int tid = TIDX, lane = tid & 63, wid = tid >> 6, wr = wid >> 1, wc = wid & 1, fr = lane & 15, fq = lane >> 4;
  int lr = tid >> 3, kc = (tid & 7) * 8;
  for (int it = vbid(); it < nitems; it += gridDim.x) {
    int e = it / (4 * mtl), rem = it % (4 * mtl);
    int n0 = (rem & 3) * 256, m0 = (rem >> 2) * 128;
    uint32_t pa[4], pb0 = (uint32_t)(e * 1024 + n0 + lr) * 1536u + kc;
#pragma unroll
    for (int i = 0; i < 4; ++i) pa[i] = (uint32_t)(e * 4352 + m0 + lr + 32 * i) * 1536u + kc;
    f32x4 acc[8][4];
    gemm_core<false>(sm, Act, pa, 1536u, Wd, pb0, 1536u, 1536, acc);
#pragma unroll
    for (int m = 0; m < 4; ++m) {
      int slot = m0 + wr * 64 + m * 16 + fr;
      int tok = stok[e * 4352 + slot];
      float gt = sgate[e * 4352 + slot];
      int mr = (tok < NL) ? (tok >> 12) : 8;
      const float* gl = mod + (size_t)mr * 6144;
      u16* dst = (u16*)(p.ws + O_OUTB) + ((size_t)e * 4352 + slot) * 1024;
#pragma unroll
      for (int n = 0; n < 8; ++n) {
        int col = n0 + wc * 128 + n * 16 + fq * 4;
        float4 gv = *(const float4*)(gl + col);
        uint2 o; o.x = pack2(acc[n][m][0] * gt * gv.x, acc[n][m][1] * gt * gv.y); o.y = pack2(acc[n][m][2] * gt * gv.z, acc[n][m][3] * gt * gv.w);
        *(uint2*)(dst + col) = o;
      }
    }
  }
}

DEVI void ph_final(const Params& p) {
  int lane = TIDX & 63, wave = TIDX >> 6;
  const float* g = p.in[43];
  for (int r = blockIdx.x * 4 + wave; r < NL; r += gridDim.x * 4) {
    float* row = p.out + (size_t)r * 1024;
    float4 v[4]; float ss = 0.f;
#pragma unroll
    for (int i = 0; i < 4; ++i) v[i] = *(const float4*)(row + lane * 4 + 256 * i);
    moe_combine(p, r, lane, v);
#pragma unroll
    for (int i = 0; i < 4; ++i) ss += v[i].x * v[i].x + v[i].y * v[i].y + v[i].z * v[i].z + v[i].w * v[i].w;
    ss = wsum(ss);
    float rs = rsqrtf(ss * (1.f / 1024.f) + 1e-6f);
#pragma unroll
    for (int i = 0; i < 4; ++i) {
      float4 gg = *(const float4*)(g + lane * 4 + 256 * i);
      *(float4*)(row + lane * 4 + 256 * i) = make_float4(v[i].x * rs * gg.x, v[i].y * rs * gg.y, v[i].z * rs * gg.z, v[i].w * rs * gg.w);
    }
  }
}
constexpr size_t O_SB = O_VXL;
constexpr size_t O_S5H = O_FRAWL;
constexpr size_t O_HDEC = O_S5H + AL(512ull * 68 * 64 * 8);
static_assert(O_SB + 4352ull * 16384 * 2 <= O_HYEND, "sb");
static_assert(O_HDEC + 4352ull * 128 * 4 <= O_Y5F, "hdec");

DEVI size_t seq_row(int s, int b, int dir) {
  if (s < 256) return (size_t)NL + b * 256 + (dir ? 255 - s : s);
  int q = s - 256;
  return (size_t)b * 4096 + (dir ? 4095 - q : q);
}
DEVI float hg_lb_val(const Params& p, int ch) {
  float l0 = p.in[27][ch], l1 = p.in[27][512 + ch];
  float mx = fmaxf(l0, l1), e0 = expf(l0 - mx), e1 = expf(l1 - mx);
  return fminf(fmaxf(e1 / (e0 + e1), 0.f), 1.f - 1e-4f);
}
DEVI void hgrnA_item(const Params& p, int it, unsigned char* smem) {
  int seq = it / 68, c = it % 68;
  int b = seq >> 3, h = (seq >> 1) & 3, dir = seq & 1;
  float* G = (float*)smem;
  u16* KdT = (u16*)(smem + 33280);
  u16* VT = (u16*)(smem + 51712);
  float* lbs = (float*)(smem + 70144);
  int tid = TIDX, lane = tid & 63, w = tid >> 6, fr = lane & 15, fq = lane >> 4;
  if (tid < 128) lbs[tid] = hg_lb_val(p, h * 128 + tid);
  __syncthreads();
  const u16* U = (const u16*)(p.ws + O_U);
  int i = tid >> 2, part = tid & 3;
  const u16* ur = U + seq_row(c * 64 + i, b, dir) * 3072;
  {
    const uint4* src = (const uint4*)(ur + dir * 512 + h * 128 + part * 32);
    const uint4* srv = (const uint4*)(ur + 1024 + h * 128 + part * 32);
#pragma unroll
    for (int q4 = 0; q4 < 4; ++q4) {
      uint4 x = src[q4], y = srv[q4];
      float fv[8]; unpack8(x, fv);
      uint32_t yw[4] = {y.x, y.y, y.z, y.w};
#pragma unroll
      for (int k = 0; k < 8; ++k) {
        int d = part * 32 + q4 * 8 + k;
        float lb = lbs[d];
        G[i * 129 + d] = __logf(lb + (1.f - lb) * sigm(fv[k]));
        VT[d * 72 + i] = (u16)((k & 1) ? (yw[k >> 1] >> 16) : (yw[k >> 1] & 0xffff));
      }
    }
  }
  __syncthreads();
  if (tid < 128) { float a = 0.f; for (int ii = 0; ii < 64; ++ii) { a += G[ii * 129 + tid]; G[ii * 129 + tid] = a; } }
  __syncthreads();
#pragma unroll 8
  for (int k = 0; k < 32; ++k) {
    int d = part * 32 + k;
    float bc = G[i * 129 + d], bp = (i > 0) ? G[(i - 1) * 129 + d] : 0.f, bl = G[63 * 129 + d];
    float f = __expf(bc - bp);
    KdT[d * 72 + i] = f2bf((1.f - f) * __expf(bl - bc));
  }
  if (tid < 128) ((float*)(p.ws + O_HDEC))[(size_t)it * 128 + tid] = __expf(G[63 * 129 + tid]);
  __syncthreads();
  f32x4 acc[2][8];
#pragma unroll
  for (int m = 0; m < 2; ++m)
#pragma unroll
    for (int n = 0; n < 8; ++n) acc[m][n] = (f32x4){0.f, 0.f, 0.f, 0.f};
#pragma unroll
  for (int ks = 0; ks < 2; ++ks) {
    bf16x8 af[2];
#pragma unroll
    for (int m = 0; m < 2; ++m) af[m] = *(const bf16x8*)(KdT + ((2 * w + m) * 16 + fr) * 72 + ks * 32 + fq * 8);
#pragma unroll
    for (int n = 0; n < 8; ++n) {
      bf16x8 bv = *(const bf16x8*)(VT + (n * 16 + fr) * 72 + ks * 32 + fq * 8);
#pragma unroll
      for (int m = 0; m < 2; ++m) acc[m][n] = __builtin_amdgcn_mfma_f32_16x16x32_bf16(af[m], bv, acc[m][n], 0, 0, 0);
    }
  }
  u16* SB = (u16*)(p.ws + O_SB) + (size_t)it * 16384;
#pragma unroll
  for (int m = 0; m < 2; ++m)
#pragma unroll
    for (int n = 0; n < 8; ++n) {
      uint2 o; o.x = pack2(acc[m][n][0], acc[m][n][1]); o.y = pack2(acc[m][n][2], acc[m][n][3]);
      *(uint2*)(SB + (n * 16 + fr) * 128 + (2 * w + m) * 16 + 4 * fq) = o;
    }
  __syncthreads();
}

DEVI void hgrnB_item(const Params& p, int it) {
  int gt = it * 256 + TIDX;
  int seq = gt >> 11, idx = (gt & 2047) * 8, d0 = idx & 127;
  u16* SB = (u16*)(p.ws + O_SB) + (size_t)seq * 68 * 16384 + idx;
  const float* DEC = (const float*)(p.ws + O_HDEC) + (size_t)seq * 68 * 128 + d0;
  float carry[8];
#pragma unroll
  for (int k = 0; k < 8; ++k) carry[k] = 0.f;
#pragma unroll 1
  for (int cb = 0; cb < 68; cb += 4) {
    uint4 kvq[4]; float4 da[4], db[4];
#pragma unroll
    for (int q = 0; q < 4; ++q) {
      kvq[q] = *(const uint4*)(SB + (size_t)(cb + q) * 16384);
      da[q] = *(const float4*)(DEC + (cb + q) * 128); db[q] = *(const float4*)(DEC + (cb + q) * 128 + 4);
    }
#pragma unroll
    for (int q = 0; q < 4; ++q) {
      float kv[8]; unpack8(kvq[q], kv);
      float dd[8] = {da[q].x, da[q].y, da[q].z, da[q].w, db[q].x, db[q].y, db[q].z, db[q].w};
      uint4 o;
      o.x = pack2(carry[0], carry[1]); o.y = pack2(carry[2], carry[3]); o.z = pack2(carry[4], carry[5]); o.w = pack2(carry[6], carry[7]);
      *(uint4*)(SB + (size_t)(cb + q) * 16384) = o;
#pragma unroll
      for (int k = 0; k < 8; ++k) carry[k] = dd[k] * carry[k] + kv[k];
    }
  }
}

DEVI void hgrnC_item(const Params& p, int it, unsigned char* smem) {
  int pb = it & 63, h = (it >> 6) & 3, b = it >> 8;
  u16* Qs = (u16*)smem;
  u16* Kt = (u16*)(smem + 17408);
  float* G = (float*)(smem + 34816);
  u16* VT = (u16*)(smem + 34816);
  u16* At = (u16*)(smem + 34816 + 18432);
  float* lbs = (float*)(smem + 68096);
  float* ssum = lbs + 128;
  int tid = TIDX, lane = tid & 63, w = tid >> 6, fr = lane & 15, fq = lane >> 4;
  if (tid < 128) lbs[tid] = hg_lb_val(p, h * 128 + tid);
  __syncthreads();
  const u16* U = (const u16*)(p.ws + O_U);
  size_t row0 = (size_t)b * 4096 + pb * 64;
  int i = tid >> 2, part = tid & 3;
  const u16* ur = U + (row0 + i) * 3072;
  f32x4 o[4][2];
#pragma unroll
  for (int m = 0; m < 4; ++m)
#pragma unroll
    for (int n = 0; n < 2; ++n) o[m][n] = (f32x4){0.f, 0.f, 0.f, 0.f};
#pragma unroll 1
  for (int dir = 0; dir < 2; ++dir) {
    {
      const uint4* src = (const uint4*)(ur + dir * 512 + h * 128 + part * 32);
#pragma unroll
      for (int q4 = 0; q4 < 4; ++q4) {
        float fv[8]; unpack8(src[q4], fv);
#pragma unroll
        for (int k = 0; k < 8; ++k) { int d = part * 32 + q4 * 8 + k; float lb = lbs[d]; G[i * 129 + d] = __logf(lb + (1.f - lb) * sigm(fv[k])); }
      }
    }
    __syncthreads();
    if (tid < 128) {
      float a = 0.f;
      if (dir == 0) { for (int ii = 0; ii < 64; ++ii) { a += G[ii * 129 + tid]; G[ii * 129 + tid] = a; } }
      else { for (int ii = 63; ii >= 0; --ii) { a += G[ii * 129 + tid]; G[ii * 129 + tid] = a; } }
    }
    __syncthreads();
    {
      const uint4* srq = (const uint4*)(ur + 2048 + h * 128 + part * 32);
      int ip = (dir == 0) ? i - 1 : i + 1;
      bool edge = (dir == 0) ? (i == 0) : (i == 63);
#pragma unroll
      for (int q4 = 0; q4 < 4; ++q4) {
        float qv[8]; unpack8(srq[q4], qv);
        uint32_t qo[4], ko[4];
#pragma unroll
        for (int k2 = 0; k2 < 4; ++k2) {
          float qq[2], kk[2];
#pragma unroll
          for (int z = 0; z < 2; ++z) {
            int d = part * 32 + q4 * 8 + k2 * 2 + z;
            float bc = G[i * 129 + d], bp = edge ? 0.f : G[ip * 129 + d];
            float f = __expf(bc - bp);
            qq[z] = siluf(qv[k2 * 2 + z]) * __expf(bc);
            kk[z] = (1.f - f) * __expf(-bc);
          }
          qo[k2] = pack2(qq[0], qq[1]); ko[k2] = pack2(kk[0], kk[1]);
        }
        *(uint4*)(Qs + i * 136 + part * 32 + q4 * 8) = make_uint4(qo[0], qo[1], qo[2], qo[3]);
        *(uint4*)(Kt + i * 136 + part * 32 + q4 * 8) = make_uint4(ko[0], ko[1], ko[2], ko[3]);
      }
    }
    __syncthreads();
    {
      const uint4* srv = (const uint4*)(ur + 1024 + h * 128 + part * 32);
#pragma unroll
      for (int q4 = 0; q4 < 4; ++q4) {
        uint4 y = srv[q4];
        uint32_t yw[4] = {y.x, y.y, y.z, y.w};
#pragma unroll
        for (int k = 0; k < 8; ++k) VT[(part * 32 + q4 * 8 + k) * 72 + i] = (u16)((k & 1) ? (yw[k >> 1] >> 16) : (yw[k >> 1] & 0xffff));
      }
    }
    int seq = (b * 4 + h) * 2 + dir, c = 4 + (dir ? 63 - pb : pb);
    const u16* SB = (const u16*)(p.ws + O_SB) + ((size_t)seq * 68 + c) * 16384;
#pragma unroll
    for (int ks = 0; ks < 4; ++ks) {
      bf16x8 sf[2];
#pragma unroll
      for (int n = 0; n < 2; ++n) sf[n] = *(const bf16x8*)(SB + ((2 * w + n) * 16 + fr) * 128 + ks * 32 + fq * 8);
#pragma unroll
      for (int m = 0; m < 4; ++m) {
        bf16x8 qf = *(const bf16x8*)(Qs + (m * 16 + fr) * 136 + ks * 32 + fq * 8);
#pragma unroll
        for (int n = 0; n < 2; ++n) o[m][n] = __builtin_amdgcn_mfma_f32_16x16x32_bf16(qf, sf[n], o[m][n], 0, 0, 0);
      }
    }
    {
      f32x4 at[4];
#pragma unroll
      for (int m = 0; m < 4; ++m) at[m] = (f32x4){0.f, 0.f, 0.f, 0.f};
#pragma unroll
      for (int ks = 0; ks < 4; ++ks) {
        bf16x8 kf = *(const bf16x8*)(Kt + (w * 16 + fr) * 136 + ks * 32 + fq * 8);
#pragma unroll
        for (int m = 0; m < 4; ++m) {
          bf16x8 qf = *(const bf16x8*)(Qs + (m * 16 + fr) * 136 + ks * 32 + fq * 8);
          at[m] = __builtin_amdgcn_mfma_f32_16x16x32_bf16(kf, qf, at[m], 0, 0, 0);
        }
      }
#pragma unroll
      for (int m = 0; m < 4; ++m) {
        int ii = m * 16 + fr, j0 = w * 16 + 4 * fq;
        float a4[4];
#pragma unroll
        for (int r = 0; r < 4; ++r) { int j = j0 + r; bool keep = (dir == 0) ? (j <= ii) : (j >= ii); a4[r] = keep ? at[m][r] : 0.f; }
        uint2 ov; ov.x = pack2(a4[0], a4[1]); ov.y = pack2(a4[2], a4[3]);
        *(uint2*)(At + ii * 72 + j0) = ov;
      }
    }
    __syncthreads();
#pragma unroll
    for (int ks = 0; ks < 2; ++ks) {
      bf16x8 vf[2];
#pragma unroll
      for (int n = 0; n < 2; ++n) vf[n] = *(const bf16x8*)(VT + ((2 * w + n) * 16 + fr) * 72 + ks * 32 + fq * 8);
#pragma unroll
      for (int m = 0; m < 4; ++m) {
        bf16x8 af = *(const bf16x8*)(At + (m * 16 + fr) * 72 + ks * 32 + fq * 8);
#pragma unroll
        for (int n = 0; n < 2; ++n) o[m][n] = __builtin_amdgcn_mfma_f32_16x16x32_bf16(af, vf[n], o[m][n], 0, 0, 0);
      }
    }
    __syncthreads();
  }
#pragma unroll
  for (int m = 0; m < 4; ++m)
#pragma unroll
    for (int r = 0; r < 4; ++r) {
      float s = o[m][0][r] * o[m][0][r] + o[m][1][r] * o[m][1][r];
      s += __shfl_xor(s, 1); s += __shfl_xor(s, 2); s += __shfl_xor(s, 4); s += __shfl_xor(s, 8);
      if (fr == 0) ssum[w * 64 + m * 16 + 4 * fq + r] = s;
    }
  __syncthreads();
  u16* Ym = (u16*)(p.ws + O_HB);
#pragma unroll
  for (int m = 0; m < 4; ++m)
#pragma unroll
    for (int r = 0; r < 4; ++r) {
      int ii = m * 16 + 4 * fq + r;
      float tot = ssum[ii] + ssum[64 + ii] + ssum[128 + ii] + ssum[192 + ii];
      float rs = rsqrtf(tot * (1.f / 128.f) + 1e-6f);
      size_t row = row0 + ii;
#pragma unroll
      for (int n = 0; n < 2; ++n) {
        int e = (2 * w + n) * 16 + fr;
        float g = bf2f(U[row * 3072 + 2560 + h * 128 + e]);
        Ym[row * 1024 + h * 128 + e] = f2bf(o[m][n][r] * rs * p.in[28][e] * siluf(g));
      }
    }
  __syncthreads();
}

DEVI void wave_lds_sync() { __builtin_amdgcn_fence(__ATOMIC_RELEASE, "wavefront"); __builtin_amdgcn_wave_barrier(); __builtin_amdgcn_fence(__ATOMIC_ACQUIRE, "wavefront"); }

DEVI void s5_wave(const Params& p, int sq, int c, int mode, float* wsm) {
  int dir = sq & 1, g = (sq >> 1) & 31, b = sq >> 6;
  int lane = TIDX & 63;
  const u16* U = (const u16*)(p.ws + O_U);
  u16* Yo = (u16*)(p.ws + (dir ? O_Y5B : O_Y5F));
  float2* HS = (float2*)(p.ws + O_S5H) + ((size_t)sq * 68 + c) * 64;
  float* Cre = wsm;
  float* Cim = wsm + 1024;
  float* Hre = wsm + 2048;
  float* Him = Hre + 8 * 68;
  if (mode == 1) { for (int i = lane; i < 1024; i += 64) { Cre[i] = p.in[34][(size_t)g * 1024 + i]; Cim[i] = p.in[35][(size_t)g * 1024 + i]; } }
  float lre = fminf(p.in[29][(dir * 32 + g) * 64 + lane], -1e-4f), lim = p.in[30][(dir * 32 + g) * 64 + lane];
  float dt = expf(p.in[31][dir * 32 + g]);
  float mag = expf(lre * dt), lbr = mag * cosf(lim * dt), lbi = mag * sinf(lim * dt);
  float xr = lbr - 1.f, xi = lbi, den = 1.f / (lre * lre + lim * lim);
  float cr = (xr * lre + xi * lim) * den, ci = (xi * lre - xr * lim) * den;
  float Br[16], Bi[16];
#pragma unroll
  for (int q = 0; q < 16; ++q) {
    float br = p.in[32][((size_t)g * 64 + lane) * 16 + q], bi = p.in[33][((size_t)g * 64 + lane) * 16 + q];
    Br[q] = cr * br - ci * bi; Bi[q] = cr * bi + ci * br;
  }
  float hr = 0.f, hi = 0.f;
  if (mode == 1) { float2 h0 = HS[lane]; hr = h0.x; hi = h0.y; }
  wave_lds_sync();
  for (int s0 = c * 64; s0 < c * 64 + 64; s0 += 8) {
#pragma unroll
    for (int s8 = 0; s8 < 8; ++s8) {
      size_t row = seq_row(s0 + s8, b, dir);
      const uint4* up = (const uint4*)(U + row * 3072 + 1536 + g * 16);
      float ua[8], ub[8]; unpack8(up[0], ua); unpack8(up[1], ub);
      float bur = 0.f, bui = 0.f;
#pragma unroll
      for (int q = 0; q < 8; ++q) { bur += Br[q] * ua[q] + Br[8 + q] * ub[q]; bui += Bi[q] * ua[q] + Bi[8 + q] * ub[q]; }
      float nr = lbr * hr - lbi * hi + bur, ni = lbr * hi + lbi * hr + bui;
      hr = nr; hi = ni;
      if (mode == 1) { Hre[s8 * 68 + lane] = hr; Him[s8 * 68 + lane] = hi; }
    }
    if (mode == 1) {
      wave_lds_sync();
      int s8 = lane >> 3, hp = lane & 7;
      float y0 = 0.f, y1 = 0.f;
#pragma unroll
      for (int p4 = 0; p4 < 16; ++p4) {
        float4 a = *(const float4*)(Hre + s8 * 68 + p4 * 4), bq = *(const float4*)(Him + s8 * 68 + p4 * 4);
        float4 c0 = *(const float4*)(Cre + (hp * 2) * 64 + p4 * 4), d0 = *(const float4*)(Cim + (hp * 2) * 64 + p4 * 4);
        float4 c1 = *(const float4*)(Cre + (hp * 2 + 1) * 64 + p4 * 4), d1 = *(const float4*)(Cim + (hp * 2 + 1) * 64 + p4 * 4);
        y0 += a.x * c0.x - bq.x * d0.x + a.y * c0.y - bq.y * d0.y + a.z * c0.z - bq.z * d0.z + a.w * c0.w - bq.w * d0.w;
        y1 += a.x * c1.x - bq.x * d1.x + a.y * c1.y - bq.y * d1.y + a.z * c1.z - bq.z * d1.z + a.w * c1.w - bq.w * d1.w;
      }
      size_t row = seq_row(s0 + s8, b, dir);
      *(uint32_t*)(Yo + row * 512 + g * 16 + hp * 2) = pack2(y0, y1);
      wave_lds_sync();
    }
  }
  if (mode == 0) HS[lane] = make_float2(hr, hi);
}

DEVI void s5B_item(const Params& p, int it) {
  int gt = it * 256 + TIDX;
  int sq = gt >> 6, lane = gt & 63;
  int dir = sq & 1, g = (sq >> 1) & 31;
  float lre = fminf(p.in[29][(dir * 32 + g) * 64 + lane], -1e-4f), lim = p.in[30][(dir * 32 + g) * 64 + lane];
  float dt = expf(p.in[31][dir * 32 + g]);
  float mag = expf(lre * dt), ar = mag * cosf(lim * dt), ai = mag * sinf(lim * dt);
#pragma unroll
  for (int k = 0; k < 6; ++k) { float nr = ar * ar - ai * ai, ni = 2.f * ar * ai; ar = nr; ai = ni; }
  float2* HS = (float2*)(p.ws + O_S5H) + (size_t)sq * 68 * 64 + lane;
  float cr = 0.f, ci = 0.f;
#pragma unroll 1
  for (int cb = 0; cb < 68; cb += 17) {
    float2 v[17];
#pragma unroll
    for (int q = 0; q < 17; ++q) v[q] = HS[(cb + q) * 64];
#pragma unroll
    for (int q = 0; q < 17; ++q) {
      HS[(cb + q) * 64] = make_float2(cr, ci);
      float nr = ar * cr - ai * ci + v[q].x, ni = ar * ci + ai * cr + v[q].y;
      cr = nr; ci = ni;
    }
  }
}

DEVI void ph_l1_finalize(const Params& p) {
  int lane = TIDX & 63, wave = TIDX >> 6;
  const u16* U = (const u16*)(p.ws + O_U);
  const u16* Yf = (const u16*)(p.ws + O_Y5F); const u16* Yb = (const u16*)(p.ws + O_Y5B);
  u16* Y5 = (u16*)(p.ws + O_Y5);
  int ch = lane * 8;
  for (int r = blockIdx.x * 4 + wave; r < NL; r += gridDim.x * 4) {
    size_t ro = (size_t)r;
    float a[8], bb[8], uu[8];
    unpack8(*(const uint4*)(Yf + ro * 512 + ch), a); unpack8(*(const uint4*)(Yb + ro * 512 + ch), bb); unpack8(*(const uint4*)(U + ro * 3072 + 1536 + ch), uu);
    uint32_t ow[4];
#pragma unroll
    for (int q = 0; q < 4; ++q) {
      float y0 = a[2 * q] + bb[2 * q] + uu[2 * q] * p.in[36][ch + 2 * q];
      float y1 = a[2 * q + 1] + bb[2 * q + 1] + uu[2 * q + 1] * p.in[36][ch + 2 * q + 1];
      ow[q] = pack2(geluf(y0), geluf(y1));
    }
    *(uint4*)(Y5 + ro * 512 + ch) = make_uint4(ow[0], ow[1], ow[2], ow[3]);
  }
}
constexpr size_t O_POW = O_END1;
constexpr size_t O_BP = O_POW + AL(64ull * 65 * 64 * 8);
constexpr size_t O_KT = O_BP + AL(64ull * 64 * 16 * 8);
constexpr size_t O_WST = O_KT + AL(64ull * 65 * 256 * 2);
constexpr size_t O_WB = O_WST + AL(64ull * 64 * 16 * 128 * 2);
constexpr size_t O_END2 = O_WB + AL(64ull * 128 * 1024 * 2);
constexpr size_t O_BAR = O_END2;
static_assert(O_BAR + 16384 < 800000000ull, "workspace budget");

DEVI void s5pow_item(const Params& p, int it) {
  int gt = it * 256 + TIDX;
  int gd = gt >> 6, lane = gt & 63, g = gd >> 1, dir = gd & 1;
  float lre = fminf(p.in[29][(dir * 32 + g) * 64 + lane], -1e-4f), lim = p.in[30][(dir * 32 + g) * 64 + lane];
  float dt = expf(p.in[31][dir * 32 + g]);
  float mag = expf(lre * dt), lbr = mag * cosf(lim * dt), lbi = mag * sinf(lim * dt);
  float xr = lbr - 1.f, xi = lbi, den = 1.f / (lre * lre + lim * lim);
  float cr = (xr * lre + xi * lim) * den, ci = (xi * lre - xr * lim) * den;
  float2* POW = (float2*)(p.ws + O_POW) + (size_t)gd * 65 * 64 + lane;
  float pr = 1.f, pi = 0.f;
  for (int t = 0; t < 65; ++t) { POW[t * 64] = make_float2(pr, pi); float nr = pr * lbr - pi * lbi, ni = pr * lbi + pi * lbr; pr = nr; pi = ni; }
  float2* BP = (float2*)(p.ws + O_BP) + ((size_t)gd * 64 + lane) * 16;
  for (int q = 0; q < 16; ++q) {
    float br = p.in[32][((size_t)g * 64 + lane) * 16 + q], bi = p.in[33][((size_t)g * 64 + lane) * 16 + q];
    BP[q] = make_float2(cr * br - ci * bi, cr * bi + ci * br);
  }
}

DEVI void s5tab_item(const Params& p, int it) {
  const float2* POWa = (const float2*)(p.ws + O_POW);
  const float2* BPa = (const float2*)(p.ws + O_BP);
  int tid = TIDX;
  if (it < 576) {
    int gd = it / 9, t8 = it % 9, g = gd >> 1;
    int hh = tid >> 4, hp = tid & 15;
    const float2* POW = POWa + (size_t)gd * 65 * 64;
    const float2* BP = BPa + (size_t)gd * 64 * 16;
    const float* Cr = p.in[34] + ((size_t)g * 16 + hh) * 64; const float* Ci = p.in[35] + ((size_t)g * 16 + hh) * 64;
    u16* KT = (u16*)(p.ws + O_KT) + (size_t)gd * 65 * 256;
    for (int ts = t8 * 8; ts < t8 * 8 + 8 && ts < 65; ++ts) {
      float acc = 0.f;
      if (ts >= 1) {
        for (int pp = 0; pp < 64; ++pp) {
          float2 P = POW[(ts - 1) * 64 + pp], B = BP[pp * 16 + hp];
          float c_r = Cr[pp], c_i = Ci[pp];
          float cpr = c_r * P.x - c_i * P.y, cpi = c_r * P.y + c_i * P.x;
          acc += cpr * B.x - cpi * B.y;
        }
      }
      KT[ts * 256 + hh * 16 + hp] = f2bf(acc);
    }
  } else if (it < 576 + 512) {
    int j = it - 576, gd = j >> 3, i8 = j & 7, g = gd >> 1;
    int hh = tid >> 4, kq = (tid & 15) * 8, p0 = kq >> 1;
    const float2* POW = POWa + (size_t)gd * 65 * 64;
    u16* WS = (u16*)(p.ws + O_WST) + (size_t)gd * 64 * 16 * 128;
    for (int ii = 0; ii < 8; ++ii) {
      int i = i8 * 8 + ii;
      float v[8];
#pragma unroll
      for (int pp = 0; pp < 4; ++pp) {
        int pq = p0 + pp;
        float2 P = POW[(i + 1) * 64 + pq];
        float c_r = p.in[34][((size_t)g * 16 + hh) * 64 + pq], c_i = p.in[35][((size_t)g * 16 + hh) * 64 + pq];
        v[2 * pp] = c_r * P.x - c_i * P.y; v[2 * pp + 1] = -(c_r * P.y + c_i * P.x);
      }
      *(uint4*)(WS + ((size_t)i * 16 + hh) * 128 + kq) = make_uint4(pack2(v[0], v[1]), pack2(v[2], v[3]), pack2(v[4], v[5]), pack2(v[6], v[7]));
    }
  } else {
    int j = it - 1088, gd = j >> 3, p8 = j & 7;
    int jj = tid >> 2, hq = tid & 3;
    const float2* POW = POWa + (size_t)gd * 65 * 64;
    const float2* BP = BPa + (size_t)gd * 64 * 16;
    u16* WB = (u16*)(p.ws + O_WB) + (size_t)gd * 128 * 1024;
    for (int pp = 0; pp < 8; ++pp) {
      int pq = p8 * 8 + pp;
      float2 P = POW[(63 - jj) * 64 + pq];
      float re[4], im[4];
#pragma unroll
      for (int h4 = 0; h4 < 4; ++h4) { float2 B = BP[pq * 16 + hq * 4 + h4]; re[h4] = P.x * B.x - P.y * B.y; im[h4] = P.x * B.y + P.y * B.x; }
      *(uint2*)(WB + (size_t)(2 * pq) * 1024 + jj * 16 + hq * 4) = make_uint2(pack2(re[0], re[1]), pack2(re[2], re[3]));
      *(uint2*)(WB + (size_t)(2 * pq + 1) * 1024 + jj * 16 + hq * 4) = make_uint2(pack2(im[0], im[1]), pack2(im[2], im[3]));
    }
  }
}

DEVI void s5A_mfma_item(const Params& p, int it) {
  int gd = it / 34, nt = it % 34, g = gd >> 1, dir = gd & 1;
  int lane = TIDX & 63, w = TIDX >> 6, fr = lane & 15, fq = lane >> 4;
  int col = nt * 16 + fr, b = col / 68, chunk = col % 68;
  const u16* U = (const u16*)(p.ws + O_U);
  const u16* WB = (const u16*)(p.ws + O_WB) + (size_t)gd * 128 * 1024;
  f32x4 acc[2] = {(f32x4){0.f, 0.f, 0.f, 0.f}, (f32x4){0.f, 0.f, 0.f, 0.f}};
#pragma unroll 8
  for (int js = 0; js < 32; ++js) {
    int j = 2 * js + (fq >> 1);
    size_t row = seq_row(chunk * 64 + j, b, dir);
    bf16x8 bfrag = *(const bf16x8*)(U + row * 3072 + 1536 + g * 16 + (fq & 1) * 8);
#pragma unroll
    for (int m = 0; m < 2; ++m) {
      bf16x8 afrag = *(const bf16x8*)(WB + (size_t)((2 * w + m) * 16 + fr) * 1024 + js * 32 + fq * 8);
      acc[m] = __builtin_amdgcn_mfma_f32_16x16x32_bf16(afrag, bfrag, acc[m], 0, 0, 0);
    }
  }
  int sq = b * 64 + gd;
  float* HSf = (float*)(p.ws + O_S5H) + ((size_t)sq * 68 + chunk) * 128;
#pragma unroll
  for (int m = 0; m < 2; ++m) *(float4*)(HSf + (2 * w + m) * 16 + 4 * fq) = make_float4(acc[m][0], acc[m][1], acc[m][2], acc[m][3]);
}

DEVI void s5C_mfma_item(const Params& p, int it, u16* KTl) {
  int gd = it >> 3, ng = it & 7, g = gd >> 1, dir = gd & 1;
  int tid = TIDX, lane = tid & 63, w = tid >> 6, fr = lane & 15, fq = lane >> 4;
  {
    const uint4* src = (const uint4*)((const u16*)(p.ws + O_KT) + (size_t)gd * 65 * 256);
    for (int i = tid; i < 2080; i += 256) ((uint4*)KTl)[i] = src[i];
  }
  __syncthreads();
  int col = (ng * 4 + w) * 16 + fr, b = col >> 6, chunk = 4 + (col & 63);
  const u16* U = (const u16*)(p.ws + O_U);
  u16* Yo = (u16*)(p.ws + (dir ? O_Y5B : O_Y5F));
  bf16x8 ub[32];
#pragma unroll
  for (int js = 0; js < 32; ++js) {
    size_t row = seq_row(chunk * 64 + 2 * js + (fq >> 1), b, dir);
    ub[js] = *(const bf16x8*)(U + row * 3072 + 1536 + g * 16 + (fq & 1) * 8);
  }
  bf16x8 hb[4];
  {
    int sq = b * 64 + gd;
    const float* HSf = (const float*)(p.ws + O_S5H) + ((size_t)sq * 68 + chunk) * 128;
#pragma unroll
    for (int ks = 0; ks < 4; ++ks) {
      float4 a = *(const float4*)(HSf + ks * 32 + 8 * fq), c = *(const float4*)(HSf + ks * 32 + 8 * fq + 4);
      uint4 pk = make_uint4(pack2(a.x, a.y), pack2(a.z, a.w), pack2(c.x, c.y), pack2(c.z, c.w));
      __builtin_memcpy(&hb[ks], &pk, 16);
    }
  }
  const u16* WS = (const u16*)(p.ws + O_WST) + (size_t)gd * 64 * 16 * 128;
  int tsl = 1 - (fq >> 1);
  const u16* KTp = KTl + fr * 16 + (fq & 1) * 8;
  bf16x8 wsc[4];
  {
    const u16* WS0 = WS + ((size_t)0 * 16 + fr) * 128 + 8 * fq;
#pragma unroll
    for (int ks = 0; ks < 4; ++ks) wsc[ks] = *(const bf16x8*)(WS0 + ks * 32);
  }
#pragma unroll 1
  for (int i = 0; i < 64; ++i) {
    f32x4 a0 = (f32x4){0.f, 0.f, 0.f, 0.f}, a1 = (f32x4){0.f, 0.f, 0.f, 0.f};
    bf16x8 wsn[4];
    {
      int inx = (i + 1 < 64) ? i + 1 : i;
      const u16* WSn = WS + ((size_t)inx * 16 + fr) * 128 + 8 * fq;
#pragma unroll
      for (int ks = 0; ks < 4; ++ks) wsn[ks] = *(const bf16x8*)(WSn + ks * 32);
    }
#pragma unroll
    for (int ks = 0; ks < 4; ++ks) {
      if (ks & 1) a1 = __builtin_amdgcn_mfma_f32_16x16x32_bf16(wsc[ks], hb[ks], a1, 0, 0, 0);
      else a0 = __builtin_amdgcn_mfma_f32_16x16x32_bf16(wsc[ks], hb[ks], a0, 0, 0, 0);
    }
#pragma unroll
    for (int js = 0; js < 32; ++js) {
      if (2 * js > i) break;
      int ts = i - 2 * js + tsl;
      bf16x8 a = *(const bf16x8*)(KTp + ts * 256);
      if (js & 1) a1 = __builtin_amdgcn_mfma_f32_16x16x32_bf16(a, ub[js], a1, 0, 0, 0);
      else a0 = __builtin_amdgcn_mfma_f32_16x16x32_bf16(a, ub[js], a0, 0, 0, 0);
    }
    size_t row = seq_row(chunk * 64 + i, b, dir);
    uint2 o; o.x = pack2(a0[0] + a1[0], a0[1] + a1[1]); o.y = pack2(a0[2] + a1[2], a0[3] + a1[3]);
    *(uint2*)(Yo + row * 512 + g * 16 + 4 * fq) = o;
#pragma unroll
    for (int ks = 0; ks < 4; ++ks) wsc[ks] = wsn[ks];
  }
  __syncthreads();
}

#define XB_TMO      128
#define XB_XCNT(j)  (256  + 64 * (j))
#define XB_XSUB(j)  (1280 + 64 * (j))
#define XB_XGEN(j)  (2304 + 64 * (j))
#define XB_TOP      3328
#define XB_TOPGEN   3392
#define XCD_BAR_WORDS 3456
#define XB_SPIN_CAP (1u << 18)
#define LAS __attribute__((address_space(3)))
__device__ __forceinline__ unsigned xb_ld(unsigned* p)              { return __hip_atomic_load(p, __ATOMIC_RELAXED, __HIP_MEMORY_SCOPE_AGENT); }
__device__ __forceinline__ unsigned xb_add(unsigned* p, unsigned v) { return __hip_atomic_fetch_add(p, v, __ATOMIC_RELAXED, __HIP_MEMORY_SCOPE_AGENT); }
__device__ __forceinline__ unsigned xb_xcc_id() { return (unsigned)__builtin_amdgcn_s_getreg((3 << 11) | 20) & 0xFu; }
#define XB_SPIN(cond, bar) do { unsigned _sp = 0; while (cond) { __builtin_amdgcn_s_sleep(1); \
    if ((++_sp & 255u) == 0u) { if (xb_ld(&(bar)[XB_TMO])) break; if (_sp > XB_SPIN_CAP) { atomicAdd(&(bar)[XB_TMO], 1u); break; } } } } while (0)
struct XcdBarrier { unsigned* bar; unsigned x; volatile LAS unsigned* st; };
__device__ __forceinline__ XcdBarrier xcd_barrier_post(unsigned* bar, volatile LAS unsigned* st) {
  XcdBarrier b; b.bar = bar; b.x = xb_xcc_id(); b.st = st;
  if (threadIdx.x == 0) (void)xb_add(&bar[XB_XCNT(b.x)], 1u);
  return b;
}
__device__ __forceinline__ void xcd_barrier_complete(unsigned* bar, unsigned x, unsigned& nloc, unsigned& nx) {
  const unsigned G = gridDim.x * gridDim.y * gridDim.z;
  unsigned sum, cnt, mine, sp = 0u;
  for (;;) {
    sum = 0u; cnt = 0u; mine = 0u;
#pragma unroll
    for (unsigned j = 0; j < 16; ++j) { const unsigned c = xb_ld(&bar[XB_XCNT(j)]); sum += c; cnt += (c > 0u) ? 1u : 0u; mine = (j == x) ? c : mine; }
    if (sum == G) break;
    __builtin_amdgcn_s_sleep(1);
    if ((++sp & 255u) == 0u) { if (xb_ld(&bar[XB_TMO])) break; if (sp > XB_SPIN_CAP) { atomicAdd(&bar[XB_TMO], 1u); break; } }
  }
  nloc = mine > 0u ? mine : 1u; nx = cnt > 0u ? cnt : 1u;
}
__device__ __forceinline__ void xcd_barrier(const XcdBarrier& b) {
  asm volatile("s_waitcnt vmcnt(0)" ::: "memory");
  __syncthreads();
  if (threadIdx.x == 0) {
    unsigned* bar = b.bar;
    __builtin_amdgcn_s_waitcnt(0);
    unsigned nloc = b.st[0], nx = b.st[1];
    if (nloc == 0u) { xcd_barrier_complete(bar, b.x, nloc, nx); b.st[0] = nloc; b.st[1] = nx; }
    const unsigned old = xb_add(&bar[XB_XSUB(b.x)], 1u);
    const unsigned gen = old / nloc;
    if (old + 1u == (gen + 1u) * nloc) {
      __builtin_amdgcn_fence(__ATOMIC_RELEASE, "agent");
      asm volatile("s_waitcnt vmcnt(0)" ::: "memory");
      const unsigned og = xb_add(&bar[XB_TOP], 1u);
      const unsigned tg = og / nx;
      if (og + 1u == (tg + 1u) * nx) xb_add(&bar[XB_TOPGEN], 1u);
      else XB_SPIN(xb_ld(&bar[XB_TOPGEN]) == tg, bar);
      __builtin_amdgcn_fence(__ATOMIC_ACQUIRE, "agent");
      xb_add(&bar[XB_XGEN(b.x)], 1u);
      asm volatile("s_waitcnt vmcnt(0)" ::: "memory");
    } else {
      XB_SPIN(xb_ld(&bar[XB_XGEN(b.x)]) == gen, bar);
      __builtin_amdgcn_fence(__ATOMIC_ACQUIRE, "agent");
      asm volatile("s_waitcnt vmcnt(0)" ::: "memory");
    }
  }
  __syncthreads();
}
DEVI void ph_gemm_glu(const Params& p, u16* sm) {
  const u16* Y5 = (const u16*)(p.ws + O_Y5);
  const u16* Wt = (const u16*)(p.ws + O_WGLU);
  u16* Ym = (u16*)(p.ws + O_HB);
  int nitems = 256 * 2;
  int tid = TIDX, lane = tid & 63, wid = tid >> 6, wr = wid >> 1, wc = wid & 1, fr = lane & 15, fq = lane >> 4;
  int lr = tid >> 3, kc = (tid & 7) * 8;
  for (int it = vbid(); it < nitems; it += gridDim.x) {
    int m0 = (it / 2) * 128, n0 = (it % 2) * 256;
    uint32_t pa[4], pb0 = (uint32_t)(n0 + lr) * 512u + kc;
#pragma unroll
    for (int i = 0; i < 4; ++i) pa[i] = (uint32_t)(m0 + lr + 32 * i) * 512u + kc;
    f32x4 acc[8][4];
    gemm_core<false>(sm, Y5, pa, 512u, Wt, pb0, 512u, 512, acc);
#pragma unroll
    for (int m = 0; m < 4; ++m) {
      size_t r = m0 + wr * 64 + m * 16 + fr;
#pragma unroll
      for (int n = 0; n < 8; ++n) {
        int col = n0 + wc * 128 + n * 16 + fq * 4;
        uint2 yv = *(const uint2*)(Y5 + r * 512 + col);
        float4 bv = *(const float4*)(p.in[38] + col);
        float y0 = bf2f((u16)(yv.x & 0xffff)), y1 = bf2f((u16)(yv.x >> 16)), y2 = bf2f((u16)(yv.y & 0xffff)), y3 = bf2f((u16)(yv.y >> 16));
        uint2 o;
        o.x = pack2(y0 * sigm(acc[n][m][0] + bv.x), y1 * sigm(acc[n][m][1] + bv.y));
        o.y = pack2(y2 * sigm(acc[n][m][2] + bv.z), y3 * sigm(acc[n][m][3] + bv.w));
        *(uint2*)(Ym + r * 1024 + 512 + col) = o;
      }
    }
  }
}

DEVI void run_phase(const Params& p, int ph, unsigned char* smem) {
  float* smf = (float*)smem; u16* smh = (u16*)smem;
  int bid = blockIdx.x, nb = gridDim.x;
#ifdef ONLY_PHASE
  if (ph != ONLY_PHASE) return;
  ph = ONLY_PHASE;
#endif
  switch (ph) {
    case 0: {
      int total = 192 + 272 + 1984 + 18432 + 32;
      for (int it = bid; it < total; it += nb) {
        if (it >= 20880) { int t = it - 20880; prep_tile(p.in[(t & 1) ? 14 : 12] + (size_t)(t >> 1) * 4096, 64, 64, (u16*)(p.ws + O_WLT) + (size_t)t * 4096, 0, smf); }
        else if (it < 192) mod_item(p, it, smf);
        else if (it < 464) filt_item(p, it - 192, smf);
        else if (it < 464 + 1984) {
          int t = it - 464;
          if (t < 640) prep_tile(p.in[9], 1024, 2560, (u16*)(p.ws + O_WIN0), t, smf);
          else if (t < 1408) prep_tile(p.in[26], 1024, 3072, (u16*)(p.ws + O_WIN1), t - 640, smf);
          else if (t < 1920) prep_tile(p.in[8], 1024, 1024, (u16*)(p.ws + O_WOUT), t - 1408, smf);
          else prep_tile(p.in[37], 512, 512, (u16*)(p.ws + O_WGLU), t - 1920, smf);
        } else prep_experts(p, 0, it - 2448, smf);
      }
    } break;
    case 1: {
      for (int it = bid; it < 1152; it += nb) filtfin_item(p, it, smf);
      ph_norm(p, 0, 1, true, false, false, false, smf);
    } break;
    case 2: ph_gemm_in(p, smh, (const u16*)(p.ws + O_WIN0), 2560); break;
    case 3: {
      int total = 4352 + 13056;
      for (int it = bid; it < total; it += nb) { if (it < 4352) lru_item(p, it, smem, 1); else hyconv_item(p, it - 4352, smf); }
    } break;
    case 4: {
      int total = 32 + 1536;
      for (int it = bid; it < total; it += nb) { if (it < 32) lru_combine_item(p, it); else toep_item(p, it - 32, smh, 0); }
    } break;
    case 5: {
      int total = 4352 + 1536;
      for (int it = bid; it < total; it += nb) { if (it < 1536) toep_item(p, it, smh, 1); else lru_item(p, it - 1536, smem, 3); }
    } break;
    case 26: for (int it = bid; it < 4352; it += nb) hytr_item(p, it, smh); break;
    case 6: ph_gemm_out(p, smh, 0); break;
    case 7: { for (int it = bid; it < 16; it += nb) s5pow_item(p, it); ph_norm(p, 0, 2, true, false, true, false, smf); } break;
    case 8: for (int it = bid; it < 256 + 1600; it += nb) { if (it < 256) topk_item(p, it, (int*)smem); else s5tab_item(p, it - 256); } break;
    case 9: ph_moe_up(p, smh, 34); break;
    case 10: ph_moe_down(p, smh, 0, 34); break;
    case 11: {
      for (int it = bid; it < 18432; it += nb) prep_experts(p, 1, it, smf);
      ph_norm(p, 1, 1, true, true, false, true, smf);
    } break;
    case 12: {
      ph_gemm_in(p, smh, (const u16*)(p.ws + O_WIN1), 3072);
    } break;
    case 13: for (int it = bid; it < 4352 + 2176; it += nb) { if (it < 2176) s5A_mfma_item(p, it); else hgrnA_item(p, it - 2176, smem); } break;
    case 24: for (int it = bid; it < 2176; it += nb) s5A_mfma_item(p, it); break;
    case 22: {
      int total = 512 + 128;
      for (int it = bid; it < total; it += nb) { if (it < 512) hgrnB_item(p, it); else s5B_item(p, it - 512); }
    } break;
    case 23: for (int it = bid; it < 2048 + 512; it += nb) { if (it < 512) s5C_mfma_item(p, it, smh); else hgrnC_item(p, it - 512, smem); } break;
    case 25: for (int it = bid; it < 512; it += nb) s5C_mfma_item(p, it, smh); break;
    case 14: ph_l1_finalize(p); break;
    case 15: ph_gemm_glu(p, smh); break;
    case 16: ph_gemm_out(p, smh, 1); break;
    case 17: ph_norm(p, 1, 2, false, false, true, false, smf); break;
    case 18: for (int it = bid; it < 128; it += nb) topk_item(p, it, (int*)smem); break;
    case 19: ph_moe_up(p, smh, 32); break;
    case 20: ph_moe_down(p, smh, 1, 32); break;
    case 21: ph_final(p); break;
  }
}

__global__ void __launch_bounds__(256, 2) mega(Params p, int ph_lo, int ph_hi) {
  extern __shared__ __attribute__((aligned(16))) unsigned char smem[];
  cg::grid_group grid = cg::this_grid();
  __shared__ __attribute__((aligned(16))) unsigned xb_words[4];
  if (threadIdx.x < 4) xb_words[threadIdx.x] = 0u;
  __syncthreads();
  XcdBarrier xb = xcd_barrier_post((unsigned*)(p.ws + O_BAR), (volatile LAS unsigned*)&xb_words);
  if (ph_lo > ph_hi) grid.sync();
#define GSYNC(POS) { xcd_barrier(xb); }
#ifdef PROBE_LO
  long long pt0 = 0;
#define PHC(POS, N) { if (POS > 0) GSYNC(POS) \
    if (POS == PROBE_HI + 1) { long long t1 = wall_clock64(); long long dl = t1 - pt0; while (wall_clock64() - t1 < dl) {} } \
    if (POS == PROBE_LO) pt0 = wall_clock64(); run_phase(p, N, smem); }
#else
#define PHC(POS, N) { if (POS > 0) GSYNC(POS) run_phase(p, N, smem); }
#endif
  PHC(0, 0) PHC(1, 1) PHC(2, 2) PHC(3, 3) PHC(4, 4) PHC(5, 5) PHC(6, 26) PHC(7, 6) PHC(8, 7) PHC(9, 8) PHC(10, 9) PHC(11, 10) PHC(12, 11)
  PHC(13, 12) PHC(14, 13) PHC(15, 22) PHC(16, 23) PHC(17, 14) PHC(18, 15) PHC(19, 16) PHC(20, 17)
  PHC(21, 18) PHC(22, 19) PHC(23, 20) PHC(24, 21)
#ifdef PROBE_LO
  PHC(25, 99)
#endif
#undef PHC
}

extern "C" void kernel_launch(void* const* d_in, const int* in_sizes, int n_in, void* d_out, int out_size,
                              void* d_ws, size_t ws_size, hipStream_t stream) {
  static int grid_blocks = 0;
  if (!grid_blocks) {
    int dev = 0, cus = 0, per_cu = 0;
    (void)hipGetDevice(&dev);
    (void)hipDeviceGetAttribute(&cus, hipDeviceAttributeMultiprocessorCount, dev);
    (void)hipFuncSetAttribute((const void*)mega, hipFuncAttributeMaxDynamicSharedMemorySize, SMEM_BYTES);
    (void)hipOccupancyMaxActiveBlocksPerMultiprocessor(&per_cu, mega, 256, SMEM_BYTES);
    if (per_cu > 2) per_cu = 2;
    if (per_cu < 1) per_cu = 1;
    grid_blocks = cus * per_cu;
  }
  Params p{};
  for (int i = 0; i < 44; ++i) p.in[i] = (const float*)d_in[i];
  p.out = (float*)d_out; p.ws = (unsigned char*)d_ws;
  int lo = 0, hi = 23;
  (void)hipMemsetAsync((unsigned char*)d_ws + O_BAR, 0, XCD_BAR_WORDS * 4, stream);
  void* args[] = {&p, &lo, &hi};
  hipError_t e = hipLaunchCooperativeKernel((void*)mega, dim3(grid_blocks), dim3(256), args, SMEM_BYTES, stream);
  if (e != hipSuccess) fprintf(stderr, "cooperative launch failed: %s (grid %d)\n", hipGetErrorString(e), grid_blocks);
}
```

```cpp
#include <hip/hip_runtime.h>
#include <hip/hip_bf16.h>
#include <hip/hip_cooperative_groups.h>
#include <cstdio>
#include <cstdint>
namespace cg = cooperative_groups;

typedef unsigned short u16;
using bf16x8 = __attribute__((ext_vector_type(8))) short;
using f32x4 = __attribute__((ext_vector_type(4))) float;
using u32x4 = __attribute__((ext_vector_type(4))) uint32_t;
#define DEVI __device__ __forceinline__
__device__ __forceinline__ int tid_opaque() { int t = threadIdx.x; asm volatile("" : "+v"(t)); return t; }
#define TIDX tid_opaque()

constexpr int NL = 32768, NC = 2048, NT = 34816;
constexpr size_t AL(size_t x) { return (x + 255) & ~(size_t)255; }
constexpr size_t EXPSZ = 16ull * 1536 * 1024;
constexpr size_t O_WIN0 = 0;
constexpr size_t O_WIN1 = O_WIN0 + AL(2560ull * 1024 * 2);
constexpr size_t O_WOUT = O_WIN1 + AL(3072ull * 1024 * 2);
constexpr size_t O_WGLU = O_WOUT + AL(2ull * 1024 * 1024 * 2);
constexpr size_t O_WEXP = O_WGLU + AL(512ull * 512 * 2);
constexpr size_t O_MOD = O_WEXP + AL(3 * EXPSZ * 2);
constexpr size_t O_HB = O_MOD + AL(2ull * 9 * 6144 * 4);
constexpr size_t O_U = O_HB + AL((size_t)NT * 1024 * 2);
constexpr size_t O_XC = O_U + AL((size_t)NT * 3072 * 2);
constexpr size_t O_VXL = O_XC + AL((size_t)NC * 1024 * 4);
constexpr size_t O_VXC = O_VXL + AL(3ull * 8 * 512 * 4096 * 2);
constexpr size_t O_Z1L = O_VXC + AL(3ull * 8 * 512 * 256 * 2);
constexpr size_t O_Z1C = O_Z1L + AL(8ull * 512 * 4096 * 2);
constexpr size_t O_HYEND = O_Z1C + AL(8ull * 512 * 256 * 2);
constexpr size_t O_OF = O_VXL;
constexpr size_t O_OB = O_OF + (size_t)NL * 512 * 4;
static_assert(O_OB + (size_t)NL * 512 * 4 <= O_HYEND, "alias");
constexpr size_t O_FRAWL = O_HYEND;
constexpr size_t O_FRAWC = O_FRAWL + AL(4096ull * 1024 * 4);
constexpr size_t O_CSUM = O_FRAWC + AL(256ull * 1024 * 4);
constexpr int GLS = 4096 + 128, GCS = 256 + 128;
constexpr size_t O_GL = O_CSUM + AL(272ull * 1024 * 4);
constexpr size_t O_GC = O_GL + AL(2ull * 1024 * GLS * 2);
constexpr size_t O_Y5F = O_GC + AL(2ull * 1024 * GCS * 2);
constexpr size_t O_Y5B = O_Y5F + AL((size_t)NL * 512 * 2);
constexpr size_t O_Y5 = O_Y5B + AL((size_t)NL * 512 * 2);
constexpr size_t O_AFF = O_Y5 + AL((size_t)NL * 512 * 2);
constexpr size_t O_STOK = O_AFF + AL((size_t)NT * 16 * 4);
constexpr size_t O_SGATE = O_STOK + AL(16ull * 4352 * 4);
constexpr size_t O_AGP = O_SGATE + AL(16ull * 4352 * 4);
constexpr size_t O_AGS = O_AGP + AL(2ull * 544 * 512 * 4);
constexpr size_t O_HS = O_AGS + AL(2ull * 544 * 512 * 4);
constexpr size_t O_END = O_HS + AL(2ull * 544 * 512 * 4);
constexpr size_t O_OUTB = O_VXL;
constexpr size_t O_INV = O_END;
constexpr size_t O_WLT = O_INV + AL((size_t)NT * 16 * 4);
constexpr size_t O_END1 = O_WLT + AL(2ull * 8 * 128 * 64 * 2);
constexpr int SMEM_BYTES = 71680;

struct Params {
  const float* in[44];
  float* out;
  unsigned char* ws;
};

DEVI u16 f2bf(float f) { uint32_t u = __float_as_uint(f); u += 0x7fffu + ((u >> 16) & 1u); return (u16)(u >> 16); }
DEVI float bf2f(u16 h) { return __uint_as_float(((uint32_t)h) << 16); }
DEVI uint32_t pack2(float a, float b) { return (uint32_t)f2bf(a) | ((uint32_t)f2bf(b) << 16); }
DEVI void unpack8(const uint4& x, float (&v)[8]) {
  v[0] = bf2f((u16)(x.x & 0xffff)); v[1] = bf2f((u16)(x.x >> 16)); v[2] = bf2f((u16)(x.y & 0xffff)); v[3] = bf2f((u16)(x.y >> 16));
  v[4] = bf2f((u16)(x.z & 0xffff)); v[5] = bf2f((u16)(x.z >> 16)); v[6] = bf2f((u16)(x.w & 0xffff)); v[7] = bf2f((u16)(x.w >> 16));
}

DEVI float sigm(float x) { return 1.f / (1.f + __expf(-x)); }
DEVI float siluf(float x) { return x * sigm(x); }
DEVI float geluf(float x) { float u = 0.7978845608028654f * (x + 0.044715f * x * x * x); return 0.5f * x * (1.f + tanhf(u)); }
DEVI float wsum(float v) { for (int o = 32; o > 0; o >>= 1) v += __shfl_xor(v, o); return v; }

DEVI void prep_tile(const float* src, int K, int N, u16* dst, int tile_id, float* tile) {
  int tpm = (K / 64) * (N / 64);
  int mat = tile_id / tpm, t = tile_id % tpm;
  int kt = t / (N / 64), nt = t % (N / 64);
  src += (size_t)mat * K * N; dst += (size_t)mat * K * N;
  int k0 = kt * 64, n0 = nt * 64, tid = TIDX;
  int r = tid >> 4, c4 = (tid & 15) * 4;
#pragma unroll
  for (int i = 0; i < 4; ++i) {
    int k = r + 16 * i;
    const float* sp_ = src + (size_t)(k0 + k) * N + n0 + c4;
    float4 v = make_float4(__builtin_nontemporal_load(sp_), __builtin_nontemporal_load(sp_ + 1), __builtin_nontemporal_load(sp_ + 2), __builtin_nontemporal_load(sp_ + 3));
    tile[k * 65 + c4 + 0] = v.x; tile[k * 65 + c4 + 1] = v.y; tile[k * 65 + c4 + 2] = v.z; tile[k * 65 + c4 + 3] = v.w;
  }
  __syncthreads();
  int n = tid >> 3, kc = (tid & 7) * 8;
#pragma unroll
  for (int i = 0; i < 2; ++i) {
    int nn = n + 32 * i;
    uint4 o;
    o.x = pack2(tile[(kc + 0) * 65 + nn], tile[(kc + 1) * 65 + nn]);
    o.y = pack2(tile[(kc + 2) * 65 + nn], tile[(kc + 3) * 65 + nn]);
    o.z = pack2(tile[(kc + 4) * 65 + nn], tile[(kc + 5) * 65 + nn]);
    o.w = pack2(tile[(kc + 6) * 65 + nn], tile[(kc + 7) * 65 + nn]);
    *(uint4*)(dst + (size_t)(n0 + nn) * K + k0 + kc) = o;
  }
  __syncthreads();
}

DEVI void prep_tile128(const float* src, int K, int N, u16* dst, int tile_id, float* tile) {
  int tpm = (K / 128) * (N / 128);
  int mat = tile_id / tpm, t = tile_id % tpm;
  int kt = t / (N / 128), nt = t % (N / 128);
  src += (size_t)mat * K * N; dst += (size_t)mat * K * N;
  int k0 = kt * 128, n0 = nt * 128, tid = TIDX;
  int r = tid >> 5, c4 = (tid & 31) * 4;
#pragma unroll 4
  for (int i = 0; i < 16; ++i) {
    int k = r + 8 * i;
    float4 v = *(const float4*)(src + (size_t)(k0 + k) * N + n0 + c4);
    tile[k * 129 + c4 + 0] = v.x; tile[k * 129 + c4 + 1] = v.y; tile[k * 129 + c4 + 2] = v.z; tile[k * 129 + c4 + 3] = v.w;
  }
  __syncthreads();
  int n = tid >> 4, kc = (tid & 15) * 8;
#pragma unroll 2
  for (int i = 0; i < 8; ++i) {
    int nn = n + 16 * i;
    uint4 o;
    o.x = pack2(tile[(kc + 0) * 129 + nn], tile[(kc + 1) * 129 + nn]);
    o.y = pack2(tile[(kc + 2) * 129 + nn], tile[(kc + 3) * 129 + nn]);
    o.z = pack2(tile[(kc + 4) * 129 + nn], tile[(kc + 5) * 129 + nn]);
    o.w = pack2(tile[(kc + 6) * 129 + nn], tile[(kc + 7) * 129 + nn]);
    *(uint4*)(dst + (size_t)(n0 + nn) * K + k0 + kc) = o;
  }
  __syncthreads();
}

DEVI void prep_experts(const Params& p, int layer, int it, float* tile) {
  u16* wexp = (u16*)(p.ws + O_WEXP);
  int kind = it / 6144, t = it % 6144;
  if (kind == 0) prep_tile(p.in[40] + (size_t)layer * EXPSZ, 1024, 1536, wexp, t, tile);
  else if (kind == 1) prep_tile(p.in[41] + (size_t)layer * EXPSZ, 1024, 1536, wexp + EXPSZ, t, tile);
  else prep_tile(p.in[42] + (size_t)layer * EXPSZ, 1536, 1024, wexp + 2 * EXPSZ, t, tile);
}

DEVI void mod_item(const Params& p, int it, float* sm) {
  int l = it / 96, j0 = (it % 96) * 64, tid = TIDX;
  float* sc = sm;
  float* red = sm + 9 * 1024;
  for (int i = tid; i < 9 * 1024; i += 256) {
    int r = i >> 10, k = i & 1023;
    float v = (r < 8) ? p.in[1][r * 1024 + k] : p.in[3][k];
    sc[i] = siluf(v);
  }
  __syncthreads();
  int col = tid & 63, kq = tid >> 6;
  float acc[9];
#pragma unroll
  for (int r = 0; r < 9; ++r) acc[r] = 0.f;
  const float* w = p.in[4] + (size_t)l * 1024 * 6144 + j0 + col;
#pragma unroll 8
  for (int k = kq * 256; k < kq * 256 + 256; ++k) {
    float wv = w[(size_t)k * 6144];
#pragma unroll
    for (int r = 0; r < 9; ++r) acc[r] += sc[r * 1024 + k] * wv;
  }
#pragma unroll
  for (int r = 0; r < 9; ++r) red[(kq * 9 + r) * 64 + col] = acc[r];
  __syncthreads();
  float* mod = (float*)(p.ws + O_MOD);
  for (int i = tid; i < 9 * 64; i += 256) {
    int r = i >> 6, c = i & 63;
    float s = red[(0 * 9 + r) * 64 + c] + red[(1 * 9 + r) * 64 + c] + red[(2 * 9 + r) * 64 + c] + red[(3 * 9 + r) * 64 + c];
    mod[((size_t)l * 9 + r) * 6144 + j0 + c] = s + p.in[5][l * 6144 + j0 + c];
  }
  __syncthreads();
}

DEVI void filt_item(const Params& p, int it, float* sm) {
  int L, t0, blk; float* fraw;
  if (it < 256) { L = 4096; t0 = it * 16; blk = it; fraw = (float*)(p.ws + O_FRAWL); }
  else { L = 256; t0 = (it - 256) * 16; blk = it; fraw = (float*)(p.ws + O_FRAWC); }
  float* z = sm;
  float* h1 = sm + 16 * 33;
  float* h2 = h1 + 16 * 64;
  int tid = TIDX;
  const float* w1 = p.in[19]; const float* b1 = p.in[20]; const float* w2 = p.in[21]; const float* b2 = p.in[22];
  const float* w3 = p.in[23]; const float* fr = p.in[24];
  for (int i = tid; i < 16 * 33; i += 256) {
    int pos = i / 33, c = i % 33;
    float t = (float)(t0 + pos);
    float v;
    if (c == 0) v = t / (float)(L - 1);
    else {
      int bi = (c - 1) & 15;
      float band = 1e-4f + (float)bi * ((15.f - 1e-4f) / 15.f);
      float ang = ((6.283185307179586f / (float)L) * t) * band;
      v = (c <= 16) ? cosf(ang) : -sinf(ang);
    }
    z[i] = v;
  }
  __syncthreads();
  for (int i = tid; i < 16 * 64; i += 256) {
    int pos = i >> 6, j = i & 63;
    float s = b1[j];
#pragma unroll 3
    for (int k = 0; k < 33; ++k) s += z[pos * 33 + k] * w1[k * 64 + j];
    h1[i] = sinf(fr[j] * s);
  }
  __syncthreads();
  for (int i = tid; i < 16 * 64; i += 256) {
    int pos = i >> 6, j = i & 63;
    float s = b2[j];
#pragma unroll 4
    for (int k = 0; k < 64; ++k) s += h1[pos * 64 + k] * w2[k * 64 + j];
    h2[i] = sinf(fr[j] * s);
  }
  __syncthreads();
  float* csum = (float*)(p.ws + O_CSUM);
  const float dmin = -3.0701134573253946f, dmax = -15.350567286626973f;
#pragma unroll 1
  for (int cc = 0; cc < 4; ++cc) {
    int col = tid + 256 * cc;
    float acc[16];
#pragma unroll
    for (int q = 0; q < 16; ++q) acc[q] = 0.f;
#pragma unroll 8
    for (int k = 0; k < 64; ++k) {
      float wv = w3[k * 1024 + col];
#pragma unroll
      for (int q = 0; q < 16; ++q) acc[q] += h2[q * 64 + k] * wv;
    }
    float delta = fabsf(dmin + (float)col * ((dmax - dmin) / 1023.f));
    float ss = 0.f;
#pragma unroll
    for (int q = 0; q < 16; ++q) {
      float t = (float)(t0 + q);
      float dist = fabsf(t - (float)(L / 2)) / ((float)L * 0.5f);
      float v = acc[q] * expf(-dist * delta);
      fraw[(size_t)(t0 + q) * 1024 + col] = v;
      ss += v * v;
    }
    csum[(size_t)blk * 1024 + col] = ss;
  }
  __syncthreads();
}

DEVI void filtfin_item(const Params& p, int it, float* sm) {
  int L, gs, ct, mt, nb, b0; const float* fraw; u16* G;
  if (it < 16 * 66) { L = 4096; gs = GLS; ct = it / 66; mt = it % 66; nb = 256; b0 = 0; fraw = (const float*)(p.ws + O_FRAWL); G = (u16*)(p.ws + O_GL); }
  else { int j = it - 16 * 66; L = 256; gs = GCS; ct = j / 6; mt = j % 6; nb = 16; b0 = 256; fraw = (const float*)(p.ws + O_FRAWC); G = (u16*)(p.ws + O_GC); }
  float* scale = sm;
  float* red = sm + 64;
  float* tile = sm + 64 + 256;
  int tid = TIDX, c0 = ct * 64, m0 = mt * 64;
  const float* csum = (const float*)(p.ws + O_CSUM);
  {
    int c = tid & 63, q = tid >> 6;
    float s = 0.f;
#pragma unroll 8
    for (int b = q; b < nb; b += 4) s += csum[(size_t)(b0 + b) * 1024 + c0 + c];
    red[q * 64 + c] = s;
  }
  __syncthreads();
  if (tid < 64) scale[tid] = rsqrtf(red[tid] + red[64 + tid] + red[128 + tid] + red[192 + tid] + 1e-6f);
  int thi = L + 63 - m0;
  for (int i = tid; i < 65 * 64; i += 256) {
    int rr = i >> 6, c = i & 63;
    int t = thi - rr;
    tile[rr * 65 + c] = (t >= 0 && t < L) ? fraw[(size_t)t * 1024 + c0 + c] : 0.f;
  }
  __syncthreads();
  for (int i = tid; i < 2 * 64 * 8; i += 256) {
    int m8 = (i & 7) * 8, c = (i >> 3) & 63, par = i >> 9;
    float sc = scale[c];
    uint4 o;
    o.x = pack2(tile[(m8 + 0 + par) * 65 + c] * sc, tile[(m8 + 1 + par) * 65 + c] * sc);
    o.y = pack2(tile[(m8 + 2 + par) * 65 + c] * sc, tile[(m8 + 3 + par) * 65 + c] * sc);
    o.z = pack2(tile[(m8 + 4 + par) * 65 + c] * sc, tile[(m8 + 5 + par) * 65 + c] * sc);
    o.w = pack2(tile[(m8 + 6 + par) * 65 + c] * sc, tile[(m8 + 7 + par) * 65 + c] * sc);
    *(uint4*)(G + ((size_t)par * 1024 + c0 + c) * gs + m0 + m8) = o;
  }
  __syncthreads();
}

DEVI void moe_combine(const Params& p, int r, int lane, float4 (&v)[4]) {
  const int* inv = (const int*)(p.ws + O_INV) + (size_t)r * 16;
  const u16* ob = (const u16*)(p.ws + O_OUTB);
  int myslot = (lane < 16) ? inv[lane] : -1;
  unsigned long long mask = __ballot(myslot >= 0);
  while (mask) {
    int e0 = __ffsll((long long)mask) - 1; mask &= mask - 1;
    int s0 = __shfl(myslot, e0);
    int e1 = -1, s1 = 0;
    if (mask) { e1 = __ffsll((long long)mask) - 1; mask &= mask - 1; s1 = __shfl(myslot, e1); }
    const u16* r0 = ob + ((size_t)e0 * 4352 + s0) * 1024 + lane * 4;
    uint2 q0[4], q1[4];
#pragma unroll
    for (int i = 0; i < 4; ++i) q0[i] = *(const uint2*)(r0 + 256 * i);
    if (e1 >= 0) {
      const u16* r1 = ob + ((size_t)e1 * 4352 + s1) * 1024 + lane * 4;
#pragma unroll
      for (int i = 0; i < 4; ++i) q1[i] = *(const uint2*)(r1 + 256 * i);
    } else {
#pragma unroll
      for (int i = 0; i < 4; ++i) q1[i] = make_uint2(0u, 0u);
    }
#pragma unroll
    for (int i = 0; i < 4; ++i) {
      v[i].x += bf2f((u16)(q0[i].x & 0xffff)); v[i].y += bf2f((u16)(q0[i].x >> 16)); v[i].z += bf2f((u16)(q0[i].y & 0xffff)); v[i].w += bf2f((u16)(q0[i].y >> 16));
      v[i].x += bf2f((u16)(q1[i].x & 0xffff)); v[i].y += bf2f((u16)(q1[i].x >> 16)); v[i].z += bf2f((u16)(q1[i].y & 0xffff)); v[i].w += bf2f((u16)(q1[i].y >> 16));
    }
  }
}

DEVI void ph_norm(const Params& p, int layer, int which, bool with_ctx, bool perm, bool router, bool combine, float* smf) {
  const float* xl = (layer == 0 && which == 1) ? p.in[0] : p.out;
  const float* xc = (layer == 0 && which == 1) ? p.in[2] : (const float*)(p.ws + O_XC);
  const float* g = p.in[which == 1 ? 6 : 7] + layer * 1024;
  const float* mod = (const float*)(p.ws + O_MOD) + (size_t)layer * 9 * 6144;
  int sh = (which == 1) ? 0 : 3;
  u16* hb = (u16*)(p.ws + O_HB);
  float* aff = (float*)(p.ws + O_AFF);
  const float* rw = p.in[39] + (size_t)layer * 1024 * 16;
  int lane = TIDX & 63, wave = TIDX >> 6;
  int nrows = with_ctx ? NT : NL;
  float4* rws = (float4*)smf;
  if (router) {
    for (int i = TIDX; i < 4096; i += 256) {
      int k = i >> 2, e4 = i & 3;
      rws[((e4 * 4 + (k & 3)) * 4 + (k >> 8)) * 64 + ((k >> 2) & 63)] = *(const float4*)(rw + (size_t)k * 16 + e4 * 4);
    }
    __syncthreads();
  }
  for (int r = blockIdx.x * 4 + wave; r < nrows; r += gridDim.x * 4) {
    const float* src; int mr; size_t drow;
    if (r < NL) {
      src = xl + (size_t)r * 1024; mr = r >> 12;
      if (perm) { int t = r & 4095; drow = (size_t)(r & ~4095) + (t & 63) * 64 + (t >> 6); } else drow = r;
    } else { src = xc + (size_t)(r - NL) * 1024; mr = 8; drow = r; }
    float4 v[4]; float ss = 0.f;
#pragma unroll
    for (int i = 0; i < 4; ++i) v[i] = *(const float4*)(src + lane * 4 + 256 * i);
    if (combine) {
      moe_combine(p, r, lane, v);
      float* wb = (float*)src;
#pragma unroll
      for (int i = 0; i < 4; ++i) *(float4*)(wb + lane * 4 + 256 * i) = v[i];
    }
#pragma unroll
    for (int i = 0; i < 4; ++i) ss += v[i].x * v[i].x + v[i].y * v[i].y + v[i].z * v[i].z + v[i].w * v[i].w;
    ss = wsum(ss);
    float rs = rsqrtf(ss * (1.f / 1024.f) + 1e-6f);
    const float* shp = mod + (size_t)mr * 6144 + sh * 1024;
    const float* scp = shp + 1024;
    float lg[16];
    if (router) {
#pragma unroll
      for (int e = 0; e < 16; ++e) lg[e] = 0.f;
    }
#pragma unroll
    for (int i = 0; i < 4; ++i) {
      int k = lane * 4 + 256 * i;
      float4 gg = *(const float4*)(g + k), s4 = *(const float4*)(shp + k), c4 = *(const float4*)(scp + k);
      float h0 = (v[i].x * rs * gg.x) * (1.f + c4.x) + s4.x;
      float h1 = (v[i].y * rs * gg.y) * (1.f + c4.y) + s4.y;
      float h2 = (v[i].z * rs * gg.z) * (1.f + c4.z) + s4.z;
      float h3 = (v[i].w * rs * gg.w) * (1.f + c4.w) + s4.w;
      uint2 o; o.x = pack2(h0, h1); o.y = pack2(h2, h3);
      *(uint2*)(hb + drow * 1024 + k) = o;
      if (router) {
        float hh[4] = {h0, h1, h2, h3};
#pragma unroll
        for (int q = 0; q < 4; ++q) {
#pragma unroll
          for (int e4 = 0; e4 < 4; ++e4) {
            float4 w = rws[((e4 * 4 + q) * 4 + i) * 64 + lane];
            lg[e4 * 4 + 0] += hh[q] * w.x; lg[e4 * 4 + 1] += hh[q] * w.y; lg[e4 * 4 + 2] += hh[q] * w.z; lg[e4 * 4 + 3] += hh[q] * w.w;
          }
          __builtin_amdgcn_sched_barrier(0);
        }
      }
    }
    if (router) {
      float mx = -1e30f;
#pragma unroll
      for (int e = 0; e < 16; ++e) { lg[e] = wsum(lg[e]); mx = fmaxf(mx, lg[e]); }
      float den = 0.f;
#pragma unroll
      for (int e = 0; e < 16; ++e) { lg[e] = expf(lg[e] - mx); den += lg[e]; }
      float inv = 1.f / den;
      float mine = 0.f;
#pragma unroll
      for (int e = 0; e < 16; ++e) if (lane == e) mine = lg[e] * inv;
      if (lane < 16) aff[(size_t)r * 16 + lane] = mine;
    }
  }
}

DEVI int vbid() { int nb = gridDim.x; return ((nb & 7) == 0) ? (int)((blockIdx.x & 7) * (nb >> 3) + (blockIdx.x >> 3)) : (int)blockIdx.x; }

DEVI uint32_t gemm_boff(int i, uint32_t ldb) { return ldb ? (uint32_t)i * 32u * ldb : (((i & 3) < 2) ? 0u : (uint32_t)EXPSZ) + (uint32_t)((i >> 2) * 64 + 32 * (i & 1)) * 1024u; }
template <bool GATHER>
DEVI void gemm_core(u16* sm, const u16* Ab, const uint32_t (&pa)[4], uint32_t lda, const u16* Bb, uint32_t pb0, uint32_t ldb, int K, f32x4 (&acc)[8][4]) {
  u16* As = sm; u16* Bs = sm + 128 * 72;
  int tid = TIDX, lane = tid & 63, wid = tid >> 6, wr = wid >> 1, wc = wid & 1;
  int fr = lane & 15, fq = lane >> 4;
  int lrow = tid >> 3, lkc = (tid & 7) * 8;
  u32x4 ra[4], rb[8];
#pragma unroll
  for (int i = 0; i < 4; ++i) ra[i] = *(const u32x4*)(Ab + (GATHER ? pa[i] : pa[0] + (uint32_t)i * 32u * lda));
#pragma unroll
  for (int i = 0; i < 8; ++i) rb[i] = *(const u32x4*)(Bb + pb0 + gemm_boff(i, ldb));
#pragma unroll
  for (int a = 0; a < 8; ++a)
#pragma unroll
    for (int b = 0; b < 4; ++b) acc[a][b] = (f32x4){0.f, 0.f, 0.f, 0.f};
  int nk = K >> 6;
  for (int kt = 0; kt < nk; ++kt) {
    __syncthreads();
#pragma unroll
    for (int i = 0; i < 4; ++i) *(u32x4*)(As + (lrow + 32 * i) * 72 + lkc) = ra[i];
#pragma unroll
    for (int i = 0; i < 8; ++i) *(u32x4*)(Bs + (lrow + 32 * i) * 72 + lkc) = rb[i];
    __syncthreads();
    if (kt + 1 < nk) {
#pragma unroll
      for (int i = 0; i < 4; ++i) ra[i] = *(const u32x4*)(Ab + (GATHER ? pa[i] : pa[0] + (uint32_t)i * 32u * lda) + (kt + 1) * 64);
#pragma unroll
      for (int i = 0; i < 8; ++i) rb[i] = *(const u32x4*)(Bb + pb0 + gemm_boff(i, ldb) + (kt + 1) * 64);
    }
    __builtin_amdgcn_sched_barrier(0);
#pragma unroll
    for (int ks = 0; ks < 2; ++ks) {
      bf16x8 af[4];
#pragma unroll
      for (int m = 0; m < 4; ++m) af[m] = *(const bf16x8*)(As + (wr * 64 + m * 16 + fr) * 72 + ks * 32 + fq * 8);
#pragma unroll
      for (int nh = 0; nh < 4; ++nh) {
        bf16x8 bfm[2];
#pragma unroll
        for (int n = 0; n < 2; ++n) bfm[n] = *(const bf16x8*)(Bs + (wc * 128 + (nh * 2 + n) * 16 + fr) * 72 + ks * 32 + fq * 8);
#pragma unroll
        for (int n = 0; n < 2; ++n)
#pragma unroll
          for (int m = 0; m < 4; ++m) acc[nh * 2 + n][m] = __builtin_amdgcn_mfma_f32_16x16x32_bf16(bfm[n], af[m], acc[nh * 2 + n][m], 0, 0, 0);
      }
      __builtin_amdgcn_sched_barrier(0);
    }
  }
  __syncthreads();
}

DEVI void ph_gemm_in(const Params& p, u16* sm, const u16* Wt, int N) {
  const u16* H = (const u16*)(p.ws + O_HB);
  u16* U = (u16*)(p.ws + O_U);
  int ntl = N / 256, nitems = 272 * ntl;
  int tid = TIDX, lane = tid & 63, wid = tid >> 6, wr = wid >> 1, wc = wid & 1, fr = lane & 15, fq = lane >> 4;
  int lr = tid >> 3, kc = (tid & 7) * 8;
  int gsz = (ntl == 10) ? 5 : 4;
  for (int it = vbid(); it < nitems; it += gridDim.x) {
    int ng = it / (272 * gsz), rem = it % (272 * gsz);
    int m0 = (rem / gsz) * 128, n0 = (ng * gsz + rem % gsz) * 256;
    uint32_t pa[4], pb0 = (uint32_t)(n0 + lr) * 1024u + kc;
#pragma unroll
    for (int i = 0; i < 4; ++i) pa[i] = (uint32_t)(m0 + lr + 32 * i) * 1024u + kc;
    f32x4 acc[8][4];
    gemm_core<false>(sm, H, pa, 1024u, Wt, pb0, 1024u, 1024, acc);
#pragma unroll
    for (int n = 0; n < 8; ++n)
#pragma unroll
      for (int m = 0; m < 4; ++m) {
        int row = m0 + wr * 64 + m * 16 + fr, col = n0 + wc * 128 + n * 16 + fq * 4;
        uint2 o; o.x = pack2(acc[n][m][0], acc[n][m][1]); o.y = pack2(acc[n][m][2], acc[n][m][3]);
        *(uint2*)(U + (size_t)row * N + col) = o;
      }
  }
}

DEVI void ph_gemm_out(const Params& p, u16* sm, int layer) {
  const u16* Y = (const u16*)(p.ws + O_HB);
  const u16* Wt = (const u16*)(p.ws + O_WOUT) + (size_t)layer * 1024 * 1024;
  const float* mod = (const float*)(p.ws + O_MOD) + (size_t)layer * 9 * 6144 + 2 * 1024;
  float* xcw = (float*)(p.ws + O_XC);
  int mtiles = (layer == 0) ? 272 : 256, nitems = mtiles * 4;
  int tid = TIDX, lane = tid & 63, wid = tid >> 6, wr = wid >> 1, wc = wid & 1, fr = lane & 15, fq = lane >> 4;
  int lr = tid >> 3, kc = (tid & 7) * 8;
  for (int it = vbid(); it < nitems; it += gridDim.x) {
    int m0 = (it / 4) * 128, n0 = (it % 4) * 256;
    uint32_t pa[4], pb0 = (uint32_t)(n0 + lr) * 1024u + kc;
#pragma unroll
    for (int i = 0; i < 4; ++i) pa[i] = (uint32_t)(m0 + lr + 32 * i) * 1024u + kc;
    f32x4 acc[8][4];
    gemm_core<false>(sm, Y, pa, 1024u, Wt, pb0, 1024u, 1024, acc);
#pragma unroll
    for (int m = 0; m < 4; ++m) {
      int r = m0 + wr * 64 + m * 16 + fr;
      const float* xin; float* dst; int mr;
      if (r < NL) {
        mr = r >> 12; size_t tok = r;
        if (layer == 1) { int pp = r & 4095; tok = (size_t)(r & ~4095) + (pp & 63) * 64 + (pp >> 6); }
        xin = ((layer == 0) ? p.in[0] : (const float*)p.out) + tok * 1024; dst = p.out + tok * 1024;
      } else { mr = 8; size_t cr = r - NL; xin = p.in[2] + cr * 1024; dst = xcw + cr * 1024; }
      const float* gl = mod + (size_t)mr * 6144;
#pragma unroll
      for (int n = 0; n < 8; ++n) {
        int col = n0 + wc * 128 + n * 16 + fq * 4;
        float4 xv = *(const float4*)(xin + col), gv = *(const float4*)(gl + col);
        float4 o = make_float4(xv.x + gv.x * acc[n][m][0], xv.y + gv.y * acc[n][m][1], xv.z + gv.z * acc[n][m][2], xv.w + gv.w * acc[n][m][3]);
        *(float4*)(dst + col) = o;
      }
    }
  }
}
DEVI void lru_gates(const Params& p, const float* xh, const u16* xhb, float* z, int dir, int h, int j, int tg, float (&a)[16], float (&bb)[16]) {
  int lane = TIDX & 63, w = TIDX >> 6, fr = lane & 15, fq = lane >> 4;
  const u16* WL = (const u16*)(p.ws + O_WLT) + (size_t)((dir * 8 + h) * 128) * 64;
  f32x4 acc[2][4];
#pragma unroll
  for (int n = 0; n < 2; ++n)
#pragma unroll
    for (int m = 0; m < 4; ++m) acc[n][m] = (f32x4){0.f, 0.f, 0.f, 0.f};
#pragma unroll
  for (int ks = 0; ks < 2; ++ks) {
    bf16x8 wf[2], xf[4];
#pragma unroll
    for (int n = 0; n < 2; ++n) wf[n] = *(const bf16x8*)(WL + ((2 * w + n) * 16 + fr) * 64 + ks * 32 + fq * 8);
#pragma unroll
    for (int m = 0; m < 4; ++m) xf[m] = *(const bf16x8*)(xhb + (m * 16 + fr) * 72 + ks * 32 + fq * 8);
#pragma unroll
    for (int n = 0; n < 2; ++n)
#pragma unroll
      for (int m = 0; m < 4; ++m) acc[n][m] = __builtin_amdgcn_mfma_f32_16x16x32_bf16(wf[n], xf[m], acc[n][m], 0, 0, 0);
  }
#pragma unroll
  for (int n = 0; n < 2; ++n)
#pragma unroll
    for (int m = 0; m < 4; ++m)
      *(float4*)(z + (m * 16 + fr) * 132 + (2 * w + n) * 16 + 4 * fq) = make_float4(acc[n][m][0], acc[n][m][1], acc[n][m][2], acc[n][m][3]);
  __syncthreads();
  int gi = (dir * 8 + h) * 64 + j;
  float bav = p.in[13][gi], bxv = p.in[15][gi], lam = p.in[16][gi];
  float sp = log1pf(expf(-lam));
#pragma unroll
  for (int q = 0; q < 16; ++q) {
    int tok = tg * 16 + q;
    float r = sigm(z[tok * 132 + j] + bav), ig = sigm(z[tok * 132 + 64 + j] + bxv);
    float la = -8.f * r * sp;
    a[q] = __expf(la);
    bb[q] = sqrtf(1.f - __expf(2.f * la)) * ig * xh[tok * 64 + j];
  }
  __syncthreads();
}

DEVI void lru_item(const Params& p, int it, unsigned char* smem, int mode) {
  int ci = it >> 3, h = it & 7;
  int rowbase, t0, slen;
  if (ci < 512) { rowbase = (ci >> 6) * 4096; t0 = (ci & 63) * 64; slen = 4096; }
  else { int cc = ci - 512; rowbase = NL + (cc >> 2) * 256; t0 = (cc & 3) * 64; slen = 256; }
  const u16* U = (const u16*)(p.ws + O_U);
  float* xh = (float*)smem;
  u16* xhb = (u16*)(smem + 16384);
  float* z = (float*)(smem + 25600);
  float* xraw = z;
  float* agg = (float*)(smem + 59392);
  int tid = TIDX, j = tid & 63, tg = tid >> 6;
  for (int i = tid; i < 67 * 8; i += 256) {
    int rr = i >> 3, c8 = (i & 7) * 8, t = t0 - 1 + rr;
    float v8[8];
    if (t >= 0 && t < slen) unpack8(*(const uint4*)(U + (size_t)(rowbase + t) * 2560 + h * 64 + c8), v8);
    else { for (int k = 0; k < 8; ++k) v8[k] = 0.f; }
#pragma unroll
    for (int k = 0; k < 8; ++k) xraw[rr * 64 + c8 + k] = v8[k];
  }
  __syncthreads();
  {
    const float* cw = p.in[10]; int ch = h * 64 + j;
    float w0 = cw[ch], w1 = cw[512 + ch], w2 = cw[1024 + ch], w3 = cw[1536 + ch], cb = p.in[11][ch];
#pragma unroll
    for (int q = 0; q < 16; ++q) {
      int t = tg * 16 + q;
      float v = cb + w0 * xraw[t * 64 + j] + w1 * xraw[(t + 1) * 64 + j] + w2 * xraw[(t + 2) * 64 + j] + w3 * xraw[(t + 3) * 64 + j];
      xh[t * 64 + j] = v; xhb[t * 72 + j] = f2bf(v);
    }
  }
  __syncthreads();
  float af[16], bf_[16], ab[16], bk[16];
  lru_gates(p, xh, xhb, z, 0, h, j, tg, af, bf_);
  lru_gates(p, xh, xhb, z, 1, h, j, tg, ab, bk);
  {
    float P = 1.f, S = 0.f;
#pragma unroll
    for (int q = 0; q < 16; ++q) { S = af[q] * S + bf_[q]; P *= af[q]; }
    agg[((0 * 4 + tg) * 2 + 0) * 64 + j] = P; agg[((0 * 4 + tg) * 2 + 1) * 64 + j] = S;
    P = 1.f; S = 0.f;
#pragma unroll
    for (int q = 15; q >= 0; --q) { S = ab[q] * S + bk[q]; P *= ab[q]; }
    agg[((1 * 4 + tg) * 2 + 0) * 64 + j] = P; agg[((1 * 4 + tg) * 2 + 1) * 64 + j] = S;
  }
  __syncthreads();
  int ch = h * 64 + j;
  if (mode == 1) {
    if (tg == 0) {
      float* agp = (float*)(p.ws + O_AGP); float* ags = (float*)(p.ws + O_AGS);
      float P = 1.f, S = 0.f;
      for (int g = 0; g < 4; ++g) { float pg = agg[((0 * 4 + g) * 2 + 0) * 64 + j], sg = agg[((0 * 4 + g) * 2 + 1) * 64 + j]; S = pg * S + sg; P *= pg; }
      agp[((size_t)0 * 544 + ci) * 512 + ch] = P; ags[((size_t)0 * 544 + ci) * 512 + ch] = S;
      P = 1.f; S = 0.f;
      for (int g = 3; g >= 0; --g) { float pg = agg[((1 * 4 + g) * 2 + 0) * 64 + j], sg = agg[((1 * 4 + g) * 2 + 1) * 64 + j]; S = pg * S + sg; P *= pg; }
      agp[((size_t)1 * 544 + ci) * 512 + ch] = P; ags[((size_t)1 * 544 + ci) * 512 + ch] = S;
    }
  } else {
    const float* hs = (const float*)(p.ws + O_HS);
    u16* Y = (u16*)(p.ws + O_HB);
    float s = hs[((size_t)0 * 544 + ci) * 512 + ch];
    for (int g = 0; g < tg; ++g) s = agg[((0 * 4 + g) * 2 + 0) * 64 + j] * s + agg[((0 * 4 + g) * 2 + 1) * 64 + j];
    float hf[16];
#pragma unroll
    for (int q = 0; q < 16; ++q) { s = af[q] * s + bf_[q]; hf[q] = s; }
    s = hs[((size_t)1 * 544 + ci) * 512 + ch];
    for (int g = 3; g > tg; --g) s = agg[((1 * 4 + g) * 2 + 0) * 64 + j] * s + agg[((1 * 4 + g) * 2 + 1) * 64 + j];
#pragma unroll
    for (int q = 15; q >= 0; --q) {
      s = ab[q] * s + bk[q];
      size_t row = (size_t)(rowbase + t0 + tg * 16 + q);
      float xg = bf2f(U[row * 2560 + 512 + ch]);
      Y[row * 1024 + ch] = f2bf((hf[q] + s) * geluf(xg));
    }
  }
  __syncthreads();
}

DEVI void lru_combine_item(const Params& p, int it) {
  int gt = it * 256 + TIDX;
  int dir = gt >> 12, b = (gt >> 9) & 7, ch = gt & 511;
  const float* agp = (const float*)(p.ws + O_AGP) + (size_t)dir * 544 * 512 + ch;
  const float* ags = (const float*)(p.ws + O_AGS) + (size_t)dir * 544 * 512 + ch;
  float* hs = (float*)(p.ws + O_HS) + (size_t)dir * 544 * 512 + ch;
  float s = 0.f;
#pragma unroll 1
  for (int kb = 0; kb < 68; kb += 17) {
    float P[17], S[17]; int ci[17];
#pragma unroll
    for (int q = 0; q < 17; ++q) {
      int k = kb + q;
      ci[q] = (k < 4) ? (512 + b * 4 + (dir ? 3 - k : k)) : (b * 64 + (dir ? 67 - k : k - 4));
      P[q] = agp[(size_t)ci[q] * 512]; S[q] = ags[(size_t)ci[q] * 512];
    }
#pragma unroll
    for (int q = 0; q < 17; ++q) { hs[(size_t)ci[q] * 512] = s; s = P[q] * s + S[q]; }
  }
}

DEVI void hyconv_item(const Params& p, int it, float* sm) {
  int ci = it / 24, ct = it % 24;
  int rowbase, t0, slen, b; u16* dst; int L;
  if (ci < 512) { b = ci >> 6; rowbase = b * 4096; t0 = (ci & 63) * 64; slen = 4096; dst = (u16*)(p.ws + O_VXL); L = 4096; }
  else { int cc = ci - 512; b = cc >> 2; rowbase = NL + b * 256; t0 = (cc & 3) * 64; slen = 256; dst = (u16*)(p.ws + O_VXC); L = 256; }
  const u16* U = (const u16*)(p.ws + O_U);
  float* xs = sm;
  int tid = TIDX, c0 = ct * 64;
  for (int i = tid; i < 66 * 8; i += 256) {
    int rr = i >> 3, c8 = (i & 7) * 8, t = t0 - 1 + rr;
    float v8[8];
    if (t >= 0 && t < slen) unpack8(*(const uint4*)(U + (size_t)(rowbase + t) * 2560 + 1024 + c0 + c8), v8);
    else { for (int k = 0; k < 8; ++k) v8[k] = 0.f; }
#pragma unroll
    for (int k = 0; k < 8; ++k) xs[rr * 65 + c8 + k] = v8[k];
  }
  __syncthreads();
  int c = tid >> 2, tq = tid & 3, ch = c0 + c;
  const float* hw = p.in[17];
  float w0 = hw[ch], w1 = hw[1536 + ch], w2 = hw[3072 + ch], cb = p.in[18][ch];
  int which = ch >> 9, cc = ch & 511;
  uint32_t o[8];
#pragma unroll
  for (int q = 0; q < 8; ++q) {
    int tl = tq * 16 + 2 * q;
    float y0 = cb + w0 * xs[tl * 65 + c] + w1 * xs[(tl + 1) * 65 + c] + w2 * xs[(tl + 2) * 65 + c];
    float y1 = cb + w0 * xs[(tl + 1) * 65 + c] + w1 * xs[(tl + 2) * 65 + c] + w2 * xs[(tl + 3) * 65 + c];
    o[q] = pack2(y0, y1);
  }
  u16* d = dst + ((size_t)(which * 8 + b) * 512 + cc) * L + t0 + tq * 16;
  *(uint4*)d = make_uint4(o[0], o[1], o[2], o[3]);
  *(uint4*)(d + 8) = make_uint4(o[4], o[5], o[6], o[7]);
  __syncthreads();
}

DEVI void toep_item(const Params& p, int it, u16* Xs, int order) {
  int c, half, L, gs; const u16* G; const u16* vx; const u16* z1; u16* z1w;
  if (it < 1024) { c = it >> 1; half = it & 1; L = 4096; gs = GLS; G = (const u16*)(p.ws + O_GL); vx = (const u16*)(p.ws + O_VXL); z1 = (const u16*)(p.ws + O_Z1L); z1w = (u16*)(p.ws + O_Z1L); }
  else { c = it - 1024; half = 0; L = 256; gs = GCS; G = (const u16*)(p.ws + O_GC); vx = (const u16*)(p.ws + O_VXC); z1 = (const u16*)(p.ws + O_Z1C); z1w = (u16*)(p.ws + O_Z1C); }
  int T1 = L >> 6, ntiles = T1 >> 1, XS = L + 8;
  int tid = TIDX, lane = tid & 63, w = tid >> 6, fr = lane & 15, fq = lane >> 4;
  const u16* xsrc = (order == 0) ? vx : z1;
  int l8 = L >> 3;
  for (int i = tid; i < 8 * l8; i += 256) {
    int b = i / l8, k8 = i % l8;
    *(uint4*)(Xs + b * XS + k8 * 8) = *(const uint4*)(xsrc + ((size_t)b * 512 + c) * L + k8 * 8);
  }
  __syncthreads();
  f32x4 acc[4][4];
#pragma unroll
  for (int a = 0; a < 4; ++a)
#pragma unroll
    for (int b = 0; b < 4; ++b) acc[a][b] = (f32x4){0.f, 0.f, 0.f, 0.f};
  const u16* Gp = G + (size_t)(order * 512 + c) * gs;
  size_t parstride = (size_t)1024 * gs;
  int bq = fr & 7, t1off = fr >> 3;
  int dmax = L >> 7;
  int base = (L >> 1) + 63 - fr + 8 * fq, par = base & 1;
  const u16* wp = Gp + par * parstride + (base - par);
  auto ldw = [&](int u) { bf16x8 r; uint32_t t4[4]; __builtin_memcpy(t4, (const uint32_t*)(wp + 16 * u), 16); __builtin_memcpy(&r, t4, 16); return r; };
  bf16x8 W[6], Nw[4];
  int t1lo = 2 * (half * 16 + w * 4);
  int dlo = max(-dmax, t1lo - (T1 - 1)), dhi = min(dmax, t1lo + 7);
#pragma unroll
  for (int j = 0; j < 6; ++j) W[j] = ldw(-4 * dlo - 3 + j);
#pragma unroll 1
  for (int d = dlo; d <= dhi; ++d) {
    if (d < dhi) {
#pragma unroll
      for (int j = 0; j < 4; ++j) Nw[j] = ldw(-4 * (d + 1) - 3 + j);
    }
#pragma unroll
    for (int n = 0; n < 4; ++n) {
      int Tn = half * 16 + w * 4 + n;
      int s1 = 2 * Tn + t1off - d;
      bool valid = (Tn < ntiles) && (s1 >= 0) && (s1 < T1);
      int s1c = valid ? s1 : 0;
#pragma unroll
      for (int ks = 0; ks < 2; ++ks) {
        bf16x8 bfrag = *(const bf16x8*)(Xs + bq * XS + s1c * 64 + 32 * ks + 8 * fq);
        if (!valid) bfrag = (bf16x8){0, 0, 0, 0, 0, 0, 0, 0};
#pragma unroll
        for (int m = 0; m < 4; ++m) acc[n][m] = __builtin_amdgcn_mfma_f32_16x16x32_bf16(W[3 - m + 2 * ks], bfrag, acc[n][m], 0, 0, 0);
      }
    }
    W[4] = W[0]; W[5] = W[1];
#pragma unroll
    for (int j = 0; j < 4; ++j) W[j] = Nw[j];
  }
  float skip = p.in[25][order * 512 + c];
#pragma unroll
  for (int n = 0; n < 4; ++n) {
    int Tn = half * 16 + w * 4 + n;
    if (Tn < ntiles) {
      int t1 = 2 * Tn + t1off;
#pragma unroll
      for (int m = 0; m < 4; ++m) {
        int t = 64 * t1 + 16 * m + 4 * fq;
        uint2 xin = *(const uint2*)(Xs + bq * XS + t);
        uint2 xm = *(const uint2*)(vx + ((size_t)((order + 1) * 8 + bq) * 512 + c) * L + t);
        float u0 = bf2f((u16)(xin.x & 0xffff)), u1 = bf2f((u16)(xin.x >> 16)), u2 = bf2f((u16)(xin.y & 0xffff)), u3 = bf2f((u16)(xin.y >> 16));
        float m0 = bf2f((u16)(xm.x & 0xffff)), m1 = bf2f((u16)(xm.x >> 16)), m2 = bf2f((u16)(xm.y & 0xffff)), m3 = bf2f((u16)(xm.y >> 16));
        float r0 = m0 * (acc[n][m][0] + skip * u0), r1 = m1 * (acc[n][m][1] + skip * u1);
        float r2 = m2 * (acc[n][m][2] + skip * u2), r3 = m3 * (acc[n][m][3] + skip * u3);
        {
          uint2 o; o.x = pack2(r0, r1); o.y = pack2(r2, r3);
          u16* dstz = (order == 0) ? z1w : (u16*)vx;
          *(uint2*)(dstz + ((size_t)bq * 512 + c) * L + t) = o;
        }
      }
    }
  }
  __syncthreads();
}

DEVI void hytr_item(const Params& p, int it, u16* sm) {
  int ci = it >> 3, c0 = (it & 7) * 64;
  int rowbase, t0, b, L; const u16* z2;
  if (ci < 512) { b = ci >> 6; rowbase = b * 4096; t0 = (ci & 63) * 64; L = 4096; z2 = (const u16*)(p.ws + O_VXL); }
  else { int cc = ci - 512; b = cc >> 2; rowbase = NL + b * 256; t0 = (cc & 3) * 64; L = 256; z2 = (const u16*)(p.ws + O_VXC); }
  int tid = TIDX;
  for (int i = tid; i < 64 * 8; i += 256) {
    int c = i >> 3, t8 = (i & 7) * 8;
    *(uint4*)(sm + c * 72 + t8) = *(const uint4*)(z2 + ((size_t)b * 512 + c0 + c) * L + t0 + t8);
  }
  __syncthreads();
  u16* Y = (u16*)(p.ws + O_HB);
  for (int i = tid; i < 64 * 8; i += 256) {
    int t = i >> 3, c8 = (i & 7) * 8;
    uint32_t o[4];
#pragma unroll
    for (int k = 0; k < 4; ++k) o[k] = (uint32_t)sm[(c8 + 2 * k) * 72 + t] | ((uint32_t)sm[(c8 + 2 * k + 1) * 72 + t] << 16);
    *(uint4*)(Y + (size_t)(rowbase + t0 + t) * 1024 + 512 + c0 + c8) = make_uint4(o[0], o[1], o[2], o[3]);
  }
  __syncthreads();
}

DEVI int blk_count(int c, int* cnts, int& flip) {
  for (int o = 32; o > 0; o >>= 1) c += __shfl_xor(c, o);
  int* s = cnts + (flip & 1) * 4;
  if ((TIDX & 63) == 0) s[TIDX >> 6] = c;
  __syncthreads();
  int tot = s[0] + s[1] + s[2] + s[3];
  flip ^= 1;
  return tot;
}

DEVI void topk_item(const Params& p, int it, int* smi) {
  int e = it & 15, seq = it >> 4;
  int n, cap, rowbase, slotbase, ept;
  if (seq < 8) { n = 4096; cap = 512; rowbase = seq * 4096; slotbase = seq * 512; ept = 16; }
  else { int b = seq - 8; n = 256; cap = 32; rowbase = NL + b * 256; slotbase = 4096 + b * 32; ept = 1; }
  const float* aff = (const float*)(p.ws + O_AFF);
  int* stok = (int*)(p.ws + O_STOK) + e * 4352 + slotbase;
  float* sgate = (float*)(p.ws + O_SGATE) + e * 4352 + slotbase;
  int* cnts = smi;
  int* wt = smi + 8;
  int tid = TIDX, flip = 0;
  uint32_t v[16];
#pragma unroll
  for (int j = 0; j < 16; ++j) v[j] = (j < ept) ? __float_as_uint(aff[(size_t)(rowbase + tid * ept + j) * 16 + e]) : 0u;
  uint32_t T = 0;
  for (int bit = 30; bit >= 0; --bit) {
    uint32_t cand = T | (1u << bit);
    int c = 0;
#pragma unroll
    for (int j = 0; j < 16; ++j) c += (j < ept && v[j] >= cand) ? 1 : 0;
    int tot = blk_count(c, cnts, flip);
    if (tot >= cap) T = cand;
  }
  int ngt = 0, neq = 0;
#pragma unroll
  for (int j = 0; j < 16; ++j) { if (j < ept) { ngt += (v[j] > T) ? 1 : 0; neq += (v[j] == T) ? 1 : 0; } }
  int cnt_gt = blk_count(ngt, cnts, flip);
  int need_eq = cap - cnt_gt;
  int comb = ngt | (neq << 16);
  int inc = comb;
  int lane = tid & 63, wv = tid >> 6;
  for (int o = 1; o < 64; o <<= 1) { int t = __shfl_up(inc, o); if (lane >= o) inc += t; }
  __syncthreads();
  if (lane == 63) wt[wv] = inc;
  __syncthreads();
  int pre = 0;
  for (int q = 0; q < wv; ++q) pre += wt[q];
  int ex = pre + inc - comb;
  int pg = ex & 0xffff, pe = ex >> 16;
#pragma unroll
  for (int j = 0; j < 16; ++j) {
    if (j < ept) {
      int slot = -1;
      if (v[j] > T) slot = pg++;
      else if (v[j] == T) { if (pe < need_eq) slot = cnt_gt + pe; pe++; }
      if (slot >= 0) { stok[slot] = rowbase + tid * ept + j; sgate[slot] = __uint_as_float(v[j]); }
      ((int*)(p.ws + O_INV))[(size_t)(rowbase + tid * ept + j) * 16 + e] = (slot >= 0) ? (slotbase + slot) : -1;
    }
  }
  __syncthreads();
}

DEVI void ph_moe_up(const Params& p, u16* sm, int mtl) {
  const u16* Hn = (const u16*)(p.ws + O_HB);
  const u16* Wg = (const u16*)(p.ws + O_WEXP);
  u16* Act = (u16*)(p.ws + O_U);
  const int* stok = (const int*)(p.ws + O_STOK);
  int nitems = 16 * 12 * mtl;
  int tid = TIDX, lane = tid & 63, wid = tid >> 6, wr = wid >> 1, wc = wid & 1, fr = lane & 15, fq = lane >> 4;
  int lr = tid >> 3, kc = (tid & 7) * 8;
  for (int it = vbid(); it < nitems; it += gridDim.x) {
    int e = it / (12 * mtl), rem = it % (12 * mtl);
    int fg = rem / (4 * mtl), r2 = rem % (4 * mtl);
    int f0 = (fg * 4 + (r2 & 3)) * 128, m0 = (r2 >> 2) * 128;
    uint32_t pa[4], pb0 = (uint32_t)(e * 1536 + f0 + lr) * 1024u + kc;
#pragma unroll
    for (int i = 0; i < 4; ++i) {
      int tok = stok[e * 4352 + m0 + lr + 32 * i];
      pa[i] = (uint32_t)tok * 1024u + kc;
    }
    f32x4 acc[8][4];
    gemm_core<true>(sm, Hn, pa, 0u, Wg, pb0, 0u, 1024, acc);
#pragma unroll
    for (int m = 0; m < 4; ++m) {
      int slot = m0 + wr * 64 + m * 16 + fr;
#pragma unroll
      for (int n = 0; n < 4; ++n) {
        int f = f0 + wc * 64 + n * 16 + fq * 4;
        float v0 = siluf(acc[n][m][0]) * acc[n + 4][m][0], v1 = siluf(acc[n][m][1]) * acc[n + 4][m][1];
        float v2 = siluf(acc[n][m][2]) * acc[n + 4][m][2], v3 = siluf(acc[n][m][3]) * acc[n + 4][m][3];
        uint2 o; o.x = pack2(v0, v1); o.y = pack2(v2, v3);
        *(uint2*)(Act + ((size_t)e * 4352 + slot) * 1536 + f) = o;
      }
    }
  }
}

DEVI void ph_moe_down(const Params& p, u16* sm, int layer, int mtl) {
  const u16* Act = (const u16*)(p.ws + O_U);
  const u16* Wd = (const u16*)(p.ws + O_WEXP) + 2 * EXPSZ;
  const int* stok = (const int*)(p.ws + O_STOK);
  const float* sgate = (const float*)(p.ws + O_SGATE);
  const float* mod = (const float*)(p.ws + O_MOD) + (size_t)layer * 9 * 6144 + 5 * 1024;
  int nitems = 16 * 4 * mtl;
  int tid = TIDX, lane = tid & 63, wid = tid >> 6, wr = wid >> 1, wc = wid & 1, fr = lane & 15, fq = lane >> 4;
  int lr = tid >> 3, kc = (tid & 7) * 8;
  for (int it = vbid(); it < nitems; it += gridDim.x) {
    int e = it / (4 * mtl), rem = it % (4 * mtl);
    int n0 = (rem & 3) * 256, m0 = (rem >> 2) * 128;
    uint32_t pa[4], pb0 = (uint32_t)(e * 1024 + n0 + lr) * 1536u + kc;
#pragma unroll
    for (int i = 0; i < 4; ++i) pa[i] = (uint32_t)(e * 4352 + m0 + lr + 32 * i) * 1536u + kc;
    f32x4 acc[8][4];
    gemm_core<false>(sm, Act, pa, 1536u, Wd, pb0, 1536u, 1536, acc);
#pragma unroll
    for (int m = 0; m < 4; ++m) {
      int slot = m0 + wr * 64 + m * 16 + fr;
      int tok = stok[e * 4352 + slot];
      float gt = sgate[e * 4352 + slot];
      int mr = (tok < NL) ? (tok >> 12) : 8;
      const float* gl = mod + (size_t)mr * 6144;
      u16* dst = (u16*)(p.ws + O_OUTB) + ((size_t)e * 4352 + slot) * 1024;
#pragma unroll
      for (int n = 0; n < 8; ++n) {
        int col = n0 + wc * 128 + n * 16 + fq * 4;
        float4 gv = *(const float4*)(gl + col);
        uint2 o; o.x = pack2(acc[n][m][0] * gt * gv.x, acc[n][m][1] * gt * gv.y); o.y = pack2(acc[n][m][2] * gt * gv.z, acc[n][m][3] * gt * gv.w);
        *(uint2*)(dst + col) = o;
      }
    }
  }
}

DEVI void ph_final(const Params& p) {
  int lane = TIDX & 63, wave = TIDX >> 6;
  const float* g = p.in[43];
  for (int r = blockIdx.x * 4 + wave; r < NL; r += gridDim.x * 4) {
    float* row = p.out + (size_t)r * 1024;
    float4 v[4]; float ss = 0.f;
#pragma unroll
    for (int i = 0; i < 4; ++i) v[i] = *(const float4*)(row + lane * 4 + 256 * i);
    moe_combine(p, r, lane, v);
#pragma unroll
    for (int i = 0; i < 4; ++i) ss += v[i].x * v[i].x + v[i].y * v[i].y + v[i].z * v[i].z + v[i].w * v[i].w;
    ss = wsum(ss);
    float rs = rsqrtf(ss * (1.f / 1024.f) + 1e-6f);
#pragma unroll
    for (int i = 0; i < 4; ++i) {
      float4 gg = *(const float4*)(g + lane * 4 + 256 * i);
      *(float4*)(row + lane * 4 + 256 * i) = make_float4(v[i].x * rs * gg.x, v[i].y * rs * gg.y, v[i].z * rs * gg.z, v[i].w * rs * gg.w);
    }
  }
}
constexpr size_t O_SB = O_VXL;
constexpr size_t O_S5H = O_FRAWL;
constexpr size_t O_HDEC = O_S5H + AL(512ull * 68 * 64 * 8);
static_assert(O_SB + 4352ull * 16384 * 2 <= O_HYEND, "sb");
static_assert(O_HDEC + 4352ull * 128 * 4 <= O_Y5F, "hdec");

DEVI size_t seq_row(int s, int b, int dir) {
  if (s < 256) return (size_t)NL + b * 256 + (dir ? 255 - s : s);
  int q = s - 256;
  return (size_t)b * 4096 + (dir ? 4095 - q : q);
}
DEVI float hg_lb_val(const Params& p, int ch) {
  float l0 = p.in[27][ch], l1 = p.in[27][512 + ch];
  float mx = fmaxf(l0, l1), e0 = expf(l0 - mx), e1 = expf(l1 - mx);
  return fminf(fmaxf(e1 / (e0 + e1), 0.f), 1.f - 1e-4f);
}
DEVI void hgrnA_item(const Params& p, int it, unsigned char* smem) {
  int seq = it / 68, c = it % 68;
  int b = seq >> 3, h = (seq >> 1) & 3, dir = seq & 1;
  float* G = (float*)smem;
  u16* KdT = (u16*)(smem + 33280);
  u16* VT = (u16*)(smem + 51712);
  float* lbs = (float*)(smem + 70144);
  int tid = TIDX, lane = tid & 63, w = tid >> 6, fr = lane & 15, fq = lane >> 4;
  if (tid < 128) lbs[tid] = hg_lb_val(p, h * 128 + tid);
  __syncthreads();
  const u16* U = (const u16*)(p.ws + O_U);
  int i = tid >> 2, part = tid & 3;
  const u16* ur = U + seq_row(c * 64 + i, b, dir) * 3072;
  {
    const uint4* src = (const uint4*)(ur + dir * 512 + h * 128 + part * 32);
    const uint4* srv = (const uint4*)(ur + 1024 + h * 128 + part * 32);
#pragma unroll
    for (int q4 = 0; q4 < 4; ++q4) {
      uint4 x = src[q4], y = srv[q4];
      float fv[8]; unpack8(x, fv);
      uint32_t yw[4] = {y.x, y.y, y.z, y.w};
#pragma unroll
      for (int k = 0; k < 8; ++k) {
        int d = part * 32 + q4 * 8 + k;
        float lb = lbs[d];
        G[i * 129 + d] = __logf(lb + (1.f - lb) * sigm(fv[k]));
        VT[d * 72 + i] = (u16)((k & 1) ? (yw[k >> 1] >> 16) : (yw[k >> 1] & 0xffff));
      }
    }
  }
  __syncthreads();
  if (tid < 128) { float a = 0.f; for (int ii = 0; ii < 64; ++ii) { a += G[ii * 129 + tid]; G[ii * 129 + tid] = a; } }
  __syncthreads();
#pragma unroll 8
  for (int k = 0; k < 32; ++k) {
    int d = part * 32 + k;
    float bc = G[i * 129 + d], bp = (i > 0) ? G[(i - 1) * 129 + d] : 0.f, bl = G[63 * 129 + d];
    float f = __expf(bc - bp);
    KdT[d * 72 + i] = f2bf((1.f - f) * __expf(bl - bc));
  }
  if (tid < 128) ((float*)(p.ws + O_HDEC))[(size_t)it * 128 + tid] = __expf(G[63 * 129 + tid]);
  __syncthreads();
  f32x4 acc[2][8];
#pragma unroll
  for (int m = 0; m < 2; ++m)
#pragma unroll
    for (int n = 0; n < 8; ++n) acc[m][n] = (f32x4){0.f, 0.f, 0.f, 0.f};
#pragma unroll
  for (int ks = 0; ks < 2; ++ks) {
    bf16x8 af[2];
#pragma unroll
    for (int m = 0; m < 2; ++m) af[m] = *(const bf16x8*)(KdT + ((2 * w + m) * 16 + fr) * 72 + ks * 32 + fq * 8);
#pragma unroll
    for (int n = 0; n < 8; ++n) {
      bf16x8 bv = *(const bf16x8*)(VT + (n * 16 + fr) * 72 + ks * 32 + fq * 8);
#pragma unroll
      for (int m = 0; m < 2; ++m) acc[m][n] = __builtin_amdgcn_mfma_f32_16x16x32_bf16(af[m], bv, acc[m][n], 0, 0, 0);
    }
  }
  u16* SB = (u16*)(p.ws + O_SB) + (size_t)it * 16384;
#pragma unroll
  for (int m = 0; m < 2; ++m)
#pragma unroll
    for (int n = 0; n < 8; ++n) {
      uint2 o; o.x = pack2(acc[m][n][0], acc[m][n][1]); o.y = pack2(acc[m][n][2], acc[m][n][3]);
      *(uint2*)(SB + (n * 16 + fr) * 128 + (2 * w + m) * 16 + 4 * fq) = o;
    }
  __syncthreads();
}

DEVI void hgrnB_item(const Params& p, int it) {
  int gt = it * 256 + TIDX;
  int seq = gt >> 11, idx = (gt & 2047) * 8, d0 = idx & 127;
  u16* SB = (u16*)(p.ws + O_SB) + (size_t)seq * 68 * 16384 + idx;
  const float* DEC = (const float*)(p.ws + O_HDEC) + (size_t)seq * 68 * 128 + d0;
  float carry[8];
#pragma unroll
  for (int k = 0; k < 8; ++k) carry[k] = 0.f;
#pragma unroll 1
  for (int cb = 0; cb < 68; cb += 4) {
    uint4 kvq[4]; float4 da[4], db[4];
#pragma unroll
    for (int q = 0; q < 4; ++q) {
      kvq[q] = *(const uint4*)(SB + (size_t)(cb + q) * 16384);
      da[q] = *(const float4*)(DEC + (cb + q) * 128); db[q] = *(const float4*)(DEC + (cb + q) * 128 + 4);
    }
#pragma unroll
    for (int q = 0; q < 4; ++q) {
      float kv[8]; unpack8(kvq[q], kv);
      float dd[8] = {da[q].x, da[q].y, da[q].z, da[q].w, db[q].x, db[q].y, db[q].z, db[q].w};
      uint4 o;
      o.x = pack2(carry[0], carry[1]); o.y = pack2(carry[2], carry[3]); o.z = pack2(carry[4], carry[5]); o.w = pack2(carry[6], carry[7]);
      *(uint4*)(SB + (size_t)(cb + q) * 16384) = o;
#pragma unroll
      for (int k = 0; k < 8; ++k) carry[k] = dd[k] * carry[k] + kv[k];
    }
  }
}

DEVI void hgrnC_item(const Params& p, int it, unsigned char* smem) {
  int pb = it & 63, h = (it >> 6) & 3, b = it >> 8;
  u16* Qs = (u16*)smem;
  u16* Kt = (u16*)(smem + 17408);
  float* G = (float*)(smem + 34816);
  u16* VT = (u16*)(smem + 34816);
  u16* At = (u16*)(smem + 34816 + 18432);
  float* lbs = (float*)(smem + 68096);
  float* ssum = lbs + 128;
  int tid = TIDX, lane = tid & 63, w = tid >> 6, fr = lane & 15, fq = lane >> 4;
  if (tid < 128) lbs[tid] = hg_lb_val(p, h * 128 + tid);
  __syncthreads();
  const u16* U = (const u16*)(p.ws + O_U);
  size_t row0 = (size_t)b * 4096 + pb * 64;
  int i = tid >> 2, part = tid & 3;
  const u16* ur = U + (row0 + i) * 3072;
  f32x4 o[4][2];
#pragma unroll
  for (int m = 0; m < 4; ++m)
#pragma unroll
    for (int n = 0; n < 2; ++n) o[m][n] = (f32x4){0.f, 0.f, 0.f, 0.f};
#pragma unroll 1
  for (int dir = 0; dir < 2; ++dir) {
    {
      const uint4* src = (const uint4*)(ur + dir * 512 + h * 128 + part * 32);
#pragma unroll
      for (int q4 = 0; q4 < 4; ++q4) {
        float fv[8]; unpack8(src[q4], fv);
#pragma unroll
        for (int k = 0; k < 8; ++k) { int d = part * 32 + q4 * 8 + k; float lb = lbs[d]; G[i * 129 + d] = __logf(lb + (1.f - lb) * sigm(fv[k])); }
      }
    }
    __syncthreads();
    if (tid < 128) {
      float a = 0.f;
      if (dir == 0) { for (int ii = 0; ii < 64; ++ii) { a += G[ii * 129 + tid]; G[ii * 129 + tid] = a; } }
      else { for (int ii = 63; ii >= 0; --ii) { a += G[ii * 129 + tid]; G[ii * 129 + tid] = a; } }
    }
    __syncthreads();
    {
      const uint4* srq = (const uint4*)(ur + 2048 + h * 128 + part * 32);
      int ip = (dir == 0) ? i - 1 : i + 1;
      bool edge = (dir == 0) ? (i == 0) : (i == 63);
#pragma unroll
      for (int q4 = 0; q4 < 4; ++q4) {
        float qv[8]; unpack8(srq[q4], qv);
        uint32_t qo[4], ko[4];
#pragma unroll
        for (int k2 = 0; k2 < 4; ++k2) {
          float qq[2], kk[2];
#pragma unroll
          for (int z = 0; z < 2; ++z) {
            int d = part * 32 + q4 * 8 + k2 * 2 + z;
            float bc = G[i * 129 + d], bp = edge ? 0.f : G[ip * 129 + d];
            float f = __expf(bc - bp);
            qq[z] = siluf(qv[k2 * 2 + z]) * __expf(bc);
            kk[z] = (1.f - f) * __expf(-bc);
          }
          qo[k2] = pack2(qq[0], qq[1]); ko[k2] = pack2(kk[0], kk[1]);
        }
        *(uint4*)(Qs + i * 136 + part * 32 + q4 * 8) = make_uint4(qo[0], qo[1], qo[2], qo[3]);
        *(uint4*)(Kt + i * 136 + part * 32 + q4 * 8) = make_uint4(ko[0], ko[1], ko[2], ko[3]);
      }
    }
    __syncthreads();
    {
      const uint4* srv = (const uint4*)(ur + 1024 + h * 128 + part * 32);
#pragma unroll
      for (int q4 = 0; q4 < 4; ++q4) {
        uint4 y = srv[q4];
        uint32_t yw[4] = {y.x, y.y, y.z, y.w};
#pragma unroll
        for (int k = 0; k < 8; ++k) VT[(part * 32 + q4 * 8 + k) * 72 + i] = (u16)((k & 1) ? (yw[k >> 1] >> 16) : (yw[k >> 1] & 0xffff));
      }
    }
    int seq = (b * 4 + h) * 2 + dir, c = 4 + (dir ? 63 - pb : pb);
    const u16* SB = (const u16*)(p.ws + O_SB) + ((size_t)seq * 68 + c) * 16384;
#pragma unroll
    for (int ks = 0; ks < 4; ++ks) {
      bf16x8 sf[2];
#pragma unroll
      for (int n = 0; n < 2; ++n) sf[n] = *(const bf16x8*)(SB + ((2 * w + n) * 16 + fr) * 128 + ks * 32 + fq * 8);
#pragma unroll
      for (int m = 0; m < 4; ++m) {
        bf16x8 qf = *(const bf16x8*)(Qs + (m * 16 + fr) * 136 + ks * 32 + fq * 8);
#pragma unroll
        for (int n = 0; n < 2; ++n) o[m][n] = __builtin_amdgcn_mfma_f32_16x16x32_bf16(qf, sf[n], o[m][n], 0, 0, 0);
      }
    }
    {
      f32x4 at[4];
#pragma unroll
      for (int m = 0; m < 4; ++m) at[m] = (f32x4){0.f, 0.f, 0.f, 0.f};
#pragma unroll
      for (int ks = 0; ks < 4; ++ks) {
        bf16x8 kf = *(const bf16x8*)(Kt + (w * 16 + fr) * 136 + ks * 32 + fq * 8);
#pragma unroll
        for (int m = 0; m < 4; ++m) {
          bf16x8 qf = *(const bf16x8*)(Qs + (m * 16 + fr) * 136 + ks * 32 + fq * 8);
          at[m] = __builtin_amdgcn_mfma_f32_16x16x32_bf16(kf, qf, at[m], 0, 0, 0);
        }
      }
#pragma unroll
      for (int m = 0; m < 4; ++m) {
        int ii = m * 16 + fr, j0 = w * 16 + 4 * fq;
        float a4[4];
#pragma unroll
        for (int r = 0; r < 4; ++r) { int j = j0 + r; bool keep = (dir == 0) ? (j <= ii) : (j >= ii); a4[r] = keep ? at[m][r] : 0.f; }
        uint2 ov; ov.x = pack2(a4[0], a4[1]); ov.y = pack2(a4[2], a4[3]);
        *(uint2*)(At + ii * 72 + j0) = ov;
      }
    }
    __syncthreads();
#pragma unroll
    for (int ks = 0; ks < 2; ++ks) {
      bf16x8 vf[2];
#pragma unroll
      for (int n = 0; n < 2; ++n) vf[n] = *(const bf16x8*)(VT + ((2 * w + n) * 16 + fr) * 72 + ks * 32 + fq * 8);
#pragma unroll
      for (int m = 0; m < 4; ++m) {
        bf16x8 af = *(const bf16x8*)(At + (m * 16 + fr) * 72 + ks * 32 + fq * 8);
#pragma unroll
        for (int n = 0; n < 2; ++n) o[m][n] = __builtin_amdgcn_mfma_f32_16x16x32_bf16(af, vf[n], o[m][n], 0, 0, 0);
      }
    }
    __syncthreads();
  }
#pragma unroll
  for (int m = 0; m < 4; ++m)
#pragma unroll
    for (int r = 0; r < 4; ++r) {
      float s = o[m][0][r] * o[m][0][r] + o[m][1][r] * o[m][1][r];
      s += __shfl_xor(s, 1); s += __shfl_xor(s, 2); s += __shfl_xor(s, 4); s += __shfl_xor(s, 8);
      if (fr == 0) ssum[w * 64 + m * 16 + 4 * fq + r] = s;
    }
  __syncthreads();
  u16* Ym = (u16*)(p.ws + O_HB);
#pragma unroll
  for (int m = 0; m < 4; ++m)
#pragma unroll
    for (int r = 0; r < 4; ++r) {
      int ii = m * 16 + 4 * fq + r;
      float tot = ssum[ii] + ssum[64 + ii] + ssum[128 + ii] + ssum[192 + ii];
      float rs = rsqrtf(tot * (1.f / 128.f) + 1e-6f);
      size_t row = row0 + ii;
#pragma unroll
      for (int n = 0; n < 2; ++n) {
        int e = (2 * w + n) * 16 + fr;
        float g = bf2f(U[row * 3072 + 2560 + h * 128 + e]);
        Ym[row * 1024 + h * 128 + e] = f2bf(o[m][n][r] * rs * p.in[28][e] * siluf(g));
      }
    }
  __syncthreads();
}

DEVI void wave_lds_sync() { __builtin_amdgcn_fence(__ATOMIC_RELEASE, "wavefront"); __builtin_amdgcn_wave_barrier(); __builtin_amdgcn_fence(__ATOMIC_ACQUIRE, "wavefront"); }

DEVI void s5_wave(const Params& p, int sq, int c, int mode, float* wsm) {
  int dir = sq & 1, g = (sq >> 1) & 31, b = sq >> 6;
  int lane = TIDX & 63;
  const u16* U = (const u16*)(p.ws + O_U);
  u16* Yo = (u16*)(p.ws + (dir ? O_Y5B : O_Y5F));
  float2* HS = (float2*)(p.ws + O_S5H) + ((size_t)sq * 68 + c) * 64;
  float* Cre = wsm;
  float* Cim = wsm + 1024;
  float* Hre = wsm + 2048;
  float* Him = Hre + 8 * 68;
  if (mode == 1) { for (int i = lane; i < 1024; i += 64) { Cre[i] = p.in[34][(size_t)g * 1024 + i]; Cim[i] = p.in[35][(size_t)g * 1024 + i]; } }
  float lre = fminf(p.in[29][(dir * 32 + g) * 64 + lane], -1e-4f), lim = p.in[30][(dir * 32 + g) * 64 + lane];
  float dt = expf(p.in[31][dir * 32 + g]);
  float mag = expf(lre * dt), lbr = mag * cosf(lim * dt), lbi = mag * sinf(lim * dt);
  float xr = lbr - 1.f, xi = lbi, den = 1.f / (lre * lre + lim * lim);
  float cr = (xr * lre + xi * lim) * den, ci = (xi * lre - xr * lim) * den;
  float Br[16], Bi[16];
#pragma unroll
  for (int q = 0; q < 16; ++q) {
    float br = p.in[32][((size_t)g * 64 + lane) * 16 + q], bi = p.in[33][((size_t)g * 64 + lane) * 16 + q];
    Br[q] = cr * br - ci * bi; Bi[q] = cr * bi + ci * br;
  }
  float hr = 0.f, hi = 0.f;
  if (mode == 1) { float2 h0 = HS[lane]; hr = h0.x; hi = h0.y; }
  wave_lds_sync();
  for (int s0 = c * 64; s0 < c * 64 + 64; s0 += 8) {
#pragma unroll
    for (int s8 = 0; s8 < 8; ++s8) {
      size_t row = seq_row(s0 + s8, b, dir);
      const uint4* up = (const uint4*)(U + row * 3072 + 1536 + g * 16);
      float ua[8], ub[8]; unpack8(up[0], ua); unpack8(up[1], ub);
      float bur = 0.f, bui = 0.f;
#pragma unroll
      for (int q = 0; q < 8; ++q) { bur += Br[q] * ua[q] + Br[8 + q] * ub[q]; bui += Bi[q] * ua[q] + Bi[8 + q] * ub[q]; }
      float nr = lbr * hr - lbi * hi + bur, ni = lbr * hi + lbi * hr + bui;
      hr = nr; hi = ni;
      if (mode == 1) { Hre[s8 * 68 + lane] = hr; Him[s8 * 68 + lane] = hi; }
    }
    if (mode == 1) {
      wave_lds_sync();
      int s8 = lane >> 3, hp = lane & 7;
      float y0 = 0.f, y1 = 0.f;
#pragma unroll
      for (int p4 = 0; p4 < 16; ++p4) {
        float4 a = *(const float4*)(Hre + s8 * 68 + p4 * 4), bq = *(const float4*)(Him + s8 * 68 + p4 * 4);
        float4 c0 = *(const float4*)(Cre + (hp * 2) * 64 + p4 * 4), d0 = *(const float4*)(Cim + (hp * 2) * 64 + p4 * 4);
        float4 c1 = *(const float4*)(Cre + (hp * 2 + 1) * 64 + p4 * 4), d1 = *(const float4*)(Cim + (hp * 2 + 1) * 64 + p4 * 4);
        y0 += a.x * c0.x - bq.x * d0.x + a.y * c0.y - bq.y * d0.y + a.z * c0.z - bq.z * d0.z + a.w * c0.w - bq.w * d0.w;
        y1 += a.x * c1.x - bq.x * d1.x + a.y * c1.y - bq.y * d1.y + a.z * c1.z - bq.z * d1.z + a.w * c1.w - bq.w * d1.w;
      }
      size_t row = seq_row(s0 + s8, b, dir);
      *(uint32_t*)(Yo + row * 512 + g * 16 + hp * 2) = pack2(y0, y1);
      wave_lds_sync();
    }
  }
  if (mode == 0) HS[lane] = make_float2(hr, hi);
}

DEVI void s5B_item(const Params& p, int it) {
  int gt = it * 256 + TIDX;
  int sq = gt >> 6, lane = gt & 63;
  int dir = sq & 1, g = (sq >> 1) & 31;
  float lre = fminf(p.in[29][(dir * 32 + g) * 64 + lane], -1e-4f), lim = p.in[30][(dir * 32 + g) * 64 + lane];
  float dt = expf(p.in[31][dir * 32 + g]);
  float mag = expf(lre * dt), ar = mag * cosf(lim * dt), ai = mag * sinf(lim * dt);
#pragma unroll
  for (int k = 0; k < 6; ++k) { float nr = ar * ar - ai * ai, ni = 2.f * ar * ai; ar = nr; ai = ni; }
  float2* HS = (float2*)(p.ws + O_S5H) + (size_t)sq * 68 * 64 + lane;
  float cr = 0.f, ci = 0.f;
#pragma unroll 1
  for (int cb = 0; cb < 68; cb += 17) {
    float2 v[17];
#pragma unroll
    for (int q = 0; q < 17; ++q) v[q] = HS[(cb + q) * 64];
#pragma unroll
    for (int q = 0; q < 17; ++q) {
      HS[(cb + q) * 64] = make_float2(cr, ci);
      float nr = ar * cr - ai * ci + v[q].x, ni = ar * ci + ai * cr + v[q].y;
      cr = nr; ci = ni;
    }
  }
}

DEVI void ph_l1_finalize(const Params& p) {
  int lane = TIDX & 63, wave = TIDX >> 6;
  const u16* U = (const u16*)(p.ws + O_U);
  const u16* Yf = (const u16*)(p.ws + O_Y5F); const u16* Yb = (const u16*)(p.ws + O_Y5B);
  u16* Y5 = (u16*)(p.ws + O_Y5);
  int ch = lane * 8;
  for (int r = blockIdx.x * 4 + wave; r < NL; r += gridDim.x * 4) {
    size_t ro = (size_t)r;
    float a[8], bb[8], uu[8];
    unpack8(*(const uint4*)(Yf + ro * 512 + ch), a); unpack8(*(const uint4*)(Yb + ro * 512 + ch), bb); unpack8(*(const uint4*)(U + ro * 3072 + 1536 + ch), uu);
    uint32_t ow[4];
#pragma unroll
    for (int q = 0; q < 4; ++q) {
      float y0 = a[2 * q] + bb[2 * q] + uu[2 * q] * p.in[36][ch + 2 * q];
      float y1 = a[2 * q + 1] + bb[2 * q + 1] + uu[2 * q + 1] * p.in[36][ch + 2 * q + 1];
      ow[q] = pack2(geluf(y0), geluf(y1));
    }
    *(uint4*)(Y5 + ro * 512 + ch) = make_uint4(ow[0], ow[1], ow[2], ow[3]);
  }
}
constexpr size_t O_POW = O_END1;
constexpr size_t O_BP = O_POW + AL(64ull * 65 * 64 * 8);
constexpr size_t O_KT = O_BP + AL(64ull * 64 * 16 * 8);
constexpr size_t O_WST = O_KT + AL(64ull * 65 * 256 * 2);
constexpr size_t O_WB = O_WST + AL(64ull * 64 * 16 * 128 * 2);
constexpr size_t O_END2 = O_WB + AL(64ull * 128 * 1024 * 2);
constexpr size_t O_BAR = O_END2;
static_assert(O_BAR + 16384 < 800000000ull, "workspace budget");

DEVI void s5pow_item(const Params& p, int it) {
  int gt = it * 256 + TIDX;
  int gd = gt >> 6, lane = gt & 63, g = gd >> 1, dir = gd & 1;
  float lre = fminf(p.in[29][(dir * 32 + g) * 64 + lane], -1e-4f), lim = p.in[30][(dir * 32 + g) * 64 + lane];
  float dt = expf(p.in[31][dir * 32 + g]);
  float mag = expf(lre * dt), lbr = mag * cosf(lim * dt), lbi = mag * sinf(lim * dt);
  float xr = lbr - 1.f, xi = lbi, den = 1.f / (lre * lre + lim * lim);
  float cr = (xr * lre + xi * lim) * den, ci = (xi * lre - xr * lim) * den;
  float2* POW = (float2*)(p.ws + O_POW) + (size_t)gd * 65 * 64 + lane;
  float pr = 1.f, pi = 0.f;
  for (int t = 0; t < 65; ++t) { POW[t * 64] = make_float2(pr, pi); float nr = pr * lbr - pi * lbi, ni = pr * lbi + pi * lbr; pr = nr; pi = ni; }
  float2* BP = (float2*)(p.ws + O_BP) + ((size_t)gd * 64 + lane) * 16;
  for (int q = 0; q < 16; ++q) {
    float br = p.in[32][((size_t)g * 64 + lane) * 16 + q], bi = p.in[33][((size_t)g * 64 + lane) * 16 + q];
    BP[q] = make_float2(cr * br - ci * bi, cr * bi + ci * br);
  }
}

DEVI void s5tab_item(const Params& p, int it) {
  const float2* POWa = (const float2*)(p.ws + O_POW);
  const float2* BPa = (const float2*)(p.ws + O_BP);
  int tid = TIDX;
  if (it < 576) {
    int gd = it / 9, t8 = it % 9, g = gd >> 1;
    int hh = tid >> 4, hp = tid & 15;
    const float2* POW = POWa + (size_t)gd * 65 * 64;
    const float2* BP = BPa + (size_t)gd * 64 * 16;
    const float* Cr = p.in[34] + ((size_t)g * 16 + hh) * 64; const float* Ci = p.in[35] + ((size_t)g * 16 + hh) * 64;
    u16* KT = (u16*)(p.ws + O_KT) + (size_t)gd * 65 * 256;
    for (int ts = t8 * 8; ts < t8 * 8 + 8 && ts < 65; ++ts) {
      float acc = 0.f;
      if (ts >= 1) {
        for (int pp = 0; pp < 64; ++pp) {
          float2 P = POW[(ts - 1) * 64 + pp], B = BP[pp * 16 + hp];
          float c_r = Cr[pp], c_i = Ci[pp];
          float cpr = c_r * P.x - c_i * P.y, cpi = c_r * P.y + c_i * P.x;
          acc += cpr * B.x - cpi * B.y;
        }
      }
      KT[ts * 256 + hh * 16 + hp] = f2bf(acc);
    }
  } else if (it < 576 + 512) {
    int j = it - 576, gd = j >> 3, i8 = j & 7, g = gd >> 1;
    int hh = tid >> 4, kq = (tid & 15) * 8, p0 = kq >> 1;
    const float2* POW = POWa + (size_t)gd * 65 * 64;
    u16* WS = (u16*)(p.ws + O_WST) + (size_t)gd * 64 * 16 * 128;
    for (int ii = 0; ii < 8; ++ii) {
      int i = i8 * 8 + ii;
      float v[8];
#pragma unroll
      for (int pp = 0; pp < 4; ++pp) {
        int pq = p0 + pp;
        float2 P = POW[(i + 1) * 64 + pq];
        float c_r = p.in[34][((size_t)g * 16 + hh) * 64 + pq], c_i = p.in[35][((size_t)g * 16 + hh) * 64 + pq];
        v[2 * pp] = c_r * P.x - c_i * P.y; v[2 * pp + 1] = -(c_r * P.y + c_i * P.x);
      }
      *(uint4*)(WS + ((size_t)i * 16 + hh) * 128 + kq) = make_uint4(pack2(v[0], v[1]), pack2(v[2], v[3]), pack2(v[4], v[5]), pack2(v[6], v[7]));
    }
  } else {
    int j = it - 1088, gd = j >> 3, p8 = j & 7;
    int jj = tid >> 2, hq = tid & 3;
    const float2* POW = POWa + (size_t)gd * 65 * 64;
    const float2* BP = BPa + (size_t)gd * 64 * 16;
    u16* WB = (u16*)(p.ws + O_WB) + (size_t)gd * 128 * 1024;
    for (int pp = 0; pp < 8; ++pp) {
      int pq = p8 * 8 + pp;
      float2 P = POW[(63 - jj) * 64 + pq];
      float re[4], im[4];
#pragma unroll
      for (int h4 = 0; h4 < 4; ++h4) { float2 B = BP[pq * 16 + hq * 4 + h4]; re[h4] = P.x * B.x - P.y * B.y; im[h4] = P.x * B.y + P.y * B.x; }
      *(uint2*)(WB + (size_t)(2 * pq) * 1024 + jj * 16 + hq * 4) = make_uint2(pack2(re[0], re[1]), pack2(re[2], re[3]));
      *(uint2*)(WB + (size_t)(2 * pq + 1) * 1024 + jj * 16 + hq * 4) = make_uint2(pack2(im[0], im[1]), pack2(im[2], im[3]));
    }
  }
}

DEVI void s5A_mfma_item(const Params& p, int it) {
  int gd = it / 34, nt = it % 34, g = gd >> 1, dir = gd & 1;
  int lane = TIDX & 63, w = TIDX >> 6, fr = lane & 15, fq = lane >> 4;
  int col = nt * 16 + fr, b = col / 68, chunk = col % 68;
  const u16* U = (const u16*)(p.ws + O_U);
  const u16* WB = (const u16*)(p.ws + O_WB) + (size_t)gd * 128 * 1024;
  f32x4 acc[2] = {(f32x4){0.f, 0.f, 0.f, 0.f}, (f32x4){0.f, 0.f, 0.f, 0.f}};
#pragma unroll 8
  for (int js = 0; js < 32; ++js) {
    int j = 2 * js + (fq >> 1);
    size_t row = seq_row(chunk * 64 + j, b, dir);
    bf16x8 bfrag = *(const bf16x8*)(U + row * 3072 + 1536 + g * 16 + (fq & 1) * 8);
#pragma unroll
    for (int m = 0; m < 2; ++m) {
      bf16x8 afrag = *(const bf16x8*)(WB + (size_t)((2 * w + m) * 16 + fr) * 1024 + js * 32 + fq * 8);
      acc[m] = __builtin_amdgcn_mfma_f32_16x16x32_bf16(afrag, bfrag, acc[m], 0, 0, 0);
    }
  }
  int sq = b * 64 + gd;
  float* HSf = (float*)(p.ws + O_S5H) + ((size_t)sq * 68 + chunk) * 128;
#pragma unroll
  for (int m = 0; m < 2; ++m) *(float4*)(HSf + (2 * w + m) * 16 + 4 * fq) = make_float4(acc[m][0], acc[m][1], acc[m][2], acc[m][3]);
}

DEVI void s5C_mfma_item(const Params& p, int it, u16* KTl) {
  int gd = it >> 3, ng = it & 7, g = gd >> 1, dir = gd & 1;
  int tid = TIDX, lane = tid & 63, w = tid >> 6, fr = lane & 15, fq = lane >> 4;
  {
    const uint4* src = (const uint4*)((const u16*)(p.ws + O_KT) + (size_t)gd * 65 * 256);
    for (int i = tid; i < 2080; i += 256) ((uint4*)KTl)[i] = src[i];
  }
  __syncthreads();
  int col = (ng * 4 + w) * 16 + fr, b = col >> 6, chunk = 4 + (col & 63);
  const u16* U = (const u16*)(p.ws + O_U);
  u16* Yo = (u16*)(p.ws + (dir ? O_Y5B : O_Y5F));
  bf16x8 ub[32];
#pragma unroll
  for (int js = 0; js < 32; ++js) {
    size_t row = seq_row(chunk * 64 + 2 * js + (fq >> 1), b, dir);
    ub[js] = *(const bf16x8*)(U + row * 3072 + 1536 + g * 16 + (fq & 1) * 8);
  }
  bf16x8 hb[4];
  {
    int sq = b * 64 + gd;
    const float* HSf = (const float*)(p.ws + O_S5H) + ((size_t)sq * 68 + chunk) * 128;
#pragma unroll
    for (int ks = 0; ks < 4; ++ks) {
      float4 a = *(const float4*)(HSf + ks * 32 + 8 * fq), c = *(const float4*)(HSf + ks * 32 + 8 * fq + 4);
      uint4 pk = make_uint4(pack2(a.x, a.y), pack2(a.z, a.w), pack2(c.x, c.y), pack2(c.z, c.w));
      __builtin_memcpy(&hb[ks], &pk, 16);
    }
  }
  const u16* WS = (const u16*)(p.ws + O_WST) + (size_t)gd * 64 * 16 * 128;
  int tsl = 1 - (fq >> 1);
  const u16* KTp = KTl + fr * 16 + (fq & 1) * 8;
  bf16x8 wsc[4];
  {
    const u16* WS0 = WS + ((size_t)0 * 16 + fr) * 128 + 8 * fq;
#pragma unroll
    for (int ks = 0; ks < 4; ++ks) wsc[ks] = *(const bf16x8*)(WS0 + ks * 32);
  }
#pragma unroll 1
  for (int i = 0; i < 64; ++i) {
    f32x4 a0 = (f32x4){0.f, 0.f, 0.f, 0.f}, a1 = (f32x4){0.f, 0.f, 0.f, 0.f};
    bf16x8 wsn[4];
    {
      int inx = (i + 1 < 64) ? i + 1 : i;
      const u16* WSn = WS + ((size_t)inx * 16 + fr) * 128 + 8 * fq;
#pragma unroll
      for (int ks = 0; ks < 4; ++ks) wsn[ks] = *(const bf16x8*)(WSn + ks * 32);
    }
#pragma unroll
    for (int ks = 0; ks < 4; ++ks) {
      if (ks & 1) a1 = __builtin_amdgcn_mfma_f32_16x16x32_bf16(wsc[ks], hb[ks], a1, 0, 0, 0);
      else a0 = __builtin_amdgcn_mfma_f32_16x16x32_bf16(wsc[ks], hb[ks], a0, 0, 0, 0);
    }
#pragma unroll
    for (int js = 0; js < 32; ++js) {
      if (2 * js > i) break;
      int ts = i - 2 * js + tsl;
      bf16x8 a = *(const bf16x8*)(KTp + ts * 256);
      if (js & 1) a1 = __builtin_amdgcn_mfma_f32_16x16x32_bf16(a, ub[js], a1, 0, 0, 0);
      else a0 = __builtin_amdgcn_mfma_f32_16x16x32_bf16(a, ub[js], a0, 0, 0, 0);
    }
    size_t row = seq_row(chunk * 64 + i, b, dir);
    uint2 o; o.x = pack2(a0[0] + a1[0], a0[1] + a1[1]); o.y = pack2(a0[2] + a1[2], a0[3] + a1[3]);
    *(uint2*)(Yo + row * 512 + g * 16 + 4 * fq) = o;
#pragma unroll
    for (int ks = 0; ks < 4; ++ks) wsc[ks] = wsn[ks];
  }
  __syncthreads();
}

#define XB_TMO      128
#define XB_XCNT(j)  (256  + 64 * (j))
#define XB_XSUB(j)  (1280 + 64 * (j))
#define XB_XGEN(j)  (2304 + 64 * (j))
#define XB_TOP      3328
#define XB_TOPGEN   3392
#define XCD_BAR_WORDS 3456
#define XB_SPIN_CAP (1u << 18)
#define LAS __attribute__((address_space(3)))
__device__ __forceinline__ unsigned xb_ld(unsigned* p)              { return __hip_atomic_load(p, __ATOMIC_RELAXED, __HIP_MEMORY_SCOPE_AGENT); }
__device__ __forceinline__ unsigned xb_add(unsigned* p, unsigned v) { return __hip_atomic_fetch_add(p, v, __ATOMIC_RELAXED, __HIP_MEMORY_SCOPE_AGENT); }
__device__ __forceinline__ unsigned xb_xcc_id() { return (unsigned)__builtin_amdgcn_s_getreg((3 << 11) | 20) & 0xFu; }
#define XB_SPIN(cond, bar) do { unsigned _sp = 0; while (cond) { __builtin_amdgcn_s_sleep(1); \
    if ((++_sp & 255u) == 0u) { if (xb_ld(&(bar)[XB_TMO])) break; if (_sp > XB_SPIN_CAP) { atomicAdd(&(bar)[XB_TMO], 1u); break; } } } } while (0)
struct XcdBarrier { unsigned* bar; unsigned x; volatile LAS unsigned* st; };
__device__ __forceinline__ XcdBarrier xcd_barrier_post(unsigned* bar, volatile LAS unsigned* st) {
  XcdBarrier b; b.bar = bar; b.x = xb_xcc_id(); b.st = st;
  if (threadIdx.x == 0) (void)xb_add(&bar[XB_XCNT(b.x)], 1u);
  return b;
}
__device__ __forceinline__ void xcd_barrier_complete(unsigned* bar, unsigned x, unsigned& nloc, unsigned& nx) {
  const unsigned G = gridDim.x * gridDim.y * gridDim.z;
  unsigned sum, cnt, mine, sp = 0u;
  for (;;) {
    sum = 0u; cnt = 0u; mine = 0u;
#pragma unroll
    for (unsigned j = 0; j < 16; ++j) { const unsigned c = xb_ld(&bar[XB_XCNT(j)]); sum += c; cnt += (c > 0u) ? 1u : 0u; mine = (j == x) ? c : mine; }
    if (sum == G) break;
    __builtin_amdgcn_s_sleep(1);
    if ((++sp & 255u) == 0u) { if (xb_ld(&bar[XB_TMO])) break; if (sp > XB_SPIN_CAP) { atomicAdd(&bar[XB_TMO], 1u); break; } }
  }
  nloc = mine > 0u ? mine : 1u; nx = cnt > 0u ? cnt : 1u;
}
__device__ __forceinline__ void xcd_barrier(const XcdBarrier& b) {
  asm volatile("s_waitcnt vmcnt(0)" ::: "memory");
  __syncthreads();
  if (threadIdx.x == 0) {
    unsigned* bar = b.bar;
    __builtin_amdgcn_s_waitcnt(0);
    unsigned nloc = b.st[0], nx = b.st[1];
    if (nloc == 0u) { xcd_barrier_complete(bar, b.x, nloc, nx); b.st[0] = nloc; b.st[1] = nx; }
    const unsigned old = xb_add(&bar[XB_XSUB(b.x)], 1u);
    const unsigned gen = old / nloc;
    if (old + 1u == (gen + 1u) * nloc) {
      __builtin_amdgcn_fence(__ATOMIC_RELEASE, "agent");
      asm volatile("s_waitcnt vmcnt(0)" ::: "memory");
      const unsigned og = xb_add(&bar[XB_TOP], 1u);
      const unsigned tg = og / nx;
      if (og + 1u == (tg + 1u) * nx) xb_add(&bar[XB_TOPGEN], 1u);
      else XB_SPIN(xb_ld(&bar[XB_TOPGEN]) == tg, bar);
      __builtin_amdgcn_fence(__ATOMIC_ACQUIRE, "agent");
      xb_add(&bar[XB_XGEN(b.x)], 1u);
      asm volatile("s_waitcnt vmcnt(0)" ::: "memory");
    } else {
      XB_SPIN(xb_ld(&bar[XB_XGEN(b.x)]) == gen, bar);
      __builtin_amdgcn_fence(__ATOMIC_ACQUIRE, "agent");
      asm volatile("s_waitcnt vmcnt(0)" ::: "memory");
    }
  }
  __syncthreads();
}
DEVI void ph_gemm_glu(const Params& p, u16* sm) {
  const u16* Y5 = (const u16*)(p.ws + O_Y5);
  const u16* Wt = (const u16*)(p.ws + O_WGLU);
  u16* Ym = (u16*)(p.ws + O_HB);
  int nitems = 256 * 2;
  int tid = TIDX, lane = tid & 63, wid = tid >> 6, wr = wid >> 1, wc = wid & 1, fr = lane & 15, fq = lane >> 4;
  int lr = tid >> 3, kc = (tid & 7) * 8;
  for (int it = vbid(); it < nitems; it += gridDim.x) {
    int m0 = (it / 2) * 128, n0 = (it % 2) * 256;
    uint32_t pa[4], pb0 = (uint32_t)(n0 + lr) * 512u + kc;
#pragma unroll
    for (int i = 0; i < 4; ++i) pa[i] = (uint32_t)(m0 + lr + 32 * i) * 512u + kc;
    f32x4 acc[8][4];
    gemm_core<false>(sm, Y5, pa, 512u, Wt, pb0, 512u, 512, acc);
#pragma unroll
    for (int m = 0; m < 4; ++m) {
      size_t r = m0 + wr * 64 + m * 16 + fr;
#pragma unroll
      for (int n = 0; n < 8; ++n) {
        int col = n0 + wc * 128 + n * 16 + fq * 4;
        uint2 yv = *(const uint2*)(Y5 + r * 512 + col);
        float4 bv = *(const float4*)(p.in[38] + col);
        float y0 = bf2f((u16)(yv.x & 0xffff)), y1 = bf2f((u16)(yv.x >> 16)), y2 = bf2f((u16)(yv.y & 0xffff)), y3 = bf2f((u16)(yv.y >> 16));
        uint2 o;
        o.x = pack2(y0 * sigm(acc[n][m][0] + bv.x), y1 * sigm(acc[n][m][1] + bv.y));
        o.y = pack2(y2 * sigm(acc[n][m][2] + bv.z), y3 * sigm(acc[n][m][3] + bv.w));
        *(uint2*)(Ym + r * 1024 + 512 + col) = o;
      }
    }
  }
}

DEVI void run_phase(const Params& p, int ph, unsigned char* smem) {
  float* smf = (float*)smem; u16* smh = (u16*)smem;
  int bid = blockIdx.x, nb = gridDim.x;
#ifdef ONLY_PHASE
  if (ph != ONLY_PHASE) return;
  ph = ONLY_PHASE;
#endif
  switch (ph) {
    case 0: {
      int total = 192 + 272 + 1984 + 18432 + 32;
      for (int it = bid; it < total; it += nb) {
        if (it >= 20880) { int t = it - 20880; prep_tile(p.in[(t & 1) ? 14 : 12] + (size_t)(t >> 1) * 4096, 64, 64, (u16*)(p.ws + O_WLT) + (size_t)t * 4096, 0, smf); }
        else if (it < 192) mod_item(p, it, smf);
        else if (it < 464) filt_item(p, it - 192, smf);
        else if (it < 464 + 1984) {
          int t = it - 464;
          if (t < 640) prep_tile(p.in[9], 1024, 2560, (u16*)(p.ws + O_WIN0), t, smf);
          else if (t < 1408) prep_tile(p.in[26], 1024, 3072, (u16*)(p.ws + O_WIN1), t - 640, smf);
          else if (t < 1920) prep_tile(p.in[8], 1024, 1024, (u16*)(p.ws + O_WOUT), t - 1408, smf);
          else prep_tile(p.in[37], 512, 512, (u16*)(p.ws + O_WGLU), t - 1920, smf);
        } else prep_experts(p, 0, it - 2448, smf);
      }
    } break;
    case 1: {
      for (int it = bid; it < 1152; it += nb) filtfin_item(p, it, smf);
      ph_norm(p, 0, 1, true, false, false, false, smf);
    } break;
    case 2: ph_gemm_in(p, smh, (const u16*)(p.ws + O_WIN0), 2560); break;
    case 3: {
      int total = 4352 + 13056;
      for (int it = bid; it < total; it += nb) { if (it < 4352) lru_item(p, it, smem, 1); else hyconv_item(p, it - 4352, smf); }
    } break;
    case 4: {
      int total = 32 + 1536;
      for (int it = bid; it < total; it += nb) { if (it < 32) lru_combine_item(p, it); else toep_item(p, it - 32, smh, 0); }
    } break;
    case 5: {
      int total = 4352 + 1536;
      for (int it = bid; it < total; it += nb) { if (it < 1536) toep_item(p, it, smh, 1); else lru_item(p, it - 1536, smem, 3); }
    } break;
    case 26: for (int it = bid; it < 4352; it += nb) hytr_item(p, it, smh); break;
    case 6: ph_gemm_out(p, smh, 0); break;
    case 7: { for (int it = bid; it < 16; it += nb) s5pow_item(p, it); ph_norm(p, 0, 2, true, false, true, false, smf); } break;
    case 8: for (int it = bid; it < 256 + 1600; it += nb) { if (it < 256) topk_item(p, it, (int*)smem); else s5tab_item(p, it - 256); } break;
    case 9: ph_moe_up(p, smh, 34); break;
    case 10: ph_moe_down(p, smh, 0, 34); break;
    case 11: {
      for (int it = bid; it < 18432; it += nb) prep_experts(p, 1, it, smf);
      ph_norm(p, 1, 1, true, true, false, true, smf);
    } break;
    case 12: {
      ph_gemm_in(p, smh, (const u16*)(p.ws + O_WIN1), 3072);
    } break;
    case 13: for (int it = bid; it < 4352 + 2176; it += nb) { if (it < 2176) s5A_mfma_item(p, it); else hgrnA_item(p, it - 2176, smem); } break;
    case 24: for (int it = bid; it < 2176; it += nb) s5A_mfma_item(p, it); break;
    case 22: {
      int total = 512 + 128;
      for (int it = bid; it < total; it += nb) { if (it < 512) hgrnB_item(p, it); else s5B_item(p, it - 512); }
    } break;
    case 23: for (int it = bid; it < 2048 + 512; it += nb) { if (it < 512) s5C_mfma_item(p, it, smh); else hgrnC_item(p, it - 512, smem); } break;
    case 25: for (int it = bid; it < 512; it += nb) s5C_mfma_item(p, it, smh); break;
    case 14: ph_l1_finalize(p); break;
    case 15: ph_gemm_glu(p, smh); break;
    case 16: ph_gemm_out(p, smh, 1); break;
    case 17: ph_norm(p, 1, 2, false, false, true, false, smf); break;
    case 18: for (int it = bid; it < 128; it += nb) topk_item(p, it, (int*)smem); break;
    case 19: ph_moe_up(p, smh, 32); break;
    case 20: ph_moe_down(p, smh, 1, 32); break;
    case 21: ph_final(p); break;
  }
}

__global__ void __launch_bounds__(256, 2) mega(Params p, int ph_lo, int ph_hi) {
  extern __shared__ __attribute__((aligned(16))) unsigned char smem[];
  cg::grid_group grid = cg::this_grid();
  __shared__ __attribute__((aligned(16))) unsigned xb_words[4];
  if (threadIdx.x < 4) xb_words[threadIdx.x] = 0u;
  __syncthreads();
  XcdBarrier xb = xcd_barrier_post((unsigned*)(p.ws + O_BAR), (volatile LAS unsigned*)&xb_words);
  if (ph_lo > ph_hi) grid.sync();
#define GSYNC(POS) { xcd_barrier(xb); }
#ifdef PROBE_LO
  long long pt0 = 0;
#define PHC(POS, N) { if (POS > 0) GSYNC(POS) \
    if (POS == PROBE_HI + 1) { long long t1 = wall_clock64(); long long dl = t1 - pt0; while (wall_clock64() - t1 < dl) {} } \
    if (POS == PROBE_LO) pt0 = wall_clock64(); run_phase(p, N, smem); }
#else
#define PHC(POS, N) { if (POS > 0) GSYNC(POS) run_phase(p, N, smem); }
#endif
  PHC(0, 0) PHC(1, 1) PHC(2, 2) PHC(3, 3) PHC(4, 4) PHC(5, 5) PHC(6, 26) PHC(7, 6) PHC(8, 7) PHC(9, 8) PHC(10, 9) PHC(11, 10) PHC(12, 11)
  PHC(13, 12) PHC(14, 13) PHC(15, 22) PHC(16, 23) PHC(17, 14) PHC(18, 15) PHC(19, 16) PHC(20, 17)
  PHC(21, 18) PHC(22, 19) PHC(23, 20) PHC(24, 21)
#ifdef PROBE_LO
  PHC(25, 99)
#endif
#undef PHC
}

extern "C" void kernel_launch(void* const* d_in, const int* in_sizes, int n_in, void* d_out, int out_size,
                              void* d_ws, size_t ws_size, hipStream_t stream) {
  static int grid_blocks = 0;
  if (!grid_blocks) {
    int dev = 0, cus = 0, per_cu = 0;
    (void)hipGetDevice(&dev);
    (void)hipDeviceGetAttribute(&cus, hipDeviceAttributeMultiprocessorCount, dev);
    (void)hipFuncSetAttribute((const void*)mega, hipFuncAttributeMaxDynamicSharedMemorySize, SMEM_BYTES);
    (void)hipOccupancyMaxActiveBlocksPerMultiprocessor(&per_cu, mega, 256, SMEM_BYTES);
    if (per_cu > 2) per_cu = 2;
    if (per_cu < 1) per_cu = 1;
    grid_blocks = cus * per_cu;
  }
  Params p{};
  for (int i = 0; i < 44; ++i) p.in[i] = (const float*)d_in[i];
  p.out = (float*)d_out; p.ws = (unsigned char*)d_ws;
  int lo = 0, hi = 23;
  (void)hipMemsetAsync((unsigned char*)d_ws + O_BAR, 0, XCD_BAR_WORDS * 4, stream);
  void* args[] = {&p, &lo, &hi};
  hipError_t e = hipLaunchCooperativeKernel((void*)mega, dim3(grid_blocks), dim3(256), args, SMEM_BYTES, stream);
  if (e != hipSuccess) fprintf(stderr, "cooperative launch failed: %s (grid %d)\n", hipGetErrorString(e), grid_blocks);
}
```
